# Optimizing an MI355X kernel written in HIP

```python
import math
import jax
import jax.numpy as jnp
from jax import lax
import numpy as np

D_MODEL = 2048
BATCH = 4
SEQ = 2048
DEPTH = 2

HEAD_DIM = 128
N_HEADS = D_MODEL // HEAD_DIM
GLA_HEADS = N_HEADS // 4
DIFF_HEADS = (N_HEADS - GLA_HEADS) // 2
MOBA_HEADS = N_HEADS - GLA_HEADS - DIFF_HEADS
DIFF_QK_DIM = HEAD_DIM // 2
DIFF_Q_BLOCK = 128
GLA_DK = HEAD_DIM // 2
GLA_DV = HEAD_DIM
GLA_GATE_RANK = 16
GLA_TAU = 16.0
GLA_CHUNK = 64
MOBA_BLOCK = 256
MOBA_TOPK = 3
MOBA_Q_CHUNK = 32
ROPE_THETA = 10000.0
D_FF = ((8 * D_MODEL // 3 + 255) // 256) * 256
PLE_DIM = 256
LN_EPS = 1e-5
DEEPNORM_ALPHA = (2 * DEPTH) ** 0.25
DEEPNORM_BETA = (8 * DEPTH) ** -0.25

_IN_WIDTHS = (
    DIFF_HEADS * 2 * DIFF_QK_DIM,
    DIFF_HEADS * 2 * DIFF_QK_DIM,
    DIFF_HEADS * HEAD_DIM,
    GLA_HEADS * GLA_DK,
    GLA_HEADS * GLA_DK,
    GLA_HEADS * GLA_DV,
    GLA_HEADS * GLA_DV,
    GLA_GATE_RANK,
    MOBA_HEADS * HEAD_DIM,
    MOBA_HEADS * HEAD_DIM,
    MOBA_HEADS * HEAD_DIM,
)
D_IN = int(sum(_IN_WIDTHS))
IN_SPLITS = tuple(int(v) for v in np.cumsum(_IN_WIDTHS)[:-1])
MIX_WIDTH = (DIFF_HEADS + GLA_HEADS + MOBA_HEADS) * HEAD_DIM

kernel_name = "hymba_style_diff_gla_moba_macaron_deepnorm"


def layer_norm(x, g, b):
    xf = x.astype(jnp.float32)
    mu = jnp.mean(xf, axis=-1, keepdims=True)
    var = jnp.mean(jnp.square(xf - mu), axis=-1, keepdims=True)
    return ((xf - mu) * lax.rsqrt(var + LN_EPS) * g + b).astype(x.dtype)


def rms_norm(x, g):
    xf = x.astype(jnp.float32)
    return (xf * lax.rsqrt(jnp.mean(xf * xf, axis=-1, keepdims=True) + LN_EPS) * g).astype(x.dtype)


def swiglu(h, w_gate, w_up, w_down):
    return (jax.nn.silu(h @ w_gate) * (h @ w_up)) @ w_down


def to_heads(t, n, d):
    b, s, _ = t.shape
    return t.reshape(b, s, n, d).transpose(0, 2, 1, 3)


def rope(t, positions):
    d = t.shape[-1]
    inv = ROPE_THETA ** (-jnp.arange(0, d, 2, dtype=jnp.float32) / d)
    ang = positions.astype(jnp.float32)[:, None, :, None] * inv
    cos, sin = jnp.cos(ang), jnp.sin(ang)
    tf = t.astype(jnp.float32)
    t1, t2 = tf[..., : d // 2], tf[..., d // 2:]
    return jnp.concatenate([t1 * cos - t2 * sin, t2 * cos + t1 * sin], axis=-1).astype(t.dtype)


def diff_attention(q1, q2, k1, k2, v, lam):
    b, h, s, dqk = q1.shape
    scale = dqk ** -0.5
    key_pos = jnp.arange(s)

    def block(i):
        qs = i * DIFF_Q_BLOCK
        q1b = lax.dynamic_slice_in_dim(q1, qs, DIFF_Q_BLOCK, axis=2)
        q2b = lax.dynamic_slice_in_dim(q2, qs, DIFF_Q_BLOCK, axis=2)
        mask = (qs + jnp.arange(DIFF_Q_BLOCK))[:, None] >= key_pos[None, :]
        s1 = jnp.einsum('bhqd,bhkd->bhqk', q1b, k1).astype(jnp.float32) * scale
        s2 = jnp.einsum('bhqd,bhkd->bhqk', q2b, k2).astype(jnp.float32) * scale
        a1 = jax.nn.softmax(jnp.where(mask, s1, -jnp.inf), axis=-1)
        a2 = jax.nn.softmax(jnp.where(mask, s2, -jnp.inf), axis=-1)
        a = (a1 - lam * a2).astype(v.dtype)
        return jnp.einsum('bhqk,bhkd->bhqd', a, v)

    out = lax.map(block, jnp.arange(s // DIFF_Q_BLOCK))
    return jnp.moveaxis(out, 0, 2).reshape(b, h, s, v.shape[-1])


def gla_chunked(q, k, v, log_a):
    dtype = v.dtype
    q, k, v, log_a = (t.astype(jnp.float32) for t in (q, k, v, log_a))
    b, h, s, dk = q.shape
    dv = v.shape[-1]
    n = s // GLA_CHUNK
    chunk = lambda t: jnp.moveaxis(t.reshape(b, h, n, GLA_CHUNK, t.shape[-1]), 2, 0)
    causal = jnp.tril(jnp.ones((GLA_CHUNK, GLA_CHUNK), dtype=bool))

    def step(state, inp):
        qc, kc, vc, gc = inp
        cum = jnp.cumsum(gc, axis=-2)
        inter = jnp.einsum('bhik,bhkv->bhiv', qc * jnp.exp(cum), state)
        rel = cum[:, :, :, None, :] - cum[:, :, None, :, :]
        decay = jnp.exp(jnp.where(causal[:, :, None], rel, -jnp.inf))
        att = jnp.einsum('bhik,bhjk,bhijk->bhij', qc, kc, decay)
        out = inter + jnp.einsum('bhij,bhjv->bhiv', att, vc)
        last = cum[:, :, -1:, :]
        new_state = jnp.exp(last[:, :, 0, :])[..., None] * state + jnp.einsum(
            'bhjk,bhjv->bhkv', kc * jnp.exp(last - cum), vc)
        return new_state, out

    state0 = jnp.zeros((b, h, dk, dv), jnp.float32)
    _, out = lax.scan(step, state0, (chunk(q), chunk(k), chunk(v), chunk(log_a)))
    return jnp.moveaxis(out, 0, 2).reshape(b, h, s, dv).astype(dtype)


def moba_attention(q, k, v):
    b, h, s, d = q.shape
    scale = d ** -0.5
    nb = -(-s // MOBA_BLOCK)
    pad = nb * MOBA_BLOCK - s
    kp = jnp.pad(k, ((0, 0), (0, 0), (0, pad), (0, 0)))
    vp = jnp.pad(v, ((0, 0), (0, 0), (0, pad), (0, 0)))
    kb = kp.reshape(b, h, nb, MOBA_BLOCK, d)
    vb = vp.reshape(b, h, nb, MOBA_BLOCK, d)
    kmean = jnp.mean(kb.astype(jnp.float32), axis=3)
    kt = min(MOBA_TOPK, nb)
    bi = jnp.arange(b)[:, None, None, None]
    hi = jnp.arange(h)[None, :, None, None]

    def chunk(c):
        qs = c * MOBA_Q_CHUNK
        own = qs // MOBA_BLOCK
        qc = lax.dynamic_slice_in_dim(q, qs, MOBA_Q_CHUNK, axis=2)
        gate = jnp.einsum('bhqd,bhnd->bhqn', qc.astype(jnp.float32), kmean)
        gate = jnp.where(jnp.arange(nb) < own, gate, -jnp.inf)
        _, idx = lax.top_k(gate, kt)
        valid = jnp.repeat(jnp.arange(kt) < own, MOBA_BLOCK)
        ksel = kb[bi, hi, idx]
        vsel = vb[bi, hi, idx]
        s_sel = jnp.einsum('bhqd,bhqrkd->bhqrk', qc, ksel).astype(jnp.float32) * scale
        s_sel = jnp.where(valid, s_sel.reshape(b, h, MOBA_Q_CHUNK, kt * MOBA_BLOCK), -jnp.inf)
        kown = lax.dynamic_slice_in_dim(kp, own * MOBA_BLOCK, MOBA_BLOCK, axis=2)
        vown = lax.dynamic_slice_in_dim(vp, own * MOBA_BLOCK, MOBA_BLOCK, axis=2)
        own_mask = (own * MOBA_BLOCK + jnp.arange(MOBA_BLOCK))[None, :] <= (qs + jnp.arange(MOBA_Q_CHUNK))[:, None]
        s_own = jnp.einsum('bhqd,bhkd->bhqk', qc, kown).astype(jnp.float32) * scale
        s_own = jnp.where(own_mask, s_own, -jnp.inf)
        probs = jax.nn.softmax(jnp.concatenate([s_sel, s_own], axis=-1), axis=-1).astype(v.dtype)
        p_sel = probs[..., : kt * MOBA_BLOCK].reshape(b, h, MOBA_Q_CHUNK, kt, MOBA_BLOCK)
        p_own = probs[..., kt * MOBA_BLOCK:]
        return (jnp.einsum('bhqrk,bhqrkd->bhqd', p_sel, vsel)
                + jnp.einsum('bhqk,bhkd->bhqd', p_own, vown))

    out = lax.map(chunk, jnp.arange(s // MOBA_Q_CHUNK))
    return jnp.moveaxis(out, 0, 2).reshape(b, h, s, d)


def token_mix(h, positions, w_in, w_out, diff_lambda, diff_norm_g, gla_gate_up, gla_gate_b,
              gla_norm_g, layer):
    b, s, _ = h.shape
    proj = h @ w_in
    dq, dk, dv, gq, gk, gv, gr, gg, mq, mk, mv = jnp.split(proj, IN_SPLITS, axis=-1)

    lam_init = 0.8 - 0.6 * math.exp(-0.3 * layer)
    lf = diff_lambda.astype(jnp.float32)
    lam = jnp.exp(jnp.sum(lf[0] * lf[1])) - jnp.exp(jnp.sum(lf[2] * lf[3])) + lam_init
    dq = dq.reshape(b, s, DIFF_HEADS, 2, DIFF_QK_DIM).transpose(0, 2, 3, 1, 4)
    dk = dk.reshape(b, s, DIFF_HEADS, 2, DIFF_QK_DIM).transpose(0, 2, 3, 1, 4)
    q1, q2 = rope(dq[:, :, 0], positions), rope(dq[:, :, 1], positions)
    k1, k2 = rope(dk[:, :, 0], positions), rope(dk[:, :, 1], positions)
    o_diff = diff_attention(q1, q2, k1, k2, to_heads(dv, DIFF_HEADS, HEAD_DIM), lam)
    o_diff = rms_norm(o_diff.transpose(0, 2, 1, 3), diff_norm_g) * (1.0 - lam_init)
    o_diff = o_diff.reshape(b, s, DIFF_HEADS * HEAD_DIM)

    log_a = jax.nn.log_sigmoid(gg @ gla_gate_up + gla_gate_b) / GLA_TAU
    o_gla = gla_chunked(to_heads(gq, GLA_HEADS, GLA_DK) * (GLA_DK ** -0.5),
                        to_heads(gk, GLA_HEADS, GLA_DK),
                        to_heads(gv, GLA_HEADS, GLA_DV),
                        to_heads(log_a, GLA_HEADS, GLA_DK))
    o_gla = rms_norm(o_gla.transpose(0, 2, 1, 3), gla_norm_g).reshape(b, s, GLA_HEADS * GLA_DV)
    o_gla = o_gla * jax.nn.silu(gr)

    o_moba = moba_attention(rope(to_heads(mq, MOBA_HEADS, HEAD_DIM), positions),
                            rope(to_heads(mk, MOBA_HEADS, HEAD_DIM), positions),
                            to_heads(mv, MOBA_HEADS, HEAD_DIM))
    o_moba = o_moba.transpose(0, 2, 1, 3).reshape(b, s, MOBA_HEADS * HEAD_DIM)

    return jnp.concatenate([o_diff, o_gla, o_moba], axis=-1) @ w_out


def setup_inputs(seed: int = 0) -> dict:
    key = jax.random.key(seed)
    ks = jax.random.split(key, 21)
    nrm = lambda k, shape, scale: jax.random.normal(k, shape, jnp.float32) * scale
    beta = DEEPNORM_BETA
    return {
        "x": nrm(ks[0], (BATCH, SEQ, D_MODEL), 1.0),
        "p": nrm(ks[1], (DEPTH, BATCH, SEQ, PLE_DIM), 1.0),
        "positions": jnp.broadcast_to(jnp.arange(SEQ, dtype=jnp.int32)[None, :], (BATCH, SEQ)),
        "w_in": nrm(ks[2], (DEPTH, D_MODEL, D_IN), D_MODEL ** -0.5),
        "w_out": nrm(ks[3], (DEPTH, MIX_WIDTH, D_MODEL), beta * MIX_WIDTH ** -0.5),
        "diff_lambda": nrm(ks[4], (DEPTH, 4, DIFF_QK_DIM), 0.1),
        "diff_norm_g": 1.0 + nrm(ks[5], (DEPTH, HEAD_DIM), 0.02),
        "gla_gate_up": nrm(ks[6], (DEPTH, GLA_GATE_RANK, GLA_HEADS * GLA_DK), GLA_GATE_RANK ** -0.5),
        "gla_gate_b": nrm(ks[7], (DEPTH, GLA_HEADS * GLA_DK), 0.1),
        "gla_norm_g": 1.0 + nrm(ks[8], (DEPTH, GLA_DV), 0.02),
        "ffn1_gate": nrm(ks[9], (DEPTH, D_MODEL, D_FF), D_MODEL ** -0.5),
        "ffn1_up": nrm(ks[10], (DEPTH, D_MODEL, D_FF), D_MODEL ** -0.5),
        "ffn1_down": nrm(ks[11], (DEPTH, D_FF, D_MODEL), beta * D_FF ** -0.5),
        "ffn2_gate": nrm(ks[12], (DEPTH, D_MODEL, D_FF), D_MODEL ** -0.5),
        "ffn2_up": nrm(ks[13], (DEPTH, D_MODEL, D_FF), D_MODEL ** -0.5),
        "ffn2_down": nrm(ks[14], (DEPTH, D_FF, D_MODEL), beta * D_FF ** -0.5),
        "w_pe": nrm(ks[15], (DEPTH, PLE_DIM, D_MODEL), beta * PLE_DIM ** -0.5),
        "w_pg": nrm(ks[16], (DEPTH, D_MODEL, D_MODEL), D_MODEL ** -0.5),
        "ln_g": 1.0 + nrm(ks[17], (DEPTH, 4, D_MODEL), 0.02),
        "ln_b": nrm(ks[18], (DEPTH, 4, D_MODEL), 0.02),
    }


def reference(x, p, positions, w_in, w_out, diff_lambda, diff_norm_g, gla_gate_up, gla_gate_b,
              gla_norm_g, ffn1_gate, ffn1_up, ffn1_down, ffn2_gate, ffn2_up, ffn2_down,
              w_pe, w_pg, ln_g, ln_b):
    a = DEEPNORM_ALPHA
    for i in range(DEPTH):
        x = layer_norm(a * x + 0.5 * swiglu(x, ffn1_gate[i], ffn1_up[i], ffn1_down[i]), ln_g[i, 0], ln_b[i, 0])
        x = layer_norm(a * x + token_mix(x, positions, w_in[i], w_out[i], diff_lambda[i], diff_norm_g[i],
                                         gla_gate_up[i], gla_gate_b[i], gla_norm_g[i], i),
                       ln_g[i, 1], ln_b[i, 1])
        x = layer_norm(a * x + 0.5 * swiglu(x, ffn2_gate[i], ffn2_up[i], ffn2_down[i]), ln_g[i, 2], ln_b[i, 2])
        e = (p[i] @ w_pe[i]) * jax.nn.sigmoid(x @ w_pg[i])
        x = layer_norm(a * x + e, ln_g[i, 3], ln_b[i, 3])
    return x
```

```cpp
#include <hip/hip_runtime.h>
#include <hip/hip_cooperative_groups.h>
#include <cstdio>
#include <cstdint>
namespace cg = cooperative_groups;

#define LAS __attribute__((address_space(3)))
typedef unsigned short bf16_t;
typedef short bf16x8 __attribute__((ext_vector_type(8)));
typedef float f32x2 __attribute__((ext_vector_type(2)));
typedef float f32x4 __attribute__((ext_vector_type(4)));
typedef float f32x16 __attribute__((ext_vector_type(16)));
typedef unsigned u32x2 __attribute__((ext_vector_type(2)));
typedef unsigned u32x4 __attribute__((ext_vector_type(4)));

constexpr int NB = 4, SEQ = 2048, DM = 2048, MTOK = NB * SEQ, FF = 5632, DIN = 6160, PLE = 256, DEPTH = 2;
constexpr int PROJW = 4096;
constexpr int C_DQ = 0, C_DK = 768, C_MQ = 1536, C_MK = 2304, C_GQ = 3072, C_GK = 3328, C_GR = 3584;
constexpr int W_DQ = 0, W_DK = 768, W_DV = 1536, W_GQ = 2304, W_GK = 2560, W_GV = 2816, W_GR = 3328, W_GG = 3840, W_MQ = 3856, W_MK = 4624, W_MV = 5392;
constexpr float LN_EPS = 1e-5f;
constexpr float ALPHA = 1.4142135623730951f;
constexpr float LOG2E = 1.4426950408889634f;
constexpr float NEG_BIG = -1.0e30f;

constexpr size_t MiB = 1u << 20;
constexpr size_t WL_GU1 = 0, WL_D1 = 44 * MiB, WL_IN = 66 * MiB, WL_V = 82 * MiB, WL_OUT = 90 * MiB, WL_GU2 = 98 * MiB, WL_D2 = 142 * MiB, WL_PE = 164 * MiB, WL_PG = 165 * MiB, WL_GG = 173 * MiB, WL_SIZE = 174 * MiB;
constexpr size_t WS_CTL = 0;
constexpr size_t WS_W = 1 * MiB;
constexpr size_t WS_X = WS_W + 2 * WL_SIZE;
constexpr size_t WS_XB = WS_X + 64 * MiB;
constexpr size_t WS_H = WS_XB + 32 * MiB;
constexpr size_t WS_PROJ = WS_H + 88 * MiB;
constexpr size_t WS_VT = WS_PROJ + 64 * MiB;
constexpr size_t WS_MIX = WS_VT + 32 * MiB;
constexpr size_t WS_PB = WS_MIX + 32 * MiB;
constexpr size_t WS_R128 = WS_PB + 8 * MiB;
constexpr size_t WS_R64 = WS_R128 + 4 * MiB;
constexpr size_t WS_GG = WS_R64 + 2 * MiB;
constexpr size_t WS_QT = WS_GG + 1 * MiB;
constexpr size_t WS_QTP = WS_QT + 4 * MiB;
constexpr size_t WS_KT = WS_QTP + 4 * MiB;
constexpr size_t WS_KTT = WS_KT + 4 * MiB;
constexpr size_t WS_EL = WS_KTT + 4 * MiB;
constexpr size_t WS_KM = WS_EL + 1 * MiB;
constexpr size_t WS_END = WS_KM + 1 * MiB;

constexpr int LDS_BYTES = 147456;
constexpr int NWAVES = 8, NTHREADS = 512;

__device__ __forceinline__ float bf2f(bf16_t b) { return __uint_as_float(((unsigned)b) << 16); }
__device__ __forceinline__ float bflo(unsigned w) { return __uint_as_float(w << 16); }
__device__ __forceinline__ float bfhi(unsigned w) { return __uint_as_float(w & 0xffff0000u); }
__device__ __forceinline__ unsigned pk_bf16(float lo, float hi) { unsigned r; asm("v_cvt_pk_bf16_f32 %0, %1, %2" : "=v"(r) : "v"(lo), "v"(hi)); return r; }
__device__ __forceinline__ float wave_sum(float v) {
#pragma unroll
    for (int o = 1; o < 64; o <<= 1) v += __shfl_xor(v, o);
    return v;
}
__device__ __forceinline__ float fexp2(float x) { return __builtin_amdgcn_exp2f(x); }
__device__ __forceinline__ float fsigmoid(float x) { return __builtin_amdgcn_rcpf(1.f + fexp2(-x * LOG2E)); }
__device__ __forceinline__ int crow(int reg, int h) { return (reg & 3) + 8 * (reg >> 2) + 4 * h; }
#define MFMA32(a, b, c) __builtin_amdgcn_mfma_f32_32x32x16_bf16((a), (b), (c), 0, 0, 0)
#define LDS_WAIT() asm volatile("s_waitcnt lgkmcnt(0)" ::: "memory")
__device__ __forceinline__ bf16x8 pack8(const f32x16& x, int s) {
    u32x4 p;
    p.x = pk_bf16(x[8 * s + 0], x[8 * s + 1]); p.y = pk_bf16(x[8 * s + 2], x[8 * s + 3]);
    p.z = pk_bf16(x[8 * s + 4], x[8 * s + 5]); p.w = pk_bf16(x[8 * s + 6], x[8 * s + 7]);
    return __builtin_bit_cast(bf16x8, p);
}

namespace pg8 {
constexpr int BM = 256, BK = 64, HALF = 128, HTB = HALF * BK * 2, STAGE_BYTES = 8 * HTB, NXCD = 8, WGM = 8;
__host__ __device__ __forceinline__ int lds_byte(int r, int c) { const int st = (r >> 4) * 2 + (c >> 5), rr = r & 15, cc = c & 31, ob = rr * 64 + cc * 2; return st * 1024 + (ob ^ (((ob >> 9) & 1) << 5)); }
__host__ __device__ __forceinline__ void stage_rc(int b, int& R, int& C) { const int st = b / 1024, sb = b % 1024, swz = sb ^ (((sb >> 9) & 1) << 5); R = (st >> 1) * 16 + swz / 64; C = (st & 1) * 32 + (swz % 64) / 2; }
__host__ __device__ __forceinline__ int perm32(int rho) { const int n = rho >> 4, i = rho & 15; return 8 * (i >> 2) + 4 * n + (i & 3); }
struct Unit { int pm, pn; };
struct Gemm { const bf16_t* A; const bf16_t* Bt; int M, N, K; };
struct StaticOrder {
    int nM, nN, nwg, G, c;
    __host__ __device__ void init(int M, int N, int G_, int c_) { nM = M / BM; nN = N / BM; nwg = nM * nN; G = G_; c = c_; }
    __host__ __device__ bool next(int i, Unit& u) const {
        const long L = (long)i * G + c; if (L >= nwg) return false;
        int wgid = (int)L; { const int q = nwg / NXCD, r = nwg % NXCD, xcd = wgid % NXCD, off = wgid / NXCD; wgid = (xcd < r ? xcd * (q + 1) : r * (q + 1) + (xcd - r) * q) + off; }
        const int nig = WGM * nN, gid = wgid / nig, fm = gid * WGM, gsz = (nM - fm) < WGM ? (nM - fm) : WGM;
        u.pm = fm + ((wgid % nig) % gsz); u.pn = (wgid % nig) / gsz; return true;
    }
    __device__ __forceinline__ void a_ready(const Unit&) const {}
    __device__ __forceinline__ void done(const Unit&) const {}
};

template <class Epi, class Sched, bool ALIGN_EPI = false, bool SP2 = false>
__device__ __forceinline__ void gemm_phase(LAS unsigned char* lds, const Gemm g, const Sched& S, const Epi& E, const int tid) {
    const int wid = __builtin_amdgcn_readfirstlane(tid >> 6), lane = tid & 63, wr = wid >> 2, wc = wid & 3, fr = lane & 15, fq = lane >> 4;
    const int K = g.K, nt = K / BK;
    unsigned voffA[2], voffB[2];
#pragma unroll
    for (int i = 0; i < 2; ++i) { int R, C; stage_rc(tid * 16 + i * 8192, R, C); const int Rb = Epi::PERM ? ((R & ~31) + perm32(R & 31)) : R;
        voffA[i] = (unsigned)(R * K + C) * 2u; voffB[i] = (unsigned)(Rb * K + C) * 2u; }
    const size_t kstep = (size_t)(BK * 2);
    const size_t hstep = (size_t)HALF * K * 2;
    const size_t tstep = 2 * hstep;
    const unsigned ldsw = (unsigned)wid * 1024u;
    const int aoff = lds_byte(wr * 64 + fr, fq * 8), boff = lds_byte(wc * 32 + fr, fq * 8);
#define PG8_SA(b, h) (((b) * 2 + (h)) * HTB)
#define PG8_SB(b, h) ((4 + (b) * 2 + (h)) * HTB)
#define PG8_STAGE(bufoff, gbase, voff) do { _Pragma("unroll") for (int _i = 0; _i < 2; ++_i) \
        __builtin_amdgcn_global_load_lds((const unsigned*)((const char*)(gbase) + (voff)[_i]), (LAS unsigned*)(lds + (bufoff) + ldsw + _i * 8192), 16, 0, 0); } while (0)
#define PG8_LDA(dst, b, h) do { _Pragma("unroll") for (int m = 0; m < 4; ++m) _Pragma("unroll") for (int k = 0; k < 2; ++k) dst[m][k] = *(const LAS bf16x8*)(lds + PG8_SA(b, h) + aoff + m * 2048 + k * 1024); } while (0)
#define PG8_LDB(dst, b, h) do { _Pragma("unroll") for (int n = 0; n < 2; ++n) _Pragma("unroll") for (int k = 0; k < 2; ++k) dst[n][k] = *(const LAS bf16x8*)(lds + PG8_SB(b, h) + boff + n * 2048 + k * 1024); } while (0)
#define PG8_MMA(ai, bj, At, Bt) do { __builtin_amdgcn_s_setprio(1); _Pragma("unroll") for (int m = 0; m < 4; ++m) _Pragma("unroll") for (int n = 0; n < 2; ++n) _Pragma("unroll") for (int k = 0; k < 2; ++k) \
        acc[ai][bj][m][n] = __builtin_amdgcn_mfma_f32_16x16x32_bf16(Bt[n][k], At[m][k], acc[ai][bj][m][n], 0, 0, 0); __builtin_amdgcn_s_setprio(0); } while (0)
#define PG8_WAIT_V(n) asm volatile("s_waitcnt vmcnt(" #n ")" ::: "memory")
#define PG8_WAIT_L(n) asm volatile("s_waitcnt lgkmcnt(" #n ")" ::: "memory")
#define PG8_BAR __builtin_amdgcn_s_barrier()
#define PG8_SCHED __builtin_amdgcn_sched_barrier(0)
    Unit cur, nxt; int ui = 0;
    if (!S.next(0, cur)) return;
    f32x4 acc[2][2][4][2];
#pragma unroll
    for (int a = 0; a < 2; ++a)
#pragma unroll
        for (int b = 0; b < 2; ++b)
#pragma unroll
            for (int m = 0; m < 4; ++m)
#pragma unroll
                for (int n = 0; n < 2; ++n) acc[a][b][m][n] = (f32x4){0.f, 0.f, 0.f, 0.f};
    bf16x8 At[4][2], B0[2][2], B1[2][2];
    const char* cA = (const char*)g.A + (size_t)cur.pm * tstep; const char* cB = (const char*)g.Bt + (size_t)cur.pn * tstep;
    S.a_ready(cur);
    if constexpr (SP2) {
        PG8_STAGE(PG8_SB(0, 0), cB, voffB); PG8_STAGE(PG8_SB(0, 1), cB + hstep, voffB); PG8_STAGE(PG8_SA(0, 0), cA, voffA); PG8_STAGE(PG8_SA(0, 1), cA + hstep, voffA);
        if (wr == 1) PG8_BAR;
        PG8_WAIT_V(2); PG8_BAR;
        PG8_STAGE(PG8_SB(1, 0), cB + kstep, voffB); PG8_STAGE(PG8_SA(1, 0), cA + kstep, voffA); PG8_STAGE(PG8_SB(1, 1), cB + hstep + kstep, voffB);
        PG8_WAIT_V(6); PG8_BAR;
    } else {
        PG8_STAGE(PG8_SB(0, 0), cB, voffB); PG8_STAGE(PG8_SA(0, 0), cA, voffA); PG8_STAGE(PG8_SB(0, 1), cB + hstep, voffB); PG8_STAGE(PG8_SA(0, 1), cA + hstep, voffA);
        if (wr == 1) PG8_BAR;
        PG8_WAIT_V(4); PG8_BAR;
        PG8_STAGE(PG8_SB(1, 0), cB + kstep, voffB); PG8_STAGE(PG8_SA(1, 0), cA + kstep, voffA); PG8_STAGE(PG8_SB(1, 1), cB + hstep + kstep, voffB);
        PG8_WAIT_V(6); PG8_BAR;
    }
    for (;;) {
        const bool has_next = S.next(ui + 1, nxt);
        const char* nA = has_next ? (const char*)g.A + (size_t)nxt.pm * tstep : cA; const char* nB = has_next ? (const char*)g.Bt + (size_t)nxt.pn * tstep : cB;
        for (int t = 0; t < nt; t += 2) {
            const bool last = (t == nt - 2);
            const char* a1 = cA + (size_t)(t + 1) * kstep;
            const char* a2 = last ? nA : cA + (size_t)(t + 2) * kstep; const char* b2 = last ? nB : cB + (size_t)(t + 2) * kstep;
            const char* a3 = a2 + kstep; const char* b3 = b2 + kstep;
            if (last && has_next) S.a_ready(nxt);
            if constexpr (SP2) {
            PG8_LDB(B0, 0, 0); PG8_LDB(B1, 0, 1); PG8_SCHED; PG8_LDA(At, 0, 0); PG8_STAGE(PG8_SA(1, 1), a1 + hstep, voffA);
            PG8_WAIT_V(8); PG8_WAIT_L(0); PG8_BAR; PG8_MMA(0, 0, At, B0); PG8_MMA(0, 1, At, B1); PG8_BAR; PG8_SCHED;
            PG8_LDA(At, 0, 1); PG8_STAGE(PG8_SB(0, 0), b2, voffB); PG8_STAGE(PG8_SB(0, 1), b2 + hstep, voffB); PG8_STAGE(PG8_SA(0, 0), a2, voffA);
            PG8_WAIT_V(8); PG8_WAIT_L(0); PG8_BAR; PG8_MMA(1, 0, At, B0); PG8_MMA(1, 1, At, B1); PG8_BAR; PG8_SCHED;
            PG8_LDB(B0, 1, 0); PG8_LDB(B1, 1, 1); PG8_SCHED; PG8_LDA(At, 1, 0); PG8_STAGE(PG8_SA(0, 1), a2 + hstep, voffA);
            PG8_WAIT_V(8); PG8_WAIT_L(0); PG8_BAR; PG8_MMA(0, 0, At, B0); PG8_MMA(0, 1, At, B1); PG8_BAR; PG8_SCHED;
            PG8_LDA(At, 1, 1); PG8_STAGE(PG8_SB(1, 0), b3, voffB); PG8_STAGE(PG8_SB(1, 1), b3 + hstep, voffB); PG8_STAGE(PG8_SA(1, 0), a3, voffA);
            PG8_WAIT_V(8); PG8_WAIT_L(0); PG8_BAR; PG8_MMA(1, 0, At, B0); PG8_MMA(1, 1, At, B1); PG8_BAR; PG8_SCHED;
            } else {
            PG8_LDB(B0, 0, 0); PG8_SCHED; PG8_LDA(At, 0, 0); PG8_STAGE(PG8_SA(1, 1), a1 + hstep, voffA);
            PG8_WAIT_L(8); PG8_BAR; PG8_WAIT_L(0); PG8_MMA(0, 0, At, B0); PG8_BAR; PG8_SCHED;
            PG8_LDB(B1, 0, 1); PG8_STAGE(PG8_SB(0, 0), b2, voffB);
            PG8_BAR; PG8_WAIT_L(0); PG8_MMA(0, 1, At, B1); PG8_BAR;
            PG8_LDA(At, 0, 1); PG8_STAGE(PG8_SA(0, 0), a2, voffA);
            PG8_BAR; PG8_WAIT_L(0); PG8_MMA(1, 0, At, B0); PG8_BAR; PG8_SCHED;
            PG8_STAGE(PG8_SB(0, 1), b2 + hstep, voffB);
            PG8_WAIT_V(6); PG8_BAR; PG8_MMA(1, 1, At, B1); PG8_BAR;
            PG8_LDB(B0, 1, 0); PG8_SCHED; PG8_LDA(At, 1, 0); PG8_STAGE(PG8_SA(0, 1), a2 + hstep, voffA);
            PG8_WAIT_L(8); PG8_BAR; PG8_WAIT_L(0); PG8_MMA(0, 0, At, B0); PG8_BAR; PG8_SCHED;
            PG8_LDB(B1, 1, 1); PG8_STAGE(PG8_SB(1, 0), b3, voffB);
            PG8_BAR; PG8_WAIT_L(0); PG8_MMA(0, 1, At, B1); PG8_BAR;
            PG8_LDA(At, 1, 1); PG8_STAGE(PG8_SA(1, 0), a3, voffA);
            PG8_BAR; PG8_WAIT_L(0); PG8_MMA(1, 0, At, B0); PG8_BAR; PG8_SCHED;
            PG8_STAGE(PG8_SB(1, 1), b3 + hstep, voffB);
            PG8_WAIT_V(6); PG8_BAR; PG8_MMA(1, 1, At, B1); PG8_BAR;
            }
        }
        if constexpr (ALIGN_EPI) { if (wr == 0) PG8_BAR; }
        E(acc, cur, wr, wc, fr, fq); S.done(cur);
        if (!has_next) break;
#pragma unroll
        for (int a = 0; a < 2; ++a)
#pragma unroll
            for (int b = 0; b < 2; ++b)
#pragma unroll
                for (int m = 0; m < 4; ++m)
#pragma unroll
                    for (int n = 0; n < 2; ++n) acc[a][b][m][n] = (f32x4){0.f, 0.f, 0.f, 0.f};
        cur = nxt; cA = nA; cB = nB; ++ui;
        if constexpr (ALIGN_EPI) { if (wr == 1) PG8_BAR; }
    }
    PG8_WAIT_V(0);
    if constexpr (!ALIGN_EPI) { if (wr == 0) PG8_BAR; }
    PG8_BAR;
#undef PG8_SA
#undef PG8_SB
#undef PG8_STAGE
#undef PG8_LDA
#undef PG8_LDB
#undef PG8_MMA
#undef PG8_WAIT_V
#undef PG8_WAIT_L
#undef PG8_BAR
#undef PG8_SCHED
}

typedef const f32x4 (&AccRef)[2][2][4][2];

struct EpiSwiGLU {
    static constexpr bool PERM = true;
    bf16_t* H;
    __device__ __forceinline__ void operator()(AccRef acc, const Unit& u, int wr, int wc, int fr, int fq) const {
        const int row0 = u.pm * BM + wr * 64 + fr, col0 = u.pn * 128 + wc * 32 + 8 * fq;
#pragma unroll
        for (int ai = 0; ai < 2; ++ai)
#pragma unroll
            for (int m = 0; m < 4; ++m) {
                float o[8];
#pragma unroll
                for (int n = 0; n < 2; ++n)
#pragma unroll
                    for (int j = 0; j < 4; ++j) { const float g = acc[ai][0][m][n][j], up = acc[ai][1][m][n][j]; o[4 * n + j] = g * fsigmoid(g) * up; }
                u32x4 w; w.x = pk_bf16(o[0], o[1]); w.y = pk_bf16(o[2], o[3]); w.z = pk_bf16(o[4], o[5]); w.w = pk_bf16(o[6], o[7]);
                *(u32x4*)(H + (size_t)(row0 + ai * HALF + m * 16) * FF + col0) = w;
            }
    }
};
struct EpiResid {
    static constexpr bool PERM = false;
    const float* src; float* dst; float alpha, beta;
    __device__ __forceinline__ void operator()(AccRef acc, const Unit& u, int wr, int wc, int fr, int fq) const {
        const int row0 = u.pm * BM + wr * 64 + fr, col0 = u.pn * BM + wc * 32 + 4 * fq;
#pragma unroll
        for (int ai = 0; ai < 2; ++ai)
#pragma unroll
            for (int m = 0; m < 4; ++m) { const size_t ro = (size_t)(row0 + ai * HALF + m * 16) * DM + col0;
#pragma unroll
                for (int bj = 0; bj < 2; ++bj)
#pragma unroll
                    for (int n = 0; n < 2; ++n) { const f32x4 xv = *(const f32x4*)(src + ro + bj * HALF + n * 16); *(f32x4*)(dst + ro + bj * HALF + n * 16) = xv * alpha + acc[ai][bj][m][n] * beta; } }
    }
};
struct EpiF32 {
    static constexpr bool PERM = false;
    float* C;
    __device__ __forceinline__ void operator()(AccRef acc, const Unit& u, int wr, int wc, int fr, int fq) const {
        const int row0 = u.pm * BM + wr * 64 + fr, col0 = u.pn * BM + wc * 32 + 4 * fq;
#pragma unroll
        for (int ai = 0; ai < 2; ++ai)
#pragma unroll
            for (int m = 0; m < 4; ++m) { const size_t ro = (size_t)(row0 + ai * HALF + m * 16) * DM + col0;
#pragma unroll
                for (int bj = 0; bj < 2; ++bj)
#pragma unroll
                    for (int n = 0; n < 2; ++n) *(f32x4*)(C + ro + bj * HALF + n * 16) = acc[ai][bj][m][n]; }
    }
};
struct EpiGate {
    static constexpr bool PERM = false;
    const float* src; float* dst; const float* E1; float alpha;
    __device__ __forceinline__ void operator()(AccRef acc, const Unit& u, int wr, int wc, int fr, int fq) const {
        const int row0 = u.pm * BM + wr * 64 + fr, col0 = u.pn * BM + wc * 32 + 4 * fq;
#pragma unroll
        for (int ai = 0; ai < 2; ++ai)
#pragma unroll
            for (int m = 0; m < 4; ++m) { const size_t ro = (size_t)(row0 + ai * HALF + m * 16) * DM + col0;
#pragma unroll
                for (int bj = 0; bj < 2; ++bj)
#pragma unroll
                    for (int n = 0; n < 2; ++n) { const size_t o = ro + bj * HALF + n * 16; const f32x4 xv = *(const f32x4*)(src + o), ev = *(const f32x4*)(E1 + o); const f32x4 a = acc[ai][bj][m][n];
                        f32x4 r; r.x = xv.x * alpha + ev.x * fsigmoid(a.x); r.y = xv.y * alpha + ev.y * fsigmoid(a.y); r.z = xv.z * alpha + ev.z * fsigmoid(a.z); r.w = xv.w * alpha + ev.w * fsigmoid(a.w);
                        *(f32x4*)(dst + o) = r; } }
    }
};
struct EpiVt {
    static constexpr bool PERM = false;
    bf16_t* VT;
    __device__ __forceinline__ void operator()(AccRef acc, const Unit& u, int wr, int wc, int fr, int fq) const {
        const int row0 = u.pm * BM + wr * 64 + fr, col0 = u.pn * BM + wc * 32 + 8 * (fq & 1) + 4 * (fq >> 1);
#pragma unroll
        for (int ai = 0; ai < 2; ++ai)
#pragma unroll
            for (int m = 0; m < 4; ++m) { bf16_t* rp = VT + (size_t)(row0 + ai * HALF + m * 16) * MTOK + col0;
#pragma unroll
                for (int bj = 0; bj < 2; ++bj)
#pragma unroll
                    for (int n = 0; n < 2; ++n) { const f32x4 a = acc[ai][bj][m][n]; u32x2 w; w.x = pk_bf16(a.x, a.y); w.y = pk_bf16(a.z, a.w); *(u32x2*)(rp + bj * HALF + n * 16) = w; } }
    }
};
struct EpiProj {
    static constexpr bool PERM = true;
    bf16_t* P; const float* rope128; const float* rope64;
    __device__ __forceinline__ void operator()(AccRef acc, const Unit& u, int wr, int wc, int fr, int fq) const {
        const int pn = u.pn, row0 = u.pm * BM + wr * 64 + fr;
        if (pn < 12) {
            const bool isdiff = pn < 6; const int pp = isdiff ? pn : pn - 6; const int g = pp / 3, tg = pp % 3;
            const float sc = (g == 0) ? (isdiff ? 0.125f * LOG2E : 0.08838834764831845f * LOG2E) : 1.f;
            int fbase, col1, half, rpitch; const float* rt0;
            if (isdiff) { fbase = 8 * fq; col1 = g * 768 + (tg * 4 + wc) * 64 + fbase; half = 32; rpitch = 64; rt0 = rope64; }
            else { fbase = 32 * (wc & 1) + 8 * fq; col1 = C_MQ + g * 768 + (tg * 2 + (wc >> 1)) * 128 + fbase; half = 64; rpitch = 128; rt0 = rope128; }
#pragma unroll
            for (int ai = 0; ai < 2; ++ai)
#pragma unroll
                for (int m = 0; m < 4; ++m) { const int row = row0 + ai * HALF + m * 16;
                    const f32x4* rt = (const f32x4*)(rt0 + (size_t)row * rpitch + 2 * fbase);
                    float o1[8], o2[8];
#pragma unroll
                    for (int q = 0; q < 4; ++q) { const f32x4 cs = rt[q];
#pragma unroll
                        for (int e = 0; e < 2; ++e) { const int idx = 2 * q + e; const float a = acc[ai][0][m][idx >> 2][idx & 3], b = acc[ai][1][m][idx >> 2][idx & 3];
                            const float c = e ? cs.z : cs.x, s = e ? cs.w : cs.y; o1[idx] = (a * c - b * s) * sc; o2[idx] = (b * c + a * s) * sc; } }
                    bf16_t* rp = P + (size_t)row * PROJW + col1;
                    u32x4 w; w.x = pk_bf16(o1[0], o1[1]); w.y = pk_bf16(o1[2], o1[3]); w.z = pk_bf16(o1[4], o1[5]); w.w = pk_bf16(o1[6], o1[7]); *(u32x4*)rp = w;
                    w.x = pk_bf16(o2[0], o2[1]); w.y = pk_bf16(o2[2], o2[3]); w.z = pk_bf16(o2[4], o2[5]); w.w = pk_bf16(o2[6], o2[7]); *(u32x4*)(rp + half) = w; }
        } else {
            const int col0 = C_GQ + (pn - 12) * 256 + wc * 32 + 8 * fq;
#pragma unroll
            for (int ai = 0; ai < 2; ++ai)
#pragma unroll
                for (int m = 0; m < 4; ++m) { bf16_t* rp = P + (size_t)(row0 + ai * HALF + m * 16) * PROJW + col0;
#pragma unroll
                    for (int bj = 0; bj < 2; ++bj) { const f32x4 v0 = acc[ai][bj][m][0], v1 = acc[ai][bj][m][1]; u32x4 w; w.x = pk_bf16(v0.x, v0.y); w.y = pk_bf16(v0.z, v0.w); w.z = pk_bf16(v1.x, v1.y); w.w = pk_bf16(v1.z, v1.w); *(u32x4*)(rp + bj * HALF) = w; } }
        }
    }
};
}

struct Args { const float* in[20]; float* out; unsigned char* ws; int ph_lo, ph_hi; int use_sync, pad; };

typedef const __attribute__((address_space(4))) Args* ArgsP;
struct Ctx { int tid, lane, wave, gw, NGW, G, bid; LAS unsigned char* lds; unsigned char* ws; };

__device__ __forceinline__ void transpose_item(const float* __restrict__ W, int ldw, int src_col0, bf16_t* WT, int K, int dst_row0, int k0, LAS float* scr, int lane) {
#pragma unroll 8
    for (int i = 0; i < 32; ++i) { const int kk = 2 * i + (lane >> 5); scr[kk * 33 + (lane & 31)] = W[(size_t)(k0 + kk) * ldw + src_col0 + (lane & 31)]; }
    LDS_WAIT();
    const int c = lane & 7;
#pragma unroll
    for (int j = 0; j < 4; ++j) { const int n = (lane >> 3) + 8 * j; const LAS float* s = scr + (8 * c) * 33 + n;
        u32x4 o; o.x = pk_bf16(s[0 * 33], s[1 * 33]); o.y = pk_bf16(s[2 * 33], s[3 * 33]); o.z = pk_bf16(s[4 * 33], s[5 * 33]); o.w = pk_bf16(s[6 * 33], s[7 * 33]);
        *(u32x4*)(WT + (size_t)(dst_row0 + n) * K + k0 + 8 * c) = o; }
    LDS_WAIT();
}
__device__ __forceinline__ int win_src_col(int gidx) {
    const int pn = gidx >> 3, w = gidx & 7;
    if (pn < 6) { const int g = pn / 3, tg = pn % 3, half = w >> 2, u = w & 3; return (g ? W_DK : W_DQ) + (tg * 4 + u) * 64 + half * 32; }
    if (pn < 12) { const int pp = pn - 6, g = pp / 3, tg = pp % 3, half = w >> 2, ww = w & 3; return (g ? W_MK : W_MQ) + (tg * 2 + (ww >> 1)) * 128 + half * 64 + (ww & 1) * 32; }
    if (pn == 12) return W_GQ + 32 * w;
    if (pn == 13) return W_GK + 32 * w;
    return W_GR + (pn - 14) * 256 + 32 * w;
}
__device__ __forceinline__ void prologue(ArgsP a, const Ctx& c) {
    LAS float* scr = (LAS float*)(c.lds + c.wave * 16384);
    constexpr int I_GU = 32 * 352, I_D = 88 * 64, I_IN = 32 * 128, I_SQ = 32 * 64, I_PE = 4 * 64;
    constexpr int PER_LAYER = 2 * I_GU + 2 * I_D + I_IN + 3 * I_SQ + I_PE;
    for (int it = c.gw; it < 2 * PER_LAYER; it += c.NGW) {
        const int l = it / PER_LAYER; int r = it - l * PER_LAYER;
        unsigned char* wl = c.ws + WS_W + (size_t)l * WL_SIZE;
        if (r < 2 * I_GU) {
            const int second = r >= I_GU; if (second) r -= I_GU;
            const int kb = r / 352, gidx = r % 352, pn = gidx >> 3, w = gidx & 7;
            const float* src = a->in[(second ? 13 : 10) + (w >> 2)] + (size_t)l * DM * FF;
            transpose_item(src, FF, 128 * pn + 32 * (w & 3), (bf16_t*)(wl + (second ? WL_GU2 : WL_GU1)), DM, 32 * gidx, 64 * kb, scr, c.lane); continue; }
        r -= 2 * I_GU;
        if (r < 2 * I_D) { const int second = r >= I_D; if (second) r -= I_D; const int kb = r / 64, nb = r % 64;
            transpose_item(a->in[second ? 15 : 12] + (size_t)l * FF * DM, DM, 32 * nb, (bf16_t*)(wl + (second ? WL_D2 : WL_D1)), FF, 32 * nb, 64 * kb, scr, c.lane); continue; }
        r -= 2 * I_D;
        if (r < I_IN) { const int kb = r / 128, gidx = r % 128;
            transpose_item(a->in[3] + (size_t)l * DM * DIN, DIN, win_src_col(gidx), (bf16_t*)(wl + WL_IN), DM, 32 * gidx, 64 * kb, scr, c.lane); continue; }
        r -= I_IN;
        if (r < I_SQ) { const int kb = r / 64, nb = r % 64, row0 = 32 * nb; const int sc = row0 < 768 ? W_DV + row0 : (row0 < 1280 ? W_GV + (row0 - 768) : W_MV + (row0 - 1280));
            transpose_item(a->in[3] + (size_t)l * DM * DIN, DIN, sc, (bf16_t*)(wl + WL_V), DM, row0, 64 * kb, scr, c.lane); continue; }
        r -= I_SQ;
        if (r < I_SQ) { const int kb = r / 64, nb = r % 64; transpose_item(a->in[4] + (size_t)l * DM * DM, DM, 32 * nb, (bf16_t*)(wl + WL_OUT), DM, 32 * nb, 64 * kb, scr, c.lane); continue; }
        r -= I_SQ;
        if (r < I_SQ) { const int kb = r / 64, nb = r % 64; transpose_item(a->in[17] + (size_t)l * DM * DM, DM, 32 * nb, (bf16_t*)(wl + WL_PG), DM, 32 * nb, 64 * kb, scr, c.lane); continue; }
        r -= I_SQ;
        { const int kb = r / 64, nb = r % 64; transpose_item(a->in[16] + (size_t)l * PLE * DM, DM, 32 * nb, (bf16_t*)(wl + WL_PE), PLE, 32 * nb, 64 * kb, scr, c.lane); }
    }
    { const float* x = a->in[0]; bf16_t* xb = (bf16_t*)(c.ws + WS_XB);
      for (int m = c.gw; m < MTOK; m += c.NGW) { const f32x4* xr = (const f32x4*)(x + (size_t)m * DM) + c.lane; u32x2* o = (u32x2*)(xb + (size_t)m * DM) + c.lane;
#pragma unroll
          for (int j = 0; j < 8; ++j) { const f32x4 v = xr[64 * j]; u32x2 w; w.x = pk_bf16(v.x, v.y); w.y = pk_bf16(v.z, v.w); o[64 * j] = w; } } }
    { const float* p = a->in[1]; bf16_t* pb = (bf16_t*)(c.ws + WS_PB);
      for (int m = c.gw; m < 2 * MTOK; m += c.NGW) { const f32x4 v = *((const f32x4*)(p + (size_t)m * PLE) + c.lane); u32x2 w; w.x = pk_bf16(v.x, v.y); w.y = pk_bf16(v.z, v.w); *((u32x2*)(pb + (size_t)m * PLE) + c.lane) = w; } }
    { const int* pos = (const int*)a->in[2]; float* r128 = (float*)(c.ws + WS_R128); float* r64 = (float*)(c.ws + WS_R64);
      const int gt = c.gw * 64 + c.lane, NT = c.NGW * 64;
      for (int idx = gt; idx < MTOK * 64; idx += NT) { const int m = idx >> 6, f = idx & 63;
          const float inv = exp2f(-(float)f * (13.287712379549449f / 64.f));
          const float ang = (float)pos[m] * inv;
          const double rev = (double)ang * 0.15915494309189535; const float fr = (float)(rev - rint(rev));
          const float cv = __builtin_amdgcn_cosf(fr), sv = __builtin_amdgcn_sinf(fr);
          r128[2 * idx] = cv; r128[2 * idx + 1] = sv;
          if ((f & 1) == 0) { const int i2 = m * 32 + (f >> 1); r64[2 * i2] = cv; r64[2 * i2 + 1] = sv; } } }
    { const int gt = c.gw * 64 + c.lane, NT = c.NGW * 64;
      for (int idx = gt; idx < 2 * 16 * DM; idx += NT) { const int l = idx / (16 * DM), rr = (idx / DM) & 15, k = idx % DM;
          ((bf16_t*)(c.ws + WS_W + (size_t)l * WL_SIZE + WL_GG))[rr * DM + k] = (bf16_t)(pk_bf16(a->in[3][(size_t)l * DM * DIN + (size_t)k * DIN + W_GG + rr], 0.f) & 0xffffu); } }
}

__device__ __forceinline__ void ln_phase(const Ctx& c, const float* z, float* xo, bf16_t* xbo, const float* g, const float* b) {
    for (int m = c.gw; m < MTOK; m += c.NGW) {
        const f32x4* zr = (const f32x4*)(z + (size_t)m * DM) + c.lane;
        f32x4 v[8]; float s = 0.f;
#pragma unroll
        for (int j = 0; j < 8; ++j) { v[j] = zr[64 * j]; s += (v[j].x + v[j].y) + (v[j].z + v[j].w); }
        const float mean = wave_sum(s) * (1.f / DM); float s2 = 0.f;
#pragma unroll
        for (int j = 0; j < 8; ++j) { v[j] = v[j] - mean; s2 += (v[j].x * v[j].x + v[j].y * v[j].y) + (v[j].z * v[j].z + v[j].w * v[j].w); }
        const float rstd = 1.f / sqrtf(wave_sum(s2) * (1.f / DM) + LN_EPS);
        f32x4* xr = (f32x4*)(xo + (size_t)m * DM) + c.lane;
#pragma unroll
        for (int j = 0; j < 8; ++j) { const f32x4 gv = ((const f32x4*)g)[c.lane + 64 * j], bv = ((const f32x4*)b)[c.lane + 64 * j]; const f32x4 o = v[j] * rstd * gv + bv; xr[64 * j] = o;
            if (xbo) { u32x2 w; w.x = pk_bf16(o.x, o.y); w.y = pk_bf16(o.z, o.w); ((u32x2*)(xbo + (size_t)m * DM) + c.lane)[64 * j] = w; } }
    }
}

__device__ __forceinline__ void gg_phase(const Ctx& c, const bf16_t* xb, const bf16_t* wgg, float* gg) {
    const int row = c.lane & 15, quad = c.lane >> 4;
    for (int t = c.gw; t < MTOK / 16; t += c.NGW) {
        f32x4 acc = {0.f, 0.f, 0.f, 0.f};
        const bf16_t* ap = xb + (size_t)(t * 16 + row) * DM + quad * 8; const bf16_t* bp = wgg + (size_t)row * DM + quad * 8;
#pragma unroll 8
        for (int k0 = 0; k0 < DM; k0 += 32) { const bf16x8 av = *(const bf16x8*)(ap + k0), bv = *(const bf16x8*)(bp + k0); acc = __builtin_amdgcn_mfma_f32_16x16x32_bf16(av, bv, acc, 0, 0, 0); }
#pragma unroll
        for (int j = 0; j < 4; ++j) gg[(size_t)(t * 16 + quad * 4 + j) * 16 + row] = acc[j];
    }
}

__device__ __forceinline__ int perm23(int t) { return (t & ~12) | ((t & 4) << 1) | ((t & 8) >> 1); }
__device__ __forceinline__ void post_phase(const Ctx& c, ArgsP a, int l) {
    const bf16_t* proj = (const bf16_t*)(c.ws + WS_PROJ); const float* gg = (const float*)(c.ws + WS_GG);
    bf16_t* QT = (bf16_t*)(c.ws + WS_QT); bf16_t* QTP = (bf16_t*)(c.ws + WS_QTP); bf16_t* KT = (bf16_t*)(c.ws + WS_KT); bf16_t* KTT = (bf16_t*)(c.ws + WS_KTT);
    float* EL = (float*)(c.ws + WS_EL); bf16_t* KM = (bf16_t*)(c.ws + WS_KM);
    const float* gate_up = a->in[7] + (size_t)l * 16 * 256; const float* gate_b = a->in[8] + (size_t)l * 256;
    for (int task = c.gw; task < 512 + 192; task += c.NGW) {
        if (task < 512) {
            const int bh = task >> 5, ch = task & 31, b = bh >> 2, hh = bh & 3, k = c.lane;
            float up[16];
#pragma unroll
            for (int r = 0; r < 16; ++r) up[r] = gate_up[r * 256 + hh * 64 + k];
            const float bias = gate_b[hh * 64 + k];
            float cum = 0.f;
            const int tok0 = b * SEQ + ch * 64; const size_t rb = (size_t)bh * SEQ + ch * 64;
            const int kp = (k & ~31) | perm23(k & 31);
            for (int t8 = 0; t8 < 8; ++t8) {
                unsigned kk[8];
#pragma unroll
                for (int tt = 0; tt < 8; ++tt) { const int t = t8 * 8 + tt; const int tok = tok0 + t;
                    const f32x4* gp = (const f32x4*)(gg + (size_t)tok * 16);
                    float pre = bias;
#pragma unroll
                    for (int q = 0; q < 4; ++q) { const f32x4 gv = gp[q]; pre += gv.x * up[4 * q] + gv.y * up[4 * q + 1] + gv.z * up[4 * q + 2] + gv.w * up[4 * q + 3]; }
                    const float ls = fminf(pre, 0.f) - log1pf(expf(-fabsf(pre)));
                    cum += ls * (1.f / 16.f);
                    const float qv = bf2f(proj[(size_t)tok * PROJW + C_GQ + hh * 64 + k]), kv = bf2f(proj[(size_t)tok * PROJW + C_GK + hh * 64 + k]);
                    const float qt = qv * expf(cum) * 0.125f, kt = kv * expf(-cum);
                    const bf16_t qb = (bf16_t)(pk_bf16(qt, 0.f) & 0xffffu), kb = (bf16_t)(pk_bf16(kt, 0.f) & 0xffffu);
                    QT[(rb + t) * 64 + k] = qb; QTP[(rb + t) * 64 + kp] = qb; KT[(rb + t) * 64 + k] = kb; kk[tt] = kb; }
                bf16_t* dst = KTT + ((size_t)(bh * 32 + ch) * 64 + k) * 64 + (t8 >> 2) * 32;
                const int t8l = t8 & 3;
                u32x2 w0, w1; w0.x = kk[0] | (kk[1] << 16); w0.y = kk[2] | (kk[3] << 16); w1.x = kk[4] | (kk[5] << 16); w1.y = kk[6] | (kk[7] << 16);
                *(u32x2*)(dst + (t8l >> 1) * 16 + 0 * 8 + (t8l & 1) * 4) = w0;
                *(u32x2*)(dst + (t8l >> 1) * 16 + 1 * 8 + (t8l & 1) * 4) = w1;
            }
            EL[(size_t)(bh * 32 + ch) * 64 + k] = expf(cum);
        } else {
            const int t2 = task - 512, b = t2 / 48, hd = (t2 / 8) % 6, blk = t2 & 7;
            const bf16_t* kp = proj + (size_t)(b * SEQ + blk * 256) * PROJW + C_MK + hd * 128 + 2 * c.lane;
            float s0 = 0.f, s1 = 0.f;
#pragma unroll 8
            for (int t = 0; t < 256; ++t) { const unsigned w = *(const unsigned*)(kp + (size_t)t * PROJW); s0 += bflo(w); s1 += bfhi(w); }
            *(unsigned*)(KM + (size_t)((b * 6 + hd) * 8 + blk) * 128 + 2 * c.lane) = pk_bf16(s0 * (1.f / 256.f), s1 * (1.f / 256.f));
        }
    }
}

template <int DQ, bool QLDS>
__device__ __forceinline__ void attn_pass(const bf16_t* qrow  , const bf16_t* kbase  , const bf16_t* vbase  ,
                                          int qt, int own, unsigned selmask, int r, int h, f32x16 (&O)[4], LAS unsigned char* wlds  ) {
    constexpr int NKS = DQ / 16;
    bf16x8 qf[QLDS ? 1 : NKS];
    if constexpr (QLDS) {
#pragma unroll
        for (int ks = 0; ks < NKS; ++ks) *(LAS bf16x8*)(wlds + ks * 1024) = *(const bf16x8*)(qrow + 16 * ks);
    } else {
#pragma unroll
        for (int ks = 0; ks < NKS; ++ks) qf[ks] = *(const bf16x8*)(qrow + 16 * ks);
    }
#pragma unroll
    for (int t = 0; t < 4; ++t)
#pragma unroll
        for (int i = 0; i < 16; ++i) O[t][i] = 0.f;
    unsigned bmask = 0u;
    for (int n = 0; n < own; ++n) if (__ballot((selmask >> n) & 1u) != 0ull) bmask |= 1u << n;
    bmask |= 0xffffff00u | (0xffu & ~((1u << own) - 1u));
    bmask = (unsigned)__builtin_amdgcn_readfirstlane((int)bmask);
    float m = NEG_BIG, l = 0.f;
    int kt = 8 * __builtin_ctz(bmask);
    bf16x8 kf[NKS];
    { const bf16_t* kp = kbase + (size_t)(kt * 32) * PROJW;
#pragma unroll
      for (int ks = 0; ks < NKS; ++ks) kf[ks] = *(const bf16x8*)(kp + 16 * ks); }
    while (kt <= qt) {
        int nk = kt + 1;
        if ((nk & 7) == 0) { const unsigned rem = bmask >> (nk >> 3); nk += 8 * __builtin_ctz(rem); }
        const int n = kt >> 3;
        const bool vis = (n >= own) || ((selmask >> n) & 1u);
        bf16x8 vf[8];
        const bf16_t* vp = vbase + kt * 32;
#pragma unroll
        for (int t = 0; t < 4; ++t) { vf[2 * t] = *(const bf16x8*)(vp + (size_t)(32 * t) * MTOK); vf[2 * t + 1] = *(const bf16x8*)(vp + (size_t)(32 * t) * MTOK + 16); }
        __builtin_amdgcn_sched_barrier(0);
        f32x16 s;
#pragma unroll
        for (int i = 0; i < 16; ++i) s[i] = 0.f;
        if constexpr (QLDS) {
            LAS unsigned char* ql = wlds; asm volatile("" : "+v"(ql));
#pragma unroll
            for (int ks = 0; ks < NKS; ++ks) { const bf16x8 qq = *(const LAS bf16x8*)(ql + ks * 1024); s = MFMA32(kf[ks], qq, s); }
        } else {
#pragma unroll
            for (int ks = 0; ks < NKS; ++ks) s = MFMA32(kf[ks], qf[ks], s);
        }
        __builtin_amdgcn_sched_barrier(0);
        { const int pk = nk <= qt ? nk : qt; const bf16_t* kp = kbase + (size_t)(pk * 32) * PROJW;
#pragma unroll
          for (int ks = 0; ks < NKS; ++ks) kf[ks] = *(const bf16x8*)(kp + 16 * ks); }
        __builtin_amdgcn_sched_barrier(0);
        if (kt == qt) {
#pragma unroll
            for (int i = 0; i < 16; ++i) if (crow(i, h) > r) s[i] = NEG_BIG;
        }
        if (!vis) {
#pragma unroll
            for (int i = 0; i < 16; ++i) s[i] = NEG_BIG;
        }
        float mx = s[0];
#pragma unroll
        for (int i = 1; i < 16; ++i) mx = fmaxf(mx, s[i]);
        mx = fmaxf(mx, __shfl_xor(mx, 32));
        if (__ballot(mx > m + 8.f) != 0ull) {
            const float mn = fmaxf(m, mx), alpha = fexp2(m - mn); m = mn; l *= alpha;
#pragma unroll
            for (int t = 0; t < 4; ++t) O[t] = O[t] * alpha;
        }
        float ls = 0.f;
#pragma unroll
        for (int i = 0; i < 16; ++i) { s[i] = fexp2(s[i] - m); ls += s[i]; }
        l += ls;
        const bf16x8 p0 = pack8(s, 0), p1 = pack8(s, 1);
#pragma unroll
        for (int t = 0; t < 4; ++t) { O[t] = MFMA32(vf[2 * t], p0, O[t]); O[t] = MFMA32(vf[2 * t + 1], p1, O[t]); }
        kt = nk;
    }
    l += __shfl_xor(l, 32);
    const float inv = 1.f / l;
#pragma unroll
    for (int t = 0; t < 4; ++t) O[t] = O[t] * inv;
}

__device__ __forceinline__ void store_o(bf16_t* orow  , const f32x16 (&O)[4]) {
#pragma unroll
    for (int t = 0; t < 4; ++t)
#pragma unroll
        for (int q = 0; q < 4; ++q) { u32x2 w; w.x = pk_bf16(O[t][4 * q], O[t][4 * q + 1]); w.y = pk_bf16(O[t][4 * q + 2], O[t][4 * q + 3]); *(u32x2*)(orow + 32 * t + 8 * q) = w; }
}

__device__ __forceinline__ void diff_task(const Ctx& c, ArgsP a, int l, int bh, int qt) {
    const int b = bh / 6, hd = bh % 6, r = c.lane & 31, h = c.lane >> 5;
    const bf16_t* proj = (const bf16_t*)(c.ws + WS_PROJ); const bf16_t* VT = (const bf16_t*)(c.ws + WS_VT); bf16_t* mix = (bf16_t*)(c.ws + WS_MIX);
    const float* lf = a->in[5] + (size_t)l * 256;
    const float d1 = wave_sum(lf[c.lane] * lf[64 + c.lane]), d2 = wave_sum(lf[128 + c.lane] * lf[192 + c.lane]);
    const float lam_init = 0.8f - 0.6f * expf(-0.3f * (float)l);
    const float lam = expf(d1) - expf(d2) + lam_init;
    const size_t tokq = (size_t)b * SEQ + qt * 32 + r;
    const bf16_t* kb = proj + ((size_t)b * SEQ + r) * PROJW + C_DK + hd * 128 + 8 * h;
    const bf16_t* vb = VT + (size_t)(hd * 128 + r) * MTOK + (size_t)b * SEQ + 8 * h;
    f32x16 O1[4];
    LAS unsigned char* wl = c.lds + c.wave * 16384 + c.lane * 16;
    {
        f32x16 O2[4];
        attn_pass<64, false>(proj + tokq * PROJW + C_DQ + hd * 128 + 64 + 8 * h, kb + 64, vb, qt, 0, 0u, r, h, O2, wl);
#pragma unroll
        for (int t = 0; t < 4; ++t)
#pragma unroll
            for (int q = 0; q < 4; ++q) { f32x4 v; v.x = O2[t][4 * q]; v.y = O2[t][4 * q + 1]; v.z = O2[t][4 * q + 2]; v.w = O2[t][4 * q + 3]; *(LAS f32x4*)(wl + (t * 4 + q) * 1024) = v; }
    }
    attn_pass<64, false>(proj + tokq * PROJW + C_DQ + hd * 128 + 8 * h, kb, vb, qt, 0, 0u, r, h, O1, wl);
    float ss = 0.f;
#pragma unroll
    for (int t = 0; t < 4; ++t)
#pragma unroll
        for (int q = 0; q < 4; ++q) { const f32x4 o2 = *(const LAS f32x4*)(wl + (t * 4 + q) * 1024);
            float v;
            v = O1[t][4 * q] - lam * o2.x; O1[t][4 * q] = v; ss += v * v;
            v = O1[t][4 * q + 1] - lam * o2.y; O1[t][4 * q + 1] = v; ss += v * v;
            v = O1[t][4 * q + 2] - lam * o2.z; O1[t][4 * q + 2] = v; ss += v * v;
            v = O1[t][4 * q + 3] - lam * o2.w; O1[t][4 * q + 3] = v; ss += v * v; }
    ss += __shfl_xor(ss, 32);
    const float rs = (1.f - lam_init) / sqrtf(ss * (1.f / 128.f) + LN_EPS);
    const float* gn = a->in[6] + (size_t)l * 128 + 4 * h;
#pragma unroll
    for (int t = 0; t < 4; ++t)
#pragma unroll
        for (int q = 0; q < 4; ++q) { const f32x4 gv = *(const f32x4*)(gn + 32 * t + 8 * q);
            O1[t][4 * q] *= rs * gv.x; O1[t][4 * q + 1] *= rs * gv.y; O1[t][4 * q + 2] *= rs * gv.z; O1[t][4 * q + 3] *= rs * gv.w; }
    store_o(mix + tokq * DM + hd * 128 + 4 * h, O1);
}

__device__ __forceinline__ void moba_task(const Ctx& c, int bh, int qt) {
    const int b = bh / 6, hd = bh % 6, r = c.lane & 31, h = c.lane >> 5;
    const bf16_t* proj = (const bf16_t*)(c.ws + WS_PROJ); const bf16_t* VT = (const bf16_t*)(c.ws + WS_VT); bf16_t* mix = (bf16_t*)(c.ws + WS_MIX);
    const bf16_t* KM = (const bf16_t*)(c.ws + WS_KM) + (size_t)(b * 6 + hd) * 8 * 128;
    const size_t tokq = (size_t)b * SEQ + qt * 32 + r;
    const bf16_t* qrow = proj + tokq * PROJW + C_MQ + hd * 128 + 8 * h;
    const int own = qt >> 3;
    unsigned selmask = 0u;
    if (own > 3) {
        f32x16 g;
#pragma unroll
        for (int i = 0; i < 16; ++i) g[i] = 0.f;
#pragma unroll
        for (int ks = 0; ks < 8; ++ks) { bf16x8 kf = {0, 0, 0, 0, 0, 0, 0, 0}; if (r < 8) kf = *(const bf16x8*)(KM + r * 128 + 16 * ks + 8 * h);
            const bf16x8 qf = *(const bf16x8*)(qrow + 16 * ks); g = MFMA32(kf, qf, g); }
        float gate[8];
#pragma unroll
        for (int i = 0; i < 4; ++i) { const float mine = g[i], other = __shfl_xor(mine, 32); gate[i] = h ? other : mine; gate[4 + i] = h ? mine : other; }
#pragma unroll
        for (int n = 0; n < 8; ++n) { int rank = 0;
#pragma unroll
            for (int mm = 0; mm < 8; ++mm) { if (mm == n) continue; const bool ahead = (gate[mm] > gate[n]) || (gate[mm] == gate[n] && mm < n); rank += (mm < own && ahead) ? 1 : 0; }
            if (n < own && rank < 3) selmask |= 1u << n; }
    } else selmask = 0xffu;
    f32x16 O[4];
    attn_pass<128, true>(qrow, proj + ((size_t)b * SEQ + r) * PROJW + C_MK + hd * 128 + 8 * h, VT + (size_t)(1280 + hd * 128 + r) * MTOK + (size_t)b * SEQ + 8 * h, qt, own, selmask, r, h, O, c.lds + c.wave * 16384 + c.lane * 16);
    store_o(mix + tokq * DM + 1280 + hd * 128 + 4 * h, O);
}

__device__ __forceinline__ void gla_chain(const Ctx& c, ArgsP a, int l, int g) {
    const int r = c.lane & 31, h = c.lane >> 5, hw = c.wave >> 2, sl = c.wave & 3;
    const int bh = 2 * g + hw, b = bh >> 2, hh = bh & 3;
    const bf16_t* QT = (const bf16_t*)(c.ws + WS_QT) + (size_t)bh * SEQ * 64; const bf16_t* QTP = (const bf16_t*)(c.ws + WS_QTP) + (size_t)bh * SEQ * 64;
    const bf16_t* KT = (const bf16_t*)(c.ws + WS_KT) + (size_t)bh * SEQ * 64; const bf16_t* KTT = (const bf16_t*)(c.ws + WS_KTT) + (size_t)bh * 32 * 4096;
    const float* EL = (const float*)(c.ws + WS_EL) + (size_t)bh * 32 * 64;
    const bf16_t* VT = (const bf16_t*)(c.ws + WS_VT) + (size_t)(768 + hh * 128 + sl * 32 + r) * MTOK + (size_t)b * SEQ + 8 * h;
    const bf16_t* proj = (const bf16_t*)(c.ws + WS_PROJ); bf16_t* mix = (bf16_t*)(c.ws + WS_MIX);
    const float* gn = a->in[9] + (size_t)l * 128;
    LAS float* obuf = (LAS float*)c.lds;
    f32x16 S0, S1;
#pragma unroll
    for (int i = 0; i < 16; ++i) { S0[i] = 0.f; S1[i] = 0.f; }
    for (int ch = 0; ch < 32; ++ch) {
        const size_t t0 = (size_t)ch * 64;
        f32x16 x00, x01, x11, acc0, acc1;
#pragma unroll
        for (int i = 0; i < 16; ++i) { x00[i] = 0.f; x01[i] = 0.f; x11[i] = 0.f; acc0[i] = 0.f; acc1[i] = 0.f; }
#pragma unroll
        for (int ks = 0; ks < 4; ++ks) {
            const bf16x8 k0 = *(const bf16x8*)(KT + (t0 + r) * 64 + 16 * ks + 8 * h), k1 = *(const bf16x8*)(KT + (t0 + 32 + r) * 64 + 16 * ks + 8 * h);
            const bf16x8 q0 = *(const bf16x8*)(QT + (t0 + r) * 64 + 16 * ks + 8 * h), q1 = *(const bf16x8*)(QT + (t0 + 32 + r) * 64 + 16 * ks + 8 * h);
            x00 = MFMA32(k0, q0, x00); x01 = MFMA32(k0, q1, x01); x11 = MFMA32(k1, q1, x11);
        }
#pragma unroll
        for (int i = 0; i < 16; ++i) if (crow(i, h) > r) { x00[i] = 0.f; x11[i] = 0.f; }
        bf16x8 vb[4];
#pragma unroll
        for (int ts = 0; ts < 4; ++ts) vb[ts] = *(const bf16x8*)(VT + t0 + 16 * ts);
        acc0 = MFMA32(pack8(x00, 0), vb[0], acc0); acc0 = MFMA32(pack8(x00, 1), vb[1], acc0);
        acc1 = MFMA32(pack8(x01, 0), vb[0], acc1); acc1 = MFMA32(pack8(x01, 1), vb[1], acc1);
        acc1 = MFMA32(pack8(x11, 0), vb[2], acc1); acc1 = MFMA32(pack8(x11, 1), vb[3], acc1);
#pragma unroll
        for (int s = 0; s < 2; ++s) {
            const bf16x8 sb0 = pack8(S0, s), sb1 = pack8(S1, s);
            const bf16x8 qa00 = *(const bf16x8*)(QTP + (t0 + r) * 64 + 16 * s + 8 * h), qa01 = *(const bf16x8*)(QTP + (t0 + r) * 64 + 32 + 16 * s + 8 * h);
            const bf16x8 qa10 = *(const bf16x8*)(QTP + (t0 + 32 + r) * 64 + 16 * s + 8 * h), qa11 = *(const bf16x8*)(QTP + (t0 + 32 + r) * 64 + 32 + 16 * s + 8 * h);
            acc0 = MFMA32(qa00, sb0, acc0); acc0 = MFMA32(qa01, sb1, acc0);
            acc1 = MFMA32(qa10, sb0, acc1); acc1 = MFMA32(qa11, sb1, acc1);
        }
        const bf16_t* ktt = KTT + (size_t)ch * 4096;
#pragma unroll
        for (int ts = 0; ts < 4; ++ts) {
            const bf16x8 ka0 = *(const bf16x8*)(ktt + (size_t)r * 64 + 16 * ts + 8 * h), ka1 = *(const bf16x8*)(ktt + (size_t)(32 + r) * 64 + 16 * ts + 8 * h);
            S0 = MFMA32(ka0, vb[ts], S0); S1 = MFMA32(ka1, vb[ts], S1);
        }
        const float* el = EL + (size_t)ch * 64 + 4 * h;
#pragma unroll
        for (int q = 0; q < 4; ++q) { const f32x4 e0 = *(const f32x4*)(el + 8 * q), e1 = *(const f32x4*)(el + 32 + 8 * q);
            S0[4 * q] *= e0.x; S0[4 * q + 1] *= e0.y; S0[4 * q + 2] *= e0.z; S0[4 * q + 3] *= e0.w;
            S1[4 * q] *= e1.x; S1[4 * q + 1] *= e1.y; S1[4 * q + 2] *= e1.z; S1[4 * q + 3] *= e1.w; }
        __syncthreads();
        LAS float* ob = obuf + hw * 64 * 132 + sl * 32 + r;
#pragma unroll
        for (int i = 0; i < 16; ++i) { ob[crow(i, h) * 132] = acc0[i]; ob[(32 + crow(i, h)) * 132] = acc1[i]; }
        __syncthreads();
        for (int rr = 0; rr < 16; ++rr) {
            const int row = c.wave * 16 + rr, hd2 = row >> 6, i = row & 63;
            const int bh2 = 2 * g + hd2, b2 = bh2 >> 2, hh2 = bh2 & 3;
            const f32x2 v = *(const LAS f32x2*)(obuf + hd2 * 64 * 132 + i * 132 + 2 * c.lane);
            const float ss = wave_sum(v.x * v.x + v.y * v.y);
            const float rs = 1.f / sqrtf(ss * (1.f / 128.f) + LN_EPS);
            const size_t tok = (size_t)b2 * SEQ + t0 + i;
            const unsigned gw = *(const unsigned*)(proj + tok * PROJW + C_GR + hh2 * 128 + 2 * c.lane);
            const float g0 = bflo(gw), g1 = bfhi(gw);
            const f32x2 gv = *(const f32x2*)(gn + 2 * c.lane);
            const float o0 = v.x * rs * gv.x * (g0 * fsigmoid(g0)), o1 = v.y * rs * gv.y * (g1 * fsigmoid(g1));
            *(unsigned*)(mix + tok * DM + 768 + hh2 * 128 + 2 * c.lane) = pk_bf16(o0, o1);
        }
    }
    __syncthreads();
}

__device__ __forceinline__ void attn_phase(const Ctx& c, ArgsP a, int l) {
    if (c.bid < 8) gla_chain(c, a, l, c.bid);
    unsigned* ctr = (unsigned*)(c.ws + WS_CTL) + 64 * (1 + l);
    for (;;) {
        int t = 0;
        if (c.lane == 0) t = (int)atomicAdd(ctr, 1u);
        t = __builtin_amdgcn_readfirstlane(t);
        if (t >= 3072) break;
        const int qt = 63 - t / 48, rem = t % 48;
        if (rem < 24) diff_task(c, a, l, rem, qt); else moba_task(c, rem - 24, qt);
    }
}

__global__ void __launch_bounds__(NTHREADS, 2) fwd_megakernel(Args args) {
    extern __shared__ __attribute__((aligned(16))) unsigned char lds_raw[];
    cg::grid_group grid = cg::this_grid();
    ArgsP ap0 = (ArgsP)__builtin_amdgcn_kernarg_segment_ptr();
    const int ph_lo = ap0->ph_lo, ph_hi = ap0->ph_hi, use_sync = ap0->use_sync;
    for (int ph = ph_lo; ph < ph_hi; ++ph) {
        if (ph > ph_lo && use_sync) grid.sync();
        ArgsP ap = ap0; asm volatile("" : "+s"(ap));
        int tid_ = threadIdx.x; asm volatile("" : "+v"(tid_));
        unsigned char* ws = ap->ws;
        int bid_ = blockIdx.x, G_ = gridDim.x; asm volatile("" : "+s"(bid_), "+s"(G_));
        Ctx c; c.tid = tid_; c.lane = c.tid & 63; c.wave = __builtin_amdgcn_readfirstlane(c.tid >> 6); c.G = G_; c.bid = bid_;
        c.gw = c.bid * NWAVES + c.wave; c.NGW = c.G * NWAVES; c.lds = (LAS unsigned char*)lds_raw; c.ws = ws;
        float* X = (float*)(ws + WS_X); bf16_t* XB = (bf16_t*)(ws + WS_XB); bf16_t* HB = (bf16_t*)(ws + WS_H); float* E1 = (float*)(ws + WS_H);
        bf16_t* PROJ = (bf16_t*)(ws + WS_PROJ); bf16_t* VT = (bf16_t*)(ws + WS_VT); bf16_t* MIX = (bf16_t*)(ws + WS_MIX);
        if (ph == 0) { prologue(ap, c); continue; }
        const int l = (ph - 1) / 13, s = (ph - 1) % 13;
        unsigned char* wl = ws + WS_W + (size_t)l * WL_SIZE;
        const float* lng = ap->in[18] + (size_t)l * 4 * DM; const float* lnb = ap->in[19] + (size_t)l * 4 * DM;
        const float* xsrc = (l == 0 && s <= 1) ? ap->in[0] : X;
        if (s == 0 || s == 8) {
            pg8::Gemm g{XB, (const bf16_t*)(wl + (s == 0 ? WL_GU1 : WL_GU2)), MTOK, 2 * FF, DM}; pg8::StaticOrder S; S.init(MTOK, 2 * FF, c.G, c.bid);
            pg8::EpiSwiGLU E{HB};
            pg8::gemm_phase<pg8::EpiSwiGLU, pg8::StaticOrder, true, true>(c.lds, g, S, E, c.tid);
        } else if (s == 1 || s == 9) {
            pg8::Gemm g{HB, (const bf16_t*)(wl + (s == 1 ? WL_D1 : WL_D2)), MTOK, DM, FF}; pg8::StaticOrder S; S.init(MTOK, DM, c.G, c.bid);
            pg8::EpiResid E{xsrc, X, ALPHA, 0.5f};
            pg8::gemm_phase<pg8::EpiResid, pg8::StaticOrder, false, true>(c.lds, g, S, E, c.tid);
        } else if (s == 2 || s == 7 || s == 10 || s == 12) {
            const int which = (s == 2) ? 0 : (s == 7) ? 1 : (s == 10) ? 2 : 3;
            const bool final_ln = (l == DEPTH - 1 && s == 12);
            ln_phase(c, X, final_ln ? ap->out : X, final_ln ? nullptr : XB, lng + which * DM, lnb + which * DM);
        } else if (s == 3) {
            { pg8::Gemm g{XB, (const bf16_t*)(wl + WL_IN), MTOK, PROJW, DM}; pg8::StaticOrder S; S.init(MTOK, PROJW, c.G, c.bid);
              pg8::EpiProj E{PROJ, (const float*)(ws + WS_R128), (const float*)(ws + WS_R64)};
              pg8::gemm_phase<pg8::EpiProj, pg8::StaticOrder, true, true>(c.lds, g, S, E, c.tid); }
            { pg8::Gemm g{(const bf16_t*)(wl + WL_V), XB, DM, MTOK, DM}; pg8::StaticOrder S; S.init(DM, MTOK, c.G, c.bid);
              pg8::EpiVt E{VT};
              pg8::gemm_phase<pg8::EpiVt, pg8::StaticOrder, false, true>(c.lds, g, S, E, c.tid); }
            gg_phase(c, XB, (const bf16_t*)(wl + WL_GG), (float*)(ws + WS_GG));
        } else if (s == 4) {
            post_phase(c, ap, l);
        } else if (s == 5) {
            attn_phase(c, ap, l);
        } else if (s == 6) {
            pg8::Gemm g{MIX, (const bf16_t*)(wl + WL_OUT), MTOK, DM, DM}; pg8::StaticOrder S; S.init(MTOK, DM, c.G, c.bid);
            pg8::EpiResid E{X, X, ALPHA, 1.0f};
            pg8::gemm_phase<pg8::EpiResid, pg8::StaticOrder, false, true>(c.lds, g, S, E, c.tid);
        } else if (s == 11) {
            { pg8::Gemm g{(const bf16_t*)(ws + WS_PB) + (size_t)l * MTOK * PLE, (const bf16_t*)(wl + WL_PE), MTOK, DM, PLE}; pg8::StaticOrder S; S.init(MTOK, DM, c.G, c.bid);
              pg8::EpiF32 E{E1};
              pg8::gemm_phase<pg8::EpiF32, pg8::StaticOrder, false, true>(c.lds, g, S, E, c.tid); }
            { pg8::Gemm g{XB, (const bf16_t*)(wl + WL_PG), MTOK, DM, DM}; pg8::StaticOrder S; S.init(MTOK, DM, c.G, c.bid);
              pg8::EpiGate E{X, X, E1, ALPHA};
              pg8::gemm_phase<pg8::EpiGate, pg8::StaticOrder, false, true>(c.lds, g, S, E, c.tid); }
        }
    }
}

extern "C" void kernel_launch(void* const* d_in, const int* in_sizes, int n_in, void* d_out, int out_size, void* d_ws, size_t ws_size, hipStream_t stream) {
    static int grid = 0;
    if (grid == 0) {
        if (n_in != 20 || in_sizes[0] != MTOK * DM || out_size != MTOK * DM || ws_size < WS_END) {
            fprintf(stderr, "kernel_launch: unexpected shapes (n_in %d, in0 %d, out %d, ws %zu need %zu)\n", n_in, n_in > 0 ? in_sizes[0] : -1, out_size, ws_size, (size_t)WS_END); grid = -1; return; }
        int dev = 0, cus = 0, per_cu = 0;
        hipGetDevice(&dev); hipDeviceGetAttribute(&cus, hipDeviceAttributeMultiprocessorCount, dev);
        hipFuncSetAttribute((const void*)fwd_megakernel, hipFuncAttributeMaxDynamicSharedMemorySize, LDS_BYTES);
        hipOccupancyMaxActiveBlocksPerMultiprocessor(&per_cu, (const void*)fwd_megakernel, NTHREADS, LDS_BYTES);
        if (per_cu < 1) { fprintf(stderr, "kernel_launch: occupancy query says %d blocks per CU\n", per_cu); per_cu = 1; }
        (void)hipGetLastError();
        grid = cus * per_cu;
        fprintf(stderr, "kernel_launch: grid %d (cus %d x %d)\n", grid, cus, per_cu);
    }
    if (grid < 0) return;
    hipMemsetAsync((char*)d_ws + WS_CTL, 0, 1 * MiB, stream);
    Args a{};
    for (int i = 0; i < 20; ++i) a.in[i] = (const float*)d_in[i];
    a.out = (float*)d_out; a.ws = (unsigned char*)d_ws; a.ph_lo = 0; a.ph_hi = 27; a.use_sync = 1; a.pad = 0;
    void* kargs[] = {&a};
    hipError_t e = hipLaunchCooperativeKernel((const void*)fwd_megakernel, dim3(grid), dim3(NTHREADS), kargs, LDS_BYTES, stream);
    if (e != hipSuccess) fprintf(stderr, "cooperative launch failed: %s (grid %d)\n", hipGetErrorString(e), grid);
}
```

```cpp
#include <hip/hip_runtime.h>
#include <hip/hip_cooperative_groups.h>
#include <cstdio>
#include <cstdint>
namespace cg = cooperative_groups;

#define LAS __attribute__((address_space(3)))
typedef unsigned short bf16_t;
typedef short bf16x8 __attribute__((ext_vector_type(8)));
typedef float f32x2 __attribute__((ext_vector_type(2)));
typedef float f32x4 __attribute__((ext_vector_type(4)));
typedef float f32x16 __attribute__((ext_vector_type(16)));
typedef unsigned u32x2 __attribute__((ext_vector_type(2)));
typedef unsigned u32x4 __attribute__((ext_vector_type(4)));

constexpr int NB = 4, SEQ = 2048, DM = 2048, MTOK = NB * SEQ, FF = 5632, DIN = 6160, PLE = 256, DEPTH = 2;
constexpr int PROJW = 4096;
constexpr int C_DQ = 0, C_DK = 768, C_MQ = 1536, C_MK = 2304, C_GQ = 3072, C_GK = 3328, C_GR = 3584;
constexpr int W_DQ = 0, W_DK = 768, W_DV = 1536, W_GQ = 2304, W_GK = 2560, W_GV = 2816, W_GR = 3328, W_GG = 3840, W_MQ = 3856, W_MK = 4624, W_MV = 5392;
constexpr float LN_EPS = 1e-5f;
constexpr float ALPHA = 1.4142135623730951f;
constexpr float LOG2E = 1.4426950408889634f;
constexpr float NEG_BIG = -1.0e30f;

constexpr size_t MiB = 1u << 20;
constexpr size_t WL_GU1 = 0, WL_D1 = 44 * MiB, WL_IN = 66 * MiB, WL_V = 82 * MiB, WL_OUT = 90 * MiB, WL_GU2 = 98 * MiB, WL_D2 = 142 * MiB, WL_PE = 164 * MiB, WL_PG = 165 * MiB, WL_GG = 173 * MiB, WL_SIZE = 174 * MiB;
constexpr size_t WS_CTL = 0;
constexpr size_t WS_W = 1 * MiB;
constexpr size_t WS_X = WS_W + 2 * WL_SIZE;
constexpr size_t WS_XB = WS_X + 64 * MiB;
constexpr size_t WS_H = WS_XB + 32 * MiB;
constexpr size_t WS_PROJ = WS_H + 88 * MiB;
constexpr size_t WS_VT = WS_PROJ + 64 * MiB;
constexpr size_t WS_MIX = WS_VT + 32 * MiB;
constexpr size_t WS_PB = WS_MIX + 32 * MiB;
constexpr size_t WS_R128 = WS_PB + 8 * MiB;
constexpr size_t WS_R64 = WS_R128 + 4 * MiB;
constexpr size_t WS_GG = WS_R64 + 2 * MiB;
constexpr size_t WS_QT = WS_GG + 1 * MiB;
constexpr size_t WS_QTP = WS_QT + 4 * MiB;
constexpr size_t WS_KT = WS_QTP + 4 * MiB;
constexpr size_t WS_KTT = WS_KT + 4 * MiB;
constexpr size_t WS_EL = WS_KTT + 4 * MiB;
constexpr size_t WS_KM = WS_EL + 1 * MiB;
constexpr size_t WS_END = WS_KM + 1 * MiB;

constexpr int LDS_BYTES = 147456;
constexpr int NWAVES = 8, NTHREADS = 512;

__device__ __forceinline__ float bf2f(bf16_t b) { return __uint_as_float(((unsigned)b) << 16); }
__device__ __forceinline__ float bflo(unsigned w) { return __uint_as_float(w << 16); }
__device__ __forceinline__ float bfhi(unsigned w) { return __uint_as_float(w & 0xffff0000u); }
__device__ __forceinline__ unsigned pk_bf16(float lo, float hi) { unsigned r; asm("v_cvt_pk_bf16_f32 %0, %1, %2" : "=v"(r) : "v"(lo), "v"(hi)); return r; }
__device__ __forceinline__ float wave_sum(float v) {
#pragma unroll
    for (int o = 1; o < 64; o <<= 1) v += __shfl_xor(v, o);
    return v;
}
__device__ __forceinline__ float fexp2(float x) { return __builtin_amdgcn_exp2f(x); }
__device__ __forceinline__ float fsigmoid(float x) { return __builtin_amdgcn_rcpf(1.f + fexp2(-x * LOG2E)); }
__device__ __forceinline__ int crow(int reg, int h) { return (reg & 3) + 8 * (reg >> 2) + 4 * h; }
#define MFMA32(a, b, c) __builtin_amdgcn_mfma_f32_32x32x16_bf16((a), (b), (c), 0, 0, 0)
#define LDS_WAIT() asm volatile("s_waitcnt lgkmcnt(0)" ::: "memory")
__device__ __forceinline__ bf16x8 pack8(const f32x16& x, int s) {
    u32x4 p;
    p.x = pk_bf16(x[8 * s + 0], x[8 * s + 1]); p.y = pk_bf16(x[8 * s + 2], x[8 * s + 3]);
    p.z = pk_bf16(x[8 * s + 4], x[8 * s + 5]); p.w = pk_bf16(x[8 * s + 6], x[8 * s + 7]);
    return __builtin_bit_cast(bf16x8, p);
}

namespace pg8 {
constexpr int BM = 256, BK = 64, HALF = 128, HTB = HALF * BK * 2, STAGE_BYTES = 8 * HTB, NXCD = 8, WGM = 8;
__host__ __device__ __forceinline__ int lds_byte(int r, int c) { const int st = (r >> 4) * 2 + (c >> 5), rr = r & 15, cc = c & 31, ob = rr * 64 + cc * 2; return st * 1024 + (ob ^ (((ob >> 9) & 1) << 5)); }
__host__ __device__ __forceinline__ void stage_rc(int b, int& R, int& C) { const int st = b / 1024, sb = b % 1024, swz = sb ^ (((sb >> 9) & 1) << 5); R = (st >> 1) * 16 + swz / 64; C = (st & 1) * 32 + (swz % 64) / 2; }
__host__ __device__ __forceinline__ int perm32(int rho) { const int n = rho >> 4, i = rho & 15; return 8 * (i >> 2) + 4 * n + (i & 3); }
struct Unit { int pm, pn; };
struct Gemm { const bf16_t* A; const bf16_t* Bt; int M, N, K; };
struct StaticOrder {
    int nM, nN, nwg, G, c;
    __host__ __device__ void init(int M, int N, int G_, int c_) { nM = M / BM; nN = N / BM; nwg = nM * nN; G = G_; c = c_; }
    __host__ __device__ bool next(int i, Unit& u) const {
        const long L = (long)i * G + c; if (L >= nwg) return false;
        int wgid = (int)L; { const int q = nwg / NXCD, r = nwg % NXCD, xcd = wgid % NXCD, off = wgid / NXCD; wgid = (xcd < r ? xcd * (q + 1) : r * (q + 1) + (xcd - r) * q) + off; }
        const int nig = WGM * nN, gid = wgid / nig, fm = gid * WGM, gsz = (nM - fm) < WGM ? (nM - fm) : WGM;
        u.pm = fm + ((wgid % nig) % gsz); u.pn = (wgid % nig) / gsz; return true;
    }
    __device__ __forceinline__ void a_ready(const Unit&) const {}
    __device__ __forceinline__ void done(const Unit&) const {}
};

template <class Epi, class Sched, bool ALIGN_EPI = false, bool SP2 = false>
__device__ __forceinline__ void gemm_phase(LAS unsigned char* lds, const Gemm g, const Sched& S, const Epi& E, const int tid) {
    const int wid = __builtin_amdgcn_readfirstlane(tid >> 6), lane = tid & 63, wr = wid >> 2, wc = wid & 3, fr = lane & 15, fq = lane >> 4;
    const int K = g.K, nt = K / BK;
    unsigned voffA[2], voffB[2];
#pragma unroll
    for (int i = 0; i < 2; ++i) { int R, C; stage_rc(tid * 16 + i * 8192, R, C); const int Rb = Epi::PERM ? ((R & ~31) + perm32(R & 31)) : R;
        voffA[i] = (unsigned)(R * K + C) * 2u; voffB[i] = (unsigned)(Rb * K + C) * 2u; }
    const size_t kstep = (size_t)(BK * 2);
    const size_t hstep = (size_t)HALF * K * 2;
    const size_t tstep = 2 * hstep;
    const unsigned ldsw = (unsigned)wid * 1024u;
    const int aoff = lds_byte(wr * 64 + fr, fq * 8), boff = lds_byte(wc * 32 + fr, fq * 8);
#define PG8_SA(b, h) (((b) * 2 + (h)) * HTB)
#define PG8_SB(b, h) ((4 + (b) * 2 + (h)) * HTB)
#define PG8_STAGE(bufoff, gbase, voff) do { _Pragma("unroll") for (int _i = 0; _i < 2; ++_i) \
        __builtin_amdgcn_global_load_lds((const unsigned*)((const char*)(gbase) + (voff)[_i]), (LAS unsigned*)(lds + (bufoff) + ldsw + _i * 8192), 16, 0, 0); } while (0)
#define PG8_LDA(dst, b, h) do { _Pragma("unroll") for (int m = 0; m < 4; ++m) _Pragma("unroll") for (int k = 0; k < 2; ++k) dst[m][k] = *(const LAS bf16x8*)(lds + PG8_SA(b, h) + aoff + m * 2048 + k * 1024); } while (0)
#define PG8_LDB(dst, b, h) do { _Pragma("unroll") for (int n = 0; n < 2; ++n) _Pragma("unroll") for (int k = 0; k < 2; ++k) dst[n][k] = *(const LAS bf16x8*)(lds + PG8_SB(b, h) + boff + n * 2048 + k * 1024); } while (0)
#define PG8_MMA(ai, bj, At, Bt) do { __builtin_amdgcn_s_setprio(1); _Pragma("unroll") for (int m = 0; m < 4; ++m) _Pragma("unroll") for (int n = 0; n < 2; ++n) _Pragma("unroll") for (int k = 0; k < 2; ++k) \
        acc[ai][bj][m][n] = __builtin_amdgcn_mfma_f32_16x16x32_bf16(Bt[n][k], At[m][k], acc[ai][bj][m][n], 0, 0, 0); __builtin_amdgcn_s_setprio(0); } while (0)
#define PG8_WAIT_V(n) asm volatile("s_waitcnt vmcnt(" #n ")" ::: "memory")
#define PG8_WAIT_L(n) asm volatile("s_waitcnt lgkmcnt(" #n ")" ::: "memory")
#define PG8_BAR __builtin_amdgcn_s_barrier()
#define PG8_SCHED __builtin_amdgcn_sched_barrier(0)
    Unit cur, nxt; int ui = 0;
    if (!S.next(0, cur)) return;
    f32x4 acc[2][2][4][2];
#pragma unroll
    for (int a = 0; a < 2; ++a)
#pragma unroll
        for (int b = 0; b < 2; ++b)
#pragma unroll
            for (int m = 0; m < 4; ++m)
#pragma unroll
                for (int n = 0; n < 2; ++n) acc[a][b][m][n] = (f32x4){0.f, 0.f, 0.f, 0.f};
    bf16x8 At[4][2], B0[2][2], B1[2][2];
    const char* cA = (const char*)g.A + (size_t)cur.pm * tstep; const char* cB = (const char*)g.Bt + (size_t)cur.pn * tstep;
    S.a_ready(cur);
    if constexpr (SP2) {
        PG8_STAGE(PG8_SB(0, 0), cB, voffB); PG8_STAGE(PG8_SB(0, 1), cB + hstep, voffB); PG8_STAGE(PG8_SA(0, 0), cA, voffA); PG8_STAGE(PG8_SA(0, 1), cA + hstep, voffA);
        if (wr == 1) PG8_BAR;
        PG8_WAIT_V(2); PG8_BAR;
        PG8_STAGE(PG8_SB(1, 0), cB + kstep, voffB); PG8_STAGE(PG8_SA(1, 0), cA + kstep, voffA); PG8_STAGE(PG8_SB(1, 1), cB + hstep + kstep, voffB);
        PG8_WAIT_V(6); PG8_BAR;
    } else {
        PG8_STAGE(PG8_SB(0, 0), cB, voffB); PG8_STAGE(PG8_SA(0, 0), cA, voffA); PG8_STAGE(PG8_SB(0, 1), cB + hstep, voffB); PG8_STAGE(PG8_SA(0, 1), cA + hstep, voffA);
        if (wr == 1) PG8_BAR;
        PG8_WAIT_V(4); PG8_BAR;
        PG8_STAGE(PG8_SB(1, 0), cB + kstep, voffB); PG8_STAGE(PG8_SA(1, 0), cA + kstep, voffA); PG8_STAGE(PG8_SB(1, 1), cB + hstep + kstep, voffB);
        PG8_WAIT_V(6); PG8_BAR;
    }
    for (;;) {
        const bool has_next = S.next(ui + 1, nxt);
        const char* nA = has_next ? (const char*)g.A + (size_t)nxt.pm * tstep : cA; const char* nB = has_next ? (const char*)g.Bt + (size_t)nxt.pn * tstep : cB;
        for (int t = 0; t < nt; t += 2) {
            const bool last = (t == nt - 2);
            const char* a1 = cA + (size_t)(t + 1) * kstep;
            const char* a2 = last ? nA : cA + (size_t)(t + 2) * kstep; const char* b2 = last ? nB : cB + (size_t)(t + 2) * kstep;
            const char* a3 = a2 + kstep; const char* b3 = b2 + kstep;
            if (last && has_next) S.a_ready(nxt);
            if constexpr (SP2) {
            PG8_LDB(B0, 0, 0); PG8_LDB(B1, 0, 1); PG8_SCHED; PG8_LDA(At, 0, 0); PG8_STAGE(PG8_SA(1, 1), a1 + hstep, voffA);
            PG8_WAIT_V(8); PG8_WAIT_L(0); PG8_BAR; PG8_MMA(0, 0, At, B0); PG8_MMA(0, 1, At, B1); PG8_BAR; PG8_SCHED;
            PG8_LDA(At, 0, 1); PG8_STAGE(PG8_SB(0, 0), b2, voffB); PG8_STAGE(PG8_SB(0, 1), b2 + hstep, voffB); PG8_STAGE(PG8_SA(0, 0), a2, voffA);
            PG8_WAIT_V(8); PG8_WAIT_L(0); PG8_BAR; PG8_MMA(1, 0, At, B0); PG8_MMA(1, 1, At, B1); PG8_BAR; PG8_SCHED;
            PG8_LDB(B0, 1, 0); PG8_LDB(B1, 1, 1); PG8_SCHED; PG8_LDA(At, 1, 0); PG8_STAGE(PG8_SA(0, 1), a2 + hstep, voffA);
            PG8_WAIT_V(8); PG8_WAIT_L(0); PG8_BAR; PG8_MMA(0, 0, At, B0); PG8_MMA(0, 1, At, B1); PG8_BAR; PG8_SCHED;
            PG8_LDA(At, 1, 1); PG8_STAGE(PG8_SB(1, 0), b3, voffB); PG8_STAGE(PG8_SB(1, 1), b3 + hstep, voffB); PG8_STAGE(PG8_SA(1, 0), a3, voffA);
            PG8_WAIT_V(8); PG8_WAIT_L(0); PG8_BAR; PG8_MMA(1, 0, At, B0); PG8_MMA(1, 1, At, B1); PG8_BAR; PG8_SCHED;
            } else {
            PG8_LDB(B0, 0, 0); PG8_SCHED; PG8_LDA(At, 0, 0); PG8_STAGE(PG8_SA(1, 1), a1 + hstep, voffA);
            PG8_WAIT_L(8); PG8_BAR; PG8_WAIT_L(0); PG8_MMA(0, 0, At, B0); PG8_BAR; PG8_SCHED;
            PG8_LDB(B1, 0, 1); PG8_STAGE(PG8_SB(0, 0), b2, voffB);
            PG8_BAR; PG8_WAIT_L(0); PG8_MMA(0, 1, At, B1); PG8_BAR;
            PG8_LDA(At, 0, 1); PG8_STAGE(PG8_SA(0, 0), a2, voffA);
            PG8_BAR; PG8_WAIT_L(0); PG8_MMA(1, 0, At, B0); PG8_BAR; PG8_SCHED;
            PG8_STAGE(PG8_SB(0, 1), b2 + hstep, voffB);
            PG8_WAIT_V(6); PG8_BAR; PG8_MMA(1, 1, At, B1); PG8_BAR;
            PG8_LDB(B0, 1, 0); PG8_SCHED; PG8_LDA(At, 1, 0); PG8_STAGE(PG8_SA(0, 1), a2 + hstep, voffA);
            PG8_WAIT_L(8); PG8_BAR; PG8_WAIT_L(0); PG8_MMA(0, 0, At, B0); PG8_BAR; PG8_SCHED;
            PG8_LDB(B1, 1, 1); PG8_STAGE(PG8_SB(1, 0), b3, voffB);
            PG8_BAR; PG8_WAIT_L(0); PG8_MMA(0, 1, At, B1); PG8_BAR;
            PG8_LDA(At, 1, 1); PG8_STAGE(PG8_SA(1, 0), a3, voffA);
            PG8_BAR; PG8_WAIT_L(0); PG8_MMA(1, 0, At, B0); PG8_BAR; PG8_SCHED;
            PG8_STAGE(PG8_SB(1, 1), b3 + hstep, voffB);
            PG8_WAIT_V(6); PG8_BAR; PG8_MMA(1, 1, At, B1); PG8_BAR;
            }
        }
        if constexpr (ALIGN_EPI) { if (wr == 0) PG8_BAR; }
        E(acc, cur, wr, wc, fr, fq); S.done(cur);
        if (!has_next) break;
#pragma unroll
        for (int a = 0; a < 2; ++a)
#pragma unroll
            for (int b = 0; b < 2; ++b)
#pragma unroll
                for (int m = 0; m < 4; ++m)
#pragma unroll
                    for (int n = 0; n < 2; ++n) acc[a][b][m][n] = (f32x4){0.f, 0.f, 0.f, 0.f};
        cur = nxt; cA = nA; cB = nB; ++ui;
        if constexpr (ALIGN_EPI) { if (wr == 1) PG8_BAR; }
    }
    PG8_WAIT_V(0);
    if constexpr (!ALIGN_EPI) { if (wr == 0) PG8_BAR; }
    PG8_BAR;
#undef PG8_SA
#undef PG8_SB
#undef PG8_STAGE
#undef PG8_LDA
#undef PG8_LDB
#undef PG8_MMA
#undef PG8_WAIT_V
#undef PG8_WAIT_L
#undef PG8_BAR
#undef PG8_SCHED
}

typedef const f32x4 (&AccRef)[2][2][4][2];

struct EpiSwiGLU {
    static constexpr bool PERM = true;
    bf16_t* H;
    __device__ __forceinline__ void operator()(AccRef acc, const Unit& u, int wr, int wc, int fr, int fq) const {
        const int row0 = u.pm * BM + wr * 64 + fr, col0 = u.pn * 128 + wc * 32 + 8 * fq;
#pragma unroll
        for (int ai = 0; ai < 2; ++ai)
#pragma unroll
            for (int m = 0; m < 4; ++m) {
                float o[8];
#pragma unroll
                for (int n = 0; n < 2; ++n)
#pragma unroll
                    for (int j = 0; j < 4; ++j) { const float g = acc[ai][0][m][n][j], up = acc[ai][1][m][n][j]; o[4 * n + j] = g * fsigmoid(g) * up; }
                u32x4 w; w.x = pk_bf16(o[0], o[1]); w.y = pk_bf16(o[2], o[3]); w.z = pk_bf16(o[4], o[5]); w.w = pk_bf16(o[6], o[7]);
                *(u32x4*)(H + (size_t)(row0 + ai * HALF + m * 16) * FF + col0) = w;
            }
    }
};
struct EpiResid {
    static constexpr bool PERM = false;
    const float* src; float* dst; float alpha, beta;
    __device__ __forceinline__ void operator()(AccRef acc, const Unit& u, int wr, int wc, int fr, int fq) const {
        const int row0 = u.pm * BM + wr * 64 + fr, col0 = u.pn * BM + wc * 32 + 4 * fq;
#pragma unroll
        for (int ai = 0; ai < 2; ++ai)
#pragma unroll
            for (int m = 0; m < 4; ++m) { const size_t ro = (size_t)(row0 + ai * HALF + m * 16) * DM + col0;
#pragma unroll
                for (int bj = 0; bj < 2; ++bj)
#pragma unroll
                    for (int n = 0; n < 2; ++n) { const f32x4 xv = *(const f32x4*)(src + ro + bj * HALF + n * 16); *(f32x4*)(dst + ro + bj * HALF + n * 16) = xv * alpha + acc[ai][bj][m][n] * beta; } }
    }
};
struct EpiF32 {
    static constexpr bool PERM = false;
    float* C;
    __device__ __forceinline__ void operator()(AccRef acc, const Unit& u, int wr, int wc, int fr, int fq) const {
        const int row0 = u.pm * BM + wr * 64 + fr, col0 = u.pn * BM + wc * 32 + 4 * fq;
#pragma unroll
        for (int ai = 0; ai < 2; ++ai)
#pragma unroll
            for (int m = 0; m < 4; ++m) { const size_t ro = (size_t)(row0 + ai * HALF + m * 16) * DM + col0;
#pragma unroll
                for (int bj = 0; bj < 2; ++bj)
#pragma unroll
                    for (int n = 0; n < 2; ++n) *(f32x4*)(C + ro + bj * HALF + n * 16) = acc[ai][bj][m][n]; }
    }
};
struct EpiGate {
    static constexpr bool PERM = false;
    const float* src; float* dst; const float* E1; float alpha;
    __device__ __forceinline__ void operator()(AccRef acc, const Unit& u, int wr, int wc, int fr, int fq) const {
        const int row0 = u.pm * BM + wr * 64 + fr, col0 = u.pn * BM + wc * 32 + 4 * fq;
#pragma unroll
        for (int ai = 0; ai < 2; ++ai)
#pragma unroll
            for (int m = 0; m < 4; ++m) { const size_t ro = (size_t)(row0 + ai * HALF + m * 16) * DM + col0;
#pragma unroll
                for (int bj = 0; bj < 2; ++bj)
#pragma unroll
                    for (int n = 0; n < 2; ++n) { const size_t o = ro + bj * HALF + n * 16; const f32x4 xv = *(const f32x4*)(src + o), ev = *(const f32x4*)(E1 + o); const f32x4 a = acc[ai][bj][m][n];
                        f32x4 r; r.x = xv.x * alpha + ev.x * fsigmoid(a.x); r.y = xv.y * alpha + ev.y * fsigmoid(a.y); r.z = xv.z * alpha + ev.z * fsigmoid(a.z); r.w = xv.w * alpha + ev.w * fsigmoid(a.w);
                        *(f32x4*)(dst + o) = r; } }
    }
};
struct EpiVt {
    static constexpr bool PERM = false;
    bf16_t* VT;
    __device__ __forceinline__ void operator()(AccRef acc, const Unit& u, int wr, int wc, int fr, int fq) const {
        const int row0 = u.pm * BM + wr * 64 + fr, col0 = u.pn * BM + wc * 32 + 8 * (fq & 1) + 4 * (fq >> 1);
#pragma unroll
        for (int ai = 0; ai < 2; ++ai)
#pragma unroll
            for (int m = 0; m < 4; ++m) { bf16_t* rp = VT + (size_t)(row0 + ai * HALF + m * 16) * MTOK + col0;
#pragma unroll
                for (int bj = 0; bj < 2; ++bj)
#pragma unroll
                    for (int n = 0; n < 2; ++n) { const f32x4 a = acc[ai][bj][m][n]; u32x2 w; w.x = pk_bf16(a.x, a.y); w.y = pk_bf16(a.z, a.w); *(u32x2*)(rp + bj * HALF + n * 16) = w; } }
    }
};
struct EpiProj {
    static constexpr bool PERM = true;
    bf16_t* P; const float* rope128; const float* rope64;
    __device__ __forceinline__ void operator()(AccRef acc, const Unit& u, int wr, int wc, int fr, int fq) const {
        const int pn = u.pn, row0 = u.pm * BM + wr * 64 + fr;
        if (pn < 12) {
            const bool isdiff = pn < 6; const int pp = isdiff ? pn : pn - 6; const int g = pp / 3, tg = pp % 3;
            const float sc = (g == 0) ? (isdiff ? 0.125f * LOG2E : 0.08838834764831845f * LOG2E) : 1.f;
            int fbase, col1, half, rpitch; const float* rt0;
            if (isdiff) { fbase = 8 * fq; col1 = g * 768 + (tg * 4 + wc) * 64 + fbase; half = 32; rpitch = 64; rt0 = rope64; }
            else { fbase = 32 * (wc & 1) + 8 * fq; col1 = C_MQ + g * 768 + (tg * 2 + (wc >> 1)) * 128 + fbase; half = 64; rpitch = 128; rt0 = rope128; }
#pragma unroll
            for (int ai = 0; ai < 2; ++ai)
#pragma unroll
                for (int m = 0; m < 4; ++m) { const int row = row0 + ai * HALF + m * 16;
                    const f32x4* rt = (const f32x4*)(rt0 + (size_t)row * rpitch + 2 * fbase);
                    float o1[8], o2[8];
#pragma unroll
                    for (int q = 0; q < 4; ++q) { const f32x4 cs = rt[q];
#pragma unroll
                        for (int e = 0; e < 2; ++e) { const int idx = 2 * q + e; const float a = acc[ai][0][m][idx >> 2][idx & 3], b = acc[ai][1][m][idx >> 2][idx & 3];
                            const float c = e ? cs.z : cs.x, s = e ? cs.w : cs.y; o1[idx] = (a * c - b * s) * sc; o2[idx] = (b * c + a * s) * sc; } }
                    bf16_t* rp = P + (size_t)row * PROJW + col1;
                    u32x4 w; w.x = pk_bf16(o1[0], o1[1]); w.y = pk_bf16(o1[2], o1[3]); w.z = pk_bf16(o1[4], o1[5]); w.w = pk_bf16(o1[6], o1[7]); *(u32x4*)rp = w;
                    w.x = pk_bf16(o2[0], o2[1]); w.y = pk_bf16(o2[2], o2[3]); w.z = pk_bf16(o2[4], o2[5]); w.w = pk_bf16(o2[6], o2[7]); *(u32x4*)(rp + half) = w; }
        } else {
            const int col0 = C_GQ + (pn - 12) * 256 + wc * 32 + 8 * fq;
#pragma unroll
            for (int ai = 0; ai < 2; ++ai)
#pragma unroll
                for (int m = 0; m < 4; ++m) { bf16_t* rp = P + (size_t)(row0 + ai * HALF + m * 16) * PROJW + col0;
#pragma unroll
                    for (int bj = 0; bj < 2; ++bj) { const f32x4 v0 = acc[ai][bj][m][0], v1 = acc[ai][bj][m][1]; u32x4 w; w.x = pk_bf16(v0.x, v0.y); w.y = pk_bf16(v0.z, v0.w); w.z = pk_bf16(v1.x, v1.y); w.w = pk_bf16(v1.z, v1.w); *(u32x4*)(rp + bj * HALF) = w; } }
        }
    }
};
}

struct Args { const float* in[20]; float* out; unsigned char* ws; int ph_lo, ph_hi; int use_sync, pad; };

typedef const __attribute__((address_space(4))) Args* ArgsP;
struct Ctx { int tid, lane, wave, gw, NGW, G, bid; LAS unsigned char* lds; unsigned char* ws; };

__device__ __forceinline__ void transpose_item(const float* __restrict__ W, int ldw, int src_col0, bf16_t* WT, int K, int dst_row0, int k0, LAS float* scr, int lane) {
#pragma unroll 8
    for (int i = 0; i < 32; ++i) { const int kk = 2 * i + (lane >> 5); scr[kk * 33 + (lane & 31)] = W[(size_t)(k0 + kk) * ldw + src_col0 + (lane & 31)]; }
    LDS_WAIT();
    const int c = lane & 7;
#pragma unroll
    for (int j = 0; j < 4; ++j) { const int n = (lane >> 3) + 8 * j; const LAS float* s = scr + (8 * c) * 33 + n;
        u32x4 o; o.x = pk_bf16(s[0 * 33], s[1 * 33]); o.y = pk_bf16(s[2 * 33], s[3 * 33]); o.z = pk_bf16(s[4 * 33], s[5 * 33]); o.w = pk_bf16(s[6 * 33], s[7 * 33]);
        *(u32x4*)(WT + (size_t)(dst_row0 + n) * K + k0 + 8 * c) = o; }
    LDS_WAIT();
}
__device__ __forceinline__ int win_src_col(int gidx) {
    const int pn = gidx >> 3, w = gidx & 7;
    if (pn < 6) { const int g = pn / 3, tg = pn % 3, half = w >> 2, u = w & 3; return (g ? W_DK : W_DQ) + (tg * 4 + u) * 64 + half * 32; }
    if (pn < 12) { const int pp = pn - 6, g = pp / 3, tg = pp % 3, half = w >> 2, ww = w & 3; return (g ? W_MK : W_MQ) + (tg * 2 + (ww >> 1)) * 128 + half * 64 + (ww & 1) * 32; }
    if (pn == 12) return W_GQ + 32 * w;
    if (pn == 13) return W_GK + 32 * w;
    return W_GR + (pn - 14) * 256 + 32 * w;
}
__device__ __forceinline__ void prologue(ArgsP a, const Ctx& c) {
    LAS float* scr = (LAS float*)(c.lds + c.wave * 16384);
    constexpr int I_GU = 32 * 352, I_D = 88 * 64, I_IN = 32 * 128, I_SQ = 32 * 64, I_PE = 4 * 64;
    constexpr int PER_LAYER = 2 * I_GU + 2 * I_D + I_IN + 3 * I_SQ + I_PE;
    for (int it = c.gw; it < 2 * PER_LAYER; it += c.NGW) {
        const int l = it / PER_LAYER; int r = it - l * PER_LAYER;
        unsigned char* wl = c.ws + WS_W + (size_t)l * WL_SIZE;
        if (r < 2 * I_GU) {
            const int second = r >= I_GU; if (second) r -= I_GU;
            const int kb = r / 352, gidx = r % 352, pn = gidx >> 3, w = gidx & 7;
            const float* src = a->in[(second ? 13 : 10) + (w >> 2)] + (size_t)l * DM * FF;
            transpose_item(src, FF, 128 * pn + 32 * (w & 3), (bf16_t*)(wl + (second ? WL_GU2 : WL_GU1)), DM, 32 * gidx, 64 * kb, scr, c.lane); continue; }
        r -= 2 * I_GU;
        if (r < 2 * I_D) { const int second = r >= I_D; if (second) r -= I_D; const int kb = r / 64, nb = r % 64;
            transpose_item(a->in[second ? 15 : 12] + (size_t)l * FF * DM, DM, 32 * nb, (bf16_t*)(wl + (second ? WL_D2 : WL_D1)), FF, 32 * nb, 64 * kb, scr, c.lane); continue; }
        r -= 2 * I_D;
        if (r < I_IN) { const int kb = r / 128, gidx = r % 128;
            transpose_item(a->in[3] + (size_t)l * DM * DIN, DIN, win_src_col(gidx), (bf16_t*)(wl + WL_IN), DM, 32 * gidx, 64 * kb, scr, c.lane); continue; }
        r -= I_IN;
        if (r < I_SQ) { const int kb = r / 64, nb = r % 64, row0 = 32 * nb; const int sc = row0 < 768 ? W_DV + row0 : (row0 < 1280 ? W_GV + (row0 - 768) : W_MV + (row0 - 1280));
            transpose_item(a->in[3] + (size_t)l * DM * DIN, DIN, sc, (bf16_t*)(wl + WL_V), DM, row0, 64 * kb, scr, c.lane); continue; }
        r -= I_SQ;
        if (r < I_SQ) { const int kb = r / 64, nb = r % 64; transpose_item(a->in[4] + (size_t)l * DM * DM, DM, 32 * nb, (bf16_t*)(wl + WL_OUT), DM, 32 * nb, 64 * kb, scr, c.lane); continue; }
        r -= I_SQ;
        if (r < I_SQ) { const int kb = r / 64, nb = r % 64; transpose_item(a->in[17] + (size_t)l * DM * DM, DM, 32 * nb, (bf16_t*)(wl + WL_PG), DM, 32 * nb, 64 * kb, scr, c.lane); continue; }
        r -= I_SQ;
        { const int kb = r / 64, nb = r % 64; transpose_item(a->in[16] + (size_t)l * PLE * DM, DM, 32 * nb, (bf16_t*)(wl + WL_PE), PLE, 32 * nb, 64 * kb, scr, c.lane); }
    }
    { const float* x = a->in[0]; bf16_t* xb = (bf16_t*)(c.ws + WS_XB);
      for (int m = c.gw; m < MTOK; m += c.NGW) { const f32x4* xr = (const f32x4*)(x + (size_t)m * DM) + c.lane; u32x2* o = (u32x2*)(xb + (size_t)m * DM) + c.lane;
#pragma unroll
          for (int j = 0; j < 8; ++j) { const f32x4 v = xr[64 * j]; u32x2 w; w.x = pk_bf16(v.x, v.y); w.y = pk_bf16(v.z, v.w); o[64 * j] = w; } } }
    { const float* p = a->in[1]; bf16_t* pb = (bf16_t*)(c.ws + WS_PB);
      for (int m = c.gw; m < 2 * MTOK; m += c.NGW) { const f32x4 v = *((const f32x4*)(p + (size_t)m * PLE) + c.lane); u32x2 w; w.x = pk_bf16(v.x, v.y); w.y = pk_bf16(v.z, v.w); *((u32x2*)(pb + (size_t)m * PLE) + c.lane) = w; } }
    { const int* pos = (const int*)a->in[2]; float* r128 = (float*)(c.ws + WS_R128); float* r64 = (float*)(c.ws + WS_R64);
      const int gt = c.gw * 64 + c.lane, NT = c.NGW * 64;
      for (int idx = gt; idx < MTOK * 64; idx += NT) { const int m = idx >> 6, f = idx & 63;
          const float inv = exp2f(-(float)f * (13.287712379549449f / 64.f));
          const float ang = (float)pos[m] * inv;
          const double rev = (double)ang * 0.15915494309189535; const float fr = (float)(rev - rint(rev));
          const float cv = __builtin_amdgcn_cosf(fr), sv = __builtin_amdgcn_sinf(fr);
          r128[2 * idx] = cv; r128[2 * idx + 1] = sv;
          if ((f & 1) == 0) { const int i2 = m * 32 + (f >> 1); r64[2 * i2] = cv; r64[2 * i2 + 1] = sv; } } }
    { const int gt = c.gw * 64 + c.lane, NT = c.NGW * 64;
      for (int idx = gt; idx < 2 * 16 * DM; idx += NT) { const int l = idx / (16 * DM), rr = (idx / DM) & 15, k = idx % DM;
          ((bf16_t*)(c.ws + WS_W + (size_t)l * WL_SIZE + WL_GG))[rr * DM + k] = (bf16_t)(pk_bf16(a->in[3][(size_t)l * DM * DIN + (size_t)k * DIN + W_GG + rr], 0.f) & 0xffffu); } }
}

__device__ __forceinline__ void ln_phase(const Ctx& c, const float* z, float* xo, bf16_t* xbo, const float* g, const float* b) {
    for (int m = c.gw; m < MTOK; m += c.NGW) {
        const f32x4* zr = (const f32x4*)(z + (size_t)m * DM) + c.lane;
        f32x4 v[8]; float s = 0.f;
#pragma unroll
        for (int j = 0; j < 8; ++j) { v[j] = zr[64 * j]; s += (v[j].x + v[j].y) + (v[j].z + v[j].w); }
        const float mean = wave_sum(s) * (1.f / DM); float s2 = 0.f;
#pragma unroll
        for (int j = 0; j < 8; ++j) { v[j] = v[j] - mean; s2 += (v[j].x * v[j].x + v[j].y * v[j].y) + (v[j].z * v[j].z + v[j].w * v[j].w); }
        const float rstd = 1.f / sqrtf(wave_sum(s2) * (1.f / DM) + LN_EPS);
        f32x4* xr = (f32x4*)(xo + (size_t)m * DM) + c.lane;
#pragma unroll
        for (int j = 0; j < 8; ++j) { const f32x4 gv = ((const f32x4*)g)[c.lane + 64 * j], bv = ((const f32x4*)b)[c.lane + 64 * j]; const f32x4 o = v[j] * rstd * gv + bv; xr[64 * j] = o;
            if (xbo) { u32x2 w; w.x = pk_bf16(o.x, o.y); w.y = pk_bf16(o.z, o.w); ((u32x2*)(xbo + (size_t)m * DM) + c.lane)[64 * j] = w; } }
    }
}

__device__ __forceinline__ void gg_phase(const Ctx& c, const bf16_t* xb, const bf16_t* wgg, float* gg) {
    const int row = c.lane & 15, quad = c.lane >> 4;
    for (int t = c.gw; t < MTOK / 16; t += c.NGW) {
        f32x4 acc = {0.f, 0.f, 0.f, 0.f};
        const bf16_t* ap = xb + (size_t)(t * 16 + row) * DM + quad * 8; const bf16_t* bp = wgg + (size_t)row * DM + quad * 8;
#pragma unroll 8
        for (int k0 = 0; k0 < DM; k0 += 32) { const bf16x8 av = *(const bf16x8*)(ap + k0), bv = *(const bf16x8*)(bp + k0); acc = __builtin_amdgcn_mfma_f32_16x16x32_bf16(av, bv, acc, 0, 0, 0); }
#pragma unroll
        for (int j = 0; j < 4; ++j) gg[(size_t)(t * 16 + quad * 4 + j) * 16 + row] = acc[j];
    }
}

__device__ __forceinline__ int perm23(int t) { return (t & ~12) | ((t & 4) << 1) | ((t & 8) >> 1); }
__device__ __forceinline__ void post_phase(const Ctx& c, ArgsP a, int l) {
    const bf16_t* proj = (const bf16_t*)(c.ws + WS_PROJ); const float* gg = (const float*)(c.ws + WS_GG);
    bf16_t* QT = (bf16_t*)(c.ws + WS_QT); bf16_t* QTP = (bf16_t*)(c.ws + WS_QTP); bf16_t* KT = (bf16_t*)(c.ws + WS_KT); bf16_t* KTT = (bf16_t*)(c.ws + WS_KTT);
    float* EL = (float*)(c.ws + WS_EL); bf16_t* KM = (bf16_t*)(c.ws + WS_KM);
    const float* gate_up = a->in[7] + (size_t)l * 16 * 256; const float* gate_b = a->in[8] + (size_t)l * 256;
    for (int task = c.gw; task < 512 + 192; task += c.NGW) {
        if (task < 512) {
            const int bh = task >> 5, ch = task & 31, b = bh >> 2, hh = bh & 3, k = c.lane;
            float up[16];
#pragma unroll
            for (int r = 0; r < 16; ++r) up[r] = gate_up[r * 256 + hh * 64 + k];
            const float bias = gate_b[hh * 64 + k];
            float cum = 0.f;
            const int tok0 = b * SEQ + ch * 64; const size_t rb = (size_t)bh * SEQ + ch * 64;
            const int kp = (k & ~31) | perm23(k & 31);
            for (int t8 = 0; t8 < 8; ++t8) {
                unsigned kk[8];
#pragma unroll
                for (int tt = 0; tt < 8; ++tt) { const int t = t8 * 8 + tt; const int tok = tok0 + t;
                    const f32x4* gp = (const f32x4*)(gg + (size_t)tok * 16);
                    float pre = bias;
#pragma unroll
                    for (int q = 0; q < 4; ++q) { const f32x4 gv = gp[q]; pre += gv.x * up[4 * q] + gv.y * up[4 * q + 1] + gv.z * up[4 * q + 2] + gv.w * up[4 * q + 3]; }
                    const float ls = fminf(pre, 0.f) - log1pf(expf(-fabsf(pre)));
                    cum += ls * (1.f / 16.f);
                    const float qv = bf2f(proj[(size_t)tok * PROJW + C_GQ + hh * 64 + k]), kv = bf2f(proj[(size_t)tok * PROJW + C_GK + hh * 64 + k]);
                    const float qt = qv * expf(cum) * 0.125f, kt = kv * expf(-cum);
                    const bf16_t qb = (bf16_t)(pk_bf16(qt, 0.f) & 0xffffu), kb = (bf16_t)(pk_bf16(kt, 0.f) & 0xffffu);
                    QT[(rb + t) * 64 + k] = qb; QTP[(rb + t) * 64 + kp] = qb; KT[(rb + t) * 64 + k] = kb; kk[tt] = kb; }
                bf16_t* dst = KTT + ((size_t)(bh * 32 + ch) * 64 + k) * 64 + (t8 >> 2) * 32;
                const int t8l = t8 & 3;
                u32x2 w0, w1; w0.x = kk[0] | (kk[1] << 16); w0.y = kk[2] | (kk[3] << 16); w1.x = kk[4] | (kk[5] << 16); w1.y = kk[6] | (kk[7] << 16);
                *(u32x2*)(dst + (t8l >> 1) * 16 + 0 * 8 + (t8l & 1) * 4) = w0;
                *(u32x2*)(dst + (t8l >> 1) * 16 + 1 * 8 + (t8l & 1) * 4) = w1;
            }
            EL[(size_t)(bh * 32 + ch) * 64 + k] = expf(cum);
        } else {
            const int t2 = task - 512, b = t2 / 48, hd = (t2 / 8) % 6, blk = t2 & 7;
            const bf16_t* kp = proj + (size_t)(b * SEQ + blk * 256) * PROJW + C_MK + hd * 128 + 2 * c.lane;
            float s0 = 0.f, s1 = 0.f;
#pragma unroll 8
            for (int t = 0; t < 256; ++t) { const unsigned w = *(const unsigned*)(kp + (size_t)t * PROJW); s0 += bflo(w); s1 += bfhi(w); }
            *(unsigned*)(KM + (size_t)((b * 6 + hd) * 8 + blk) * 128 + 2 * c.lane) = pk_bf16(s0 * (1.f / 256.f), s1 * (1.f / 256.f));
        }
    }
}

template <int DQ, bool QLDS>
__device__ __forceinline__ void attn_pass(const bf16_t* qrow  , const bf16_t* kbase  , const bf16_t* vbase  ,
                                          int qt, int own, unsigned selmask, int r, int h, f32x16 (&O)[4], LAS unsigned char* wlds  ) {
    constexpr int NKS = DQ / 16;
    bf16x8 qf[QLDS ? 1 : NKS];
    if constexpr (QLDS) {
#pragma unroll
        for (int ks = 0; ks < NKS; ++ks) *(LAS bf16x8*)(wlds + ks * 1024) = *(const bf16x8*)(qrow + 16 * ks);
    } else {
#pragma unroll
        for (int ks = 0; ks < NKS; ++ks) qf[ks] = *(const bf16x8*)(qrow + 16 * ks);
    }
#pragma unroll
    for (int t = 0; t < 4; ++t)
#pragma unroll
        for (int i = 0; i < 16; ++i) O[t][i] = 0.f;
    unsigned bmask = 0u;
    for (int n = 0; n < own; ++n) if (__ballot((selmask >> n) & 1u) != 0ull) bmask |= 1u << n;
    bmask |= 0xffffff00u | (0xffu & ~((1u << own) - 1u));
    bmask = (unsigned)__builtin_amdgcn_readfirstlane((int)bmask);
    float m = NEG_BIG, l = 0.f;
    int kt = 8 * __builtin_ctz(bmask);
    bf16x8 kf[NKS];
    { const bf16_t* kp = kbase + (size_t)(kt * 32) * PROJW;
#pragma unroll
      for (int ks = 0; ks < NKS; ++ks) kf[ks] = *(const bf16x8*)(kp + 16 * ks); }
    while (kt <= qt) {
        int nk = kt + 1;
        if ((nk & 7) == 0) { const unsigned rem = bmask >> (nk >> 3); nk += 8 * __builtin_ctz(rem); }
        const int n = kt >> 3;
        const bool vis = (n >= own) || ((selmask >> n) & 1u);
        bf16x8 vf[8];
        const bf16_t* vp = vbase + kt * 32;
#pragma unroll
        for (int t = 0; t < 4; ++t) { vf[2 * t] = *(const bf16x8*)(vp + (size_t)(32 * t) * MTOK); vf[2 * t + 1] = *(const bf16x8*)(vp + (size_t)(32 * t) * MTOK + 16); }
        __builtin_amdgcn_sched_barrier(0);
        f32x16 s;
#pragma unroll
        for (int i = 0; i < 16; ++i) s[i] = 0.f;
        if constexpr (QLDS) {
            LAS unsigned char* ql = wlds; asm volatile("" : "+v"(ql));
#pragma unroll
            for (int ks = 0; ks < NKS; ++ks) { const bf16x8 qq = *(const LAS bf16x8*)(ql + ks * 1024); s = MFMA32(kf[ks], qq, s); }
        } else {
#pragma unroll
            for (int ks = 0; ks < NKS; ++ks) s = MFMA32(kf[ks], qf[ks], s);
        }
        __builtin_amdgcn_sched_barrier(0);
        { const int pk = nk <= qt ? nk : qt; const bf16_t* kp = kbase + (size_t)(pk * 32) * PROJW;
#pragma unroll
          for (int ks = 0; ks < NKS; ++ks) kf[ks] = *(const bf16x8*)(kp + 16 * ks); }
        __builtin_amdgcn_sched_barrier(0);
        if (kt == qt) {
#pragma unroll
            for (int i = 0; i < 16; ++i) if (crow(i, h) > r) s[i] = NEG_BIG;
        }
        if (!vis) {
#pragma unroll
            for (int i = 0; i < 16; ++i) s[i] = NEG_BIG;
        }
        float mx = s[0];
#pragma unroll
        for (int i = 1; i < 16; ++i) mx = fmaxf(mx, s[i]);
        mx = fmaxf(mx, __shfl_xor(mx, 32));
        if (__ballot(mx > m + 8.f) != 0ull) {
            const float mn = fmaxf(m, mx), alpha = fexp2(m - mn); m = mn; l *= alpha;
#pragma unroll
            for (int t = 0; t < 4; ++t) O[t] = O[t] * alpha;
        }
        float ls = 0.f;
#pragma unroll
        for (int i = 0; i < 16; ++i) { s[i] = fexp2(s[i] - m); ls += s[i]; }
        l += ls;
        const bf16x8 p0 = pack8(s, 0), p1 = pack8(s, 1);
#pragma unroll
        for (int t = 0; t < 4; ++t) { O[t] = MFMA32(vf[2 * t], p0, O[t]); O[t] = MFMA32(vf[2 * t + 1], p1, O[t]); }
        kt = nk;
    }
    l += __shfl_xor(l, 32);
    const float inv = 1.f / l;
#pragma unroll
    for (int t = 0; t < 4; ++t) O[t] = O[t] * inv;
}

__device__ __forceinline__ void store_o(bf16_t* orow  , const f32x16 (&O)[4]) {
#pragma unroll
    for (int t = 0; t < 4; ++t)
#pragma unroll
        for (int q = 0; q < 4; ++q) { u32x2 w; w.x = pk_bf16(O[t][4 * q], O[t][4 * q + 1]); w.y = pk_bf16(O[t][4 * q + 2], O[t][4 * q + 3]); *(u32x2*)(orow + 32 * t + 8 * q) = w; }
}

__device__ __forceinline__ void diff_task(const Ctx& c, ArgsP a, int l, int bh, int qt) {
    const int b = bh / 6, hd = bh % 6, r = c.lane & 31, h = c.lane >> 5;
    const bf16_t* proj = (const bf16_t*)(c.ws + WS_PROJ); const bf16_t* VT = (const bf16_t*)(c.ws + WS_VT); bf16_t* mix = (bf16_t*)(c.ws + WS_MIX);
    const float* lf = a->in[5] + (size_t)l * 256;
    const float d1 = wave_sum(lf[c.lane] * lf[64 + c.lane]), d2 = wave_sum(lf[128 + c.lane] * lf[192 + c.lane]);
    const float lam_init = 0.8f - 0.6f * expf(-0.3f * (float)l);
    const float lam = expf(d1) - expf(d2) + lam_init;
    const size_t tokq = (size_t)b * SEQ + qt * 32 + r;
    const bf16_t* kb = proj + ((size_t)b * SEQ + r) * PROJW + C_DK + hd * 128 + 8 * h;
    const bf16_t* vb = VT + (size_t)(hd * 128 + r) * MTOK + (size_t)b * SEQ + 8 * h;
    f32x16 O1[4];
    LAS unsigned char* wl = c.lds + c.wave * 16384 + c.lane * 16;
    {
        f32x16 O2[4];
        attn_pass<64, false>(proj + tokq * PROJW + C_DQ + hd * 128 + 64 + 8 * h, kb + 64, vb, qt, 0, 0u, r, h, O2, wl);
#pragma unroll
        for (int t = 0; t < 4; ++t)
#pragma unroll
            for (int q = 0; q < 4; ++q) { f32x4 v; v.x = O2[t][4 * q]; v.y = O2[t][4 * q + 1]; v.z = O2[t][4 * q + 2]; v.w = O2[t][4 * q + 3]; *(LAS f32x4*)(wl + (t * 4 + q) * 1024) = v; }
    }
    attn_pass<64, false>(proj + tokq * PROJW + C_DQ + hd * 128 + 8 * h, kb, vb, qt, 0, 0u, r, h, O1, wl);
    float ss = 0.f;
#pragma unroll
    for (int t = 0; t < 4; ++t)
#pragma unroll
        for (int q = 0; q < 4; ++q) { const f32x4 o2 = *(const LAS f32x4*)(wl + (t * 4 + q) * 1024);
            float v;
            v = O1[t][4 * q] - lam * o2.x; O1[t][4 * q] = v; ss += v * v;
            v = O1[t][4 * q + 1] - lam * o2.y; O1[t][4 * q + 1] = v; ss += v * v;
            v = O1[t][4 * q + 2] - lam * o2.z; O1[t][4 * q + 2] = v; ss += v * v;
            v = O1[t][4 * q + 3] - lam * o2.w; O1[t][4 * q + 3] = v; ss += v * v; }
    ss += __shfl_xor(ss, 32);
    const float rs = (1.f - lam_init) / sqrtf(ss * (1.f / 128.f) + LN_EPS);
    const float* gn = a->in[6] + (size_t)l * 128 + 4 * h;
#pragma unroll
    for (int t = 0; t < 4; ++t)
#pragma unroll
        for (int q = 0; q < 4; ++q) { const f32x4 gv = *(const f32x4*)(gn + 32 * t + 8 * q);
            O1[t][4 * q] *= rs * gv.x; O1[t][4 * q + 1] *= rs * gv.y; O1[t][4 * q + 2] *= rs * gv.z; O1[t][4 * q + 3] *= rs * gv.w; }
    store_o(mix + tokq * DM + hd * 128 + 4 * h, O1);
}

__device__ __forceinline__ void moba_task(const Ctx& c, int bh, int qt) {
    const int b = bh / 6, hd = bh % 6, r = c.lane & 31, h = c.lane >> 5;
    const bf16_t* proj = (const bf16_t*)(c.ws + WS_PROJ); const bf16_t* VT = (const bf16_t*)(c.ws + WS_VT); bf16_t* mix = (bf16_t*)(c.ws + WS_MIX);
    const bf16_t* KM = (const bf16_t*)(c.ws + WS_KM) + (size_t)(b * 6 + hd) * 8 * 128;
    const size_t tokq = (size_t)b * SEQ + qt * 32 + r;
    const bf16_t* qrow = proj + tokq * PROJW + C_MQ + hd * 128 + 8 * h;
    const int own = qt >> 3;
    unsigned selmask = 0u;
    if (own > 3) {
        f32x16 g;
#pragma unroll
        for (int i = 0; i < 16; ++i) g[i] = 0.f;
#pragma unroll
        for (int ks = 0; ks < 8; ++ks) { bf16x8 kf = {0, 0, 0, 0, 0, 0, 0, 0}; if (r < 8) kf = *(const bf16x8*)(KM + r * 128 + 16 * ks + 8 * h);
            const bf16x8 qf = *(const bf16x8*)(qrow + 16 * ks); g = MFMA32(kf, qf, g); }
        float gate[8];
#pragma unroll
        for (int i = 0; i < 4; ++i) { const float mine = g[i], other = __shfl_xor(mine, 32); gate[i] = h ? other : mine; gate[4 + i] = h ? mine : other; }
#pragma unroll
        for (int n = 0; n < 8; ++n) { int rank = 0;
#pragma unroll
            for (int mm = 0; mm < 8; ++mm) { if (mm == n) continue; const bool ahead = (gate[mm] > gate[n]) || (gate[mm] == gate[n] && mm < n); rank += (mm < own && ahead) ? 1 : 0; }
            if (n < own && rank < 3) selmask |= 1u << n; }
    } else selmask = 0xffu;
    f32x16 O[4];
    attn_pass<128, true>(qrow, proj + ((size_t)b * SEQ + r) * PROJW + C_MK + hd * 128 + 8 * h, VT + (size_t)(1280 + hd * 128 + r) * MTOK + (size_t)b * SEQ + 8 * h, qt, own, selmask, r, h, O, c.lds + c.wave * 16384 + c.lane * 16);
    store_o(mix + tokq * DM + 1280 + hd * 128 + 4 * h, O);
}

__device__ __forceinline__ void gla_chain(const Ctx& c, ArgsP a, int l, int g) {
    const int r = c.lane & 31, h = c.lane >> 5, hw = c.wave >> 2, sl = c.wave & 3;
    const int bh = 2 * g + hw, b = bh >> 2, hh = bh & 3;
    const bf16_t* QT = (const bf16_t*)(c.ws + WS_QT) + (size_t)bh * SEQ * 64; const bf16_t* QTP = (const bf16_t*)(c.ws + WS_QTP) + (size_t)bh * SEQ * 64;
    const bf16_t* KT = (const bf16_t*)(c.ws + WS_KT) + (size_t)bh * SEQ * 64; const bf16_t* KTT = (const bf16_t*)(c.ws + WS_KTT) + (size_t)bh * 32 * 4096;
    const float* EL = (const float*)(c.ws + WS_EL) + (size_t)bh * 32 * 64;
    const bf16_t* VT = (const bf16_t*)(c.ws + WS_VT) + (size_t)(768 + hh * 128 + sl * 32 + r) * MTOK + (size_t)b * SEQ + 8 * h;
    const bf16_t* proj = (const bf16_t*)(c.ws + WS_PROJ); bf16_t* mix = (bf16_t*)(c.ws + WS_MIX);
    const float* gn = a->in[9] + (size_t)l * 128;
    LAS float* obuf = (LAS float*)c.lds;
    f32x16 S0, S1;
#pragma unroll
    for (int i = 0; i < 16; ++i) { S0[i] = 0.f; S1[i] = 0.f; }
    for (int ch = 0; ch < 32; ++ch) {
        const size_t t0 = (size_t)ch * 64;
        f32x16 x00, x01, x11, acc0, acc1;
#pragma unroll
        for (int i = 0; i < 16; ++i) { x00[i] = 0.f; x01[i] = 0.f; x11[i] = 0.f; acc0[i] = 0.f; acc1[i] = 0.f; }
#pragma unroll
        for (int ks = 0; ks < 4; ++ks) {
            const bf16x8 k0 = *(const bf16x8*)(KT + (t0 + r) * 64 + 16 * ks + 8 * h), k1 = *(const bf16x8*)(KT + (t0 + 32 + r) * 64 + 16 * ks + 8 * h);
            const bf16x8 q0 = *(const bf16x8*)(QT + (t0 + r) * 64 + 16 * ks + 8 * h), q1 = *(const bf16x8*)(QT + (t0 + 32 + r) * 64 + 16 * ks + 8 * h);
            x00 = MFMA32(k0, q0, x00); x01 = MFMA32(k0, q1, x01); x11 = MFMA32(k1, q1, x11);
        }
#pragma unroll
        for (int i = 0; i < 16; ++i) if (crow(i, h) > r) { x00[i] = 0.f; x11[i] = 0.f; }
        bf16x8 vb[4];
#pragma unroll
        for (int ts = 0; ts < 4; ++ts) vb[ts] = *(const bf16x8*)(VT + t0 + 16 * ts);
        acc0 = MFMA32(pack8(x00, 0), vb[0], acc0); acc0 = MFMA32(pack8(x00, 1), vb[1], acc0);
        acc1 = MFMA32(pack8(x01, 0), vb[0], acc1); acc1 = MFMA32(pack8(x01, 1), vb[1], acc1);
        acc1 = MFMA32(pack8(x11, 0), vb[2], acc1); acc1 = MFMA32(pack8(x11, 1), vb[3], acc1);
#pragma unroll
        for (int s = 0; s < 2; ++s) {
            const bf16x8 sb0 = pack8(S0, s), sb1 = pack8(S1, s);
            const bf16x8 qa00 = *(const bf16x8*)(QTP + (t0 + r) * 64 + 16 * s + 8 * h), qa01 = *(const bf16x8*)(QTP + (t0 + r) * 64 + 32 + 16 * s + 8 * h);
            const bf16x8 qa10 = *(const bf16x8*)(QTP + (t0 + 32 + r) * 64 + 16 * s + 8 * h), qa11 = *(const bf16x8*)(QTP + (t0 + 32 + r) * 64 + 32 + 16 * s + 8 * h);
            acc0 = MFMA32(qa00, sb0, acc0); acc0 = MFMA32(qa01, sb1, acc0);
            acc1 = MFMA32(qa10, sb0, acc1); acc1 = MFMA32(qa11, sb1, acc1);
        }
        const bf16_t* ktt = KTT + (size_t)ch * 4096;
#pragma unroll
        for (int ts = 0; ts < 4; ++ts) {
            const bf16x8 ka0 = *(const bf16x8*)(ktt + (size_t)r * 64 + 16 * ts + 8 * h), ka1 = *(const bf16x8*)(ktt + (size_t)(32 + r) * 64 + 16 * ts + 8 * h);
            S0 = MFMA32(ka0, vb[ts], S0); S1 = MFMA32(ka1, vb[ts], S1);
        }
        const float* el = EL + (size_t)ch * 64 + 4 * h;
#pragma unroll
        for (int q = 0; q < 4; ++q) { const f32x4 e0 = *(const f32x4*)(el + 8 * q), e1 = *(const f32x4*)(el + 32 + 8 * q);
            S0[4 * q] *= e0.x; S0[4 * q + 1] *= e0.y; S0[4 * q + 2] *= e0.z; S0[4 * q + 3] *= e0.w;
            S1[4 * q] *= e1.x; S1[4 * q + 1] *= e1.y; S1[4 * q + 2] *= e1.z; S1[4 * q + 3] *= e1.w; }
        __syncthreads();
        LAS float* ob = obuf + hw * 64 * 132 + sl * 32 + r;
#pragma unroll
        for (int i = 0; i < 16; ++i) { ob[crow(i, h) * 132] = acc0[i]; ob[(32 + crow(i, h)) * 132] = acc1[i]; }
        __syncthreads();
        for (int rr = 0; rr < 16; ++rr) {
            const int row = c.wave * 16 + rr, hd2 = row >> 6, i = row & 63;
            const int bh2 = 2 * g + hd2, b2 = bh2 >> 2, hh2 = bh2 & 3;
            const f32x2 v = *(const LAS f32x2*)(obuf + hd2 * 64 * 132 + i * 132 + 2 * c.lane);
            const float ss = wave_sum(v.x * v.x + v.y * v.y);
            const float rs = 1.f / sqrtf(ss * (1.f / 128.f) + LN_EPS);
            const size_t tok = (size_t)b2 * SEQ + t0 + i;
            const unsigned gw = *(const unsigned*)(proj + tok * PROJW + C_GR + hh2 * 128 + 2 * c.lane);
            const float g0 = bflo(gw), g1 = bfhi(gw);
            const f32x2 gv = *(const f32x2*)(gn + 2 * c.lane);
            const float o0 = v.x * rs * gv.x * (g0 * fsigmoid(g0)), o1 = v.y * rs * gv.y * (g1 * fsigmoid(g1));
            *(unsigned*)(mix + tok * DM + 768 + hh2 * 128 + 2 * c.lane) = pk_bf16(o0, o1);
        }
    }
    __syncthreads();
}

__device__ __forceinline__ void attn_phase(const Ctx& c, ArgsP a, int l) {
    if (c.bid < 8) gla_chain(c, a, l, c.bid);
    unsigned* ctr = (unsigned*)(c.ws + WS_CTL) + 64 * (1 + l);
    for (;;) {
        int t = 0;
        if (c.lane == 0) t = (int)atomicAdd(ctr, 1u);
        t = __builtin_amdgcn_readfirstlane(t);
        if (t >= 3072) break;
        const int qt = 63 - t / 48, rem = t % 48;
        if (rem < 24) diff_task(c, a, l, rem, qt); else moba_task(c, rem - 24, qt);
    }
}


#define XB_TMO      128
#define XB_XCNT(j)  (256  + 64 * (j))
#define XB_XSUB(j)  (1280 + 64 * (j))
#define XB_XGEN(j)  (2304 + 64 * (j))
#define XB_TOP      3328
#define XB_TOPGEN   3392
#define XB_SPIN_CAP (1u << 22)
__device__ __forceinline__ unsigned xb_ld(unsigned* p)              { return __hip_atomic_load(p, __ATOMIC_RELAXED, __HIP_MEMORY_SCOPE_AGENT); }
__device__ __forceinline__ unsigned xb_add(unsigned* p, unsigned v) { return __hip_atomic_fetch_add(p, v, __ATOMIC_RELAXED, __HIP_MEMORY_SCOPE_AGENT); }
__device__ __forceinline__ unsigned xb_xcc_id() { return (unsigned)__builtin_amdgcn_s_getreg((3 << 11) | 20) & 0xFu; }
#define XB_SPIN(cond, bar) do { unsigned _sp = 0; while (cond) { __builtin_amdgcn_s_sleep(1); \
    if ((++_sp & 255u) == 0u) { if (xb_ld(&(bar)[XB_TMO])) break; if (_sp > XB_SPIN_CAP) { atomicAdd(&(bar)[XB_TMO], 1u); break; } } } } while (0)
__device__ __forceinline__ void xcd_barrier_complete(unsigned* bar, unsigned x, unsigned G, unsigned& nloc, unsigned& nx) {
    unsigned sum, cnt, mine, sp = 0u;
    for (;;) {
        sum = 0u; cnt = 0u; mine = 0u;
#pragma unroll
        for (unsigned j = 0; j < 16; ++j) { const unsigned cc = xb_ld(&bar[XB_XCNT(j)]); sum += cc; cnt += (cc > 0u) ? 1u : 0u; mine = (j == x) ? cc : mine; }
        if (sum == G) break;
        __builtin_amdgcn_s_sleep(1);
        if ((++sp & 255u) == 0u) { if (xb_ld(&bar[XB_TMO])) break; if (sp > XB_SPIN_CAP) { atomicAdd(&bar[XB_TMO], 1u); break; } }
    }
    nloc = mine > 0u ? mine : 1u; nx = cnt > 0u ? cnt : 1u;
}
__device__ __forceinline__ void xcd_barrier(unsigned* bar, volatile LAS unsigned* st, unsigned G) {
    asm volatile("s_waitcnt vmcnt(0)" ::: "memory");
    __syncthreads();
    if (threadIdx.x == 0) {
        const unsigned x = xb_xcc_id();
        __builtin_amdgcn_s_waitcnt(0);
        unsigned nloc = st[0], nx = st[1];
        if (nloc == 0u) { xcd_barrier_complete(bar, x, G, nloc, nx); st[0] = nloc; st[1] = nx; }
        const unsigned old = xb_add(&bar[XB_XSUB(x)], 1u);
        const unsigned gen = old / nloc;
        if (old + 1u == (gen + 1u) * nloc) {
            __builtin_amdgcn_fence(__ATOMIC_RELEASE, "agent");
            asm volatile("s_waitcnt vmcnt(0)" ::: "memory");
            const unsigned og = xb_add(&bar[XB_TOP], 1u);
            const unsigned tg = og / nx;
            if (og + 1u == (tg + 1u) * nx) xb_add(&bar[XB_TOPGEN], 1u);
            else XB_SPIN(xb_ld(&bar[XB_TOPGEN]) == tg, bar);
            __builtin_amdgcn_fence(__ATOMIC_ACQUIRE, "agent");
            xb_add(&bar[XB_XGEN(x)], 1u);
            asm volatile("s_waitcnt vmcnt(0)" ::: "memory");
        } else {
            XB_SPIN(xb_ld(&bar[XB_XGEN(x)]) == gen, bar);
            __builtin_amdgcn_fence(__ATOMIC_ACQUIRE, "agent");
            asm volatile("s_waitcnt vmcnt(0)" ::: "memory");
        }
    }
    __syncthreads();
}

__global__ void __launch_bounds__(NTHREADS, 2) fwd_megakernel(Args args) {
    extern __shared__ __attribute__((aligned(16))) unsigned char lds_raw[];
    cg::grid_group grid = cg::this_grid();
    ArgsP ap0 = (ArgsP)__builtin_amdgcn_kernarg_segment_ptr();
    const int ph_lo = ap0->ph_lo, ph_hi = ap0->ph_hi, use_sync = ap0->use_sync;
    {
        volatile LAS unsigned* st0 = (volatile LAS unsigned*)((LAS unsigned char*)lds_raw + 131072 + 512);
        if (threadIdx.x == 0) { st0[0] = 0u; st0[1] = 0u; (void)xb_add((unsigned*)(ap0->ws + WS_CTL) + 4096 + XB_XCNT(xb_xcc_id()), 1u); }
        __syncthreads();
    }
    for (int ph = ph_lo; ph < ph_hi; ++ph) {
        if (ph > ph_lo && use_sync) {
            if (ph == ph_lo + 1) grid.sync();
            else xcd_barrier((unsigned*)(ap0->ws + WS_CTL) + 4096, (volatile LAS unsigned*)((LAS unsigned char*)lds_raw + 131072 + 512), gridDim.x);
        }
        ArgsP ap = ap0; asm volatile("" : "+s"(ap));
        int tid_ = threadIdx.x; asm volatile("" : "+v"(tid_));
        unsigned char* ws = ap->ws;
        int bid_ = blockIdx.x, G_ = gridDim.x; asm volatile("" : "+s"(bid_), "+s"(G_));
        Ctx c; c.tid = tid_; c.lane = c.tid & 63; c.wave = __builtin_amdgcn_readfirstlane(c.tid >> 6); c.G = G_; c.bid = bid_;
        c.gw = c.bid * NWAVES + c.wave; c.NGW = c.G * NWAVES; c.lds = (LAS unsigned char*)lds_raw; c.ws = ws;
        float* X = (float*)(ws + WS_X); bf16_t* XB = (bf16_t*)(ws + WS_XB); bf16_t* HB = (bf16_t*)(ws + WS_H); float* E1 = (float*)(ws + WS_H);
        bf16_t* PROJ = (bf16_t*)(ws + WS_PROJ); bf16_t* VT = (bf16_t*)(ws + WS_VT); bf16_t* MIX = (bf16_t*)(ws + WS_MIX);
        if (ph == 0) { prologue(ap, c); continue; }
        const int l = (ph - 1) / 13, s = (ph - 1) % 13;
        unsigned char* wl = ws + WS_W + (size_t)l * WL_SIZE;
        const float* lng = ap->in[18] + (size_t)l * 4 * DM; const float* lnb = ap->in[19] + (size_t)l * 4 * DM;
        const float* xsrc = (l == 0 && s <= 1) ? ap->in[0] : X;
        if (s == 0 || s == 8) {
            pg8::Gemm g{XB, (const bf16_t*)(wl + (s == 0 ? WL_GU1 : WL_GU2)), MTOK, 2 * FF, DM}; pg8::StaticOrder S; S.init(MTOK, 2 * FF, c.G, c.bid);
            pg8::EpiSwiGLU E{HB};
            pg8::gemm_phase<pg8::EpiSwiGLU, pg8::StaticOrder, true, true>(c.lds, g, S, E, c.tid);
        } else if (s == 1 || s == 9) {
            pg8::Gemm g{HB, (const bf16_t*)(wl + (s == 1 ? WL_D1 : WL_D2)), MTOK, DM, FF}; pg8::StaticOrder S; S.init(MTOK, DM, c.G, c.bid);
            pg8::EpiResid E{xsrc, X, ALPHA, 0.5f};
            pg8::gemm_phase<pg8::EpiResid, pg8::StaticOrder, false, true>(c.lds, g, S, E, c.tid);
        } else if (s == 2 || s == 7 || s == 10 || s == 12) {
            const int which = (s == 2) ? 0 : (s == 7) ? 1 : (s == 10) ? 2 : 3;
            const bool final_ln = (l == DEPTH - 1 && s == 12);
            ln_phase(c, X, final_ln ? ap->out : X, final_ln ? nullptr : XB, lng + which * DM, lnb + which * DM);
        } else if (s == 3) {
            { pg8::Gemm g{XB, (const bf16_t*)(wl + WL_IN), MTOK, PROJW, DM}; pg8::StaticOrder S; S.init(MTOK, PROJW, c.G, c.bid);
              pg8::EpiProj E{PROJ, (const float*)(ws + WS_R128), (const float*)(ws + WS_R64)};
              pg8::gemm_phase<pg8::EpiProj, pg8::StaticOrder, true, true>(c.lds, g, S, E, c.tid); }
            { pg8::Gemm g{(const bf16_t*)(wl + WL_V), XB, DM, MTOK, DM}; pg8::StaticOrder S; S.init(DM, MTOK, c.G, c.bid);
              pg8::EpiVt E{VT};
              pg8::gemm_phase<pg8::EpiVt, pg8::StaticOrder, false, true>(c.lds, g, S, E, c.tid); }
            gg_phase(c, XB, (const bf16_t*)(wl + WL_GG), (float*)(ws + WS_GG));
        } else if (s == 4) {
            post_phase(c, ap, l);
        } else if (s == 5) {
            attn_phase(c, ap, l);
        } else if (s == 6) {
            pg8::Gemm g{MIX, (const bf16_t*)(wl + WL_OUT), MTOK, DM, DM}; pg8::StaticOrder S; S.init(MTOK, DM, c.G, c.bid);
            pg8::EpiResid E{X, X, ALPHA, 1.0f};
            pg8::gemm_phase<pg8::EpiResid, pg8::StaticOrder, false, true>(c.lds, g, S, E, c.tid);
        } else if (s == 11) {
            { pg8::Gemm g{(const bf16_t*)(ws + WS_PB) + (size_t)l * MTOK * PLE, (const bf16_t*)(wl + WL_PE), MTOK, DM, PLE}; pg8::StaticOrder S; S.init(MTOK, DM, c.G, c.bid);
              pg8::EpiF32 E{E1};
              pg8::gemm_phase<pg8::EpiF32, pg8::StaticOrder, false, true>(c.lds, g, S, E, c.tid); }
            { pg8::Gemm g{XB, (const bf16_t*)(wl + WL_PG), MTOK, DM, DM}; pg8::StaticOrder S; S.init(MTOK, DM, c.G, c.bid);
              pg8::EpiGate E{X, X, E1, ALPHA};
              pg8::gemm_phase<pg8::EpiGate, pg8::StaticOrder, false, true>(c.lds, g, S, E, c.tid); }
        }
    }
}

extern "C" void kernel_launch(void* const* d_in, const int* in_sizes, int n_in, void* d_out, int out_size, void* d_ws, size_t ws_size, hipStream_t stream) {
    static int grid = 0;
    if (grid == 0) {
        if (n_in != 20 || in_sizes[0] != MTOK * DM || out_size != MTOK * DM || ws_size < WS_END) {
            fprintf(stderr, "kernel_launch: unexpected shapes (n_in %d, in0 %d, out %d, ws %zu need %zu)\n", n_in, n_in > 0 ? in_sizes[0] : -1, out_size, ws_size, (size_t)WS_END); grid = -1; return; }
        int dev = 0, cus = 0, per_cu = 0;
        hipGetDevice(&dev); hipDeviceGetAttribute(&cus, hipDeviceAttributeMultiprocessorCount, dev);
        hipFuncSetAttribute((const void*)fwd_megakernel, hipFuncAttributeMaxDynamicSharedMemorySize, LDS_BYTES);
        hipOccupancyMaxActiveBlocksPerMultiprocessor(&per_cu, (const void*)fwd_megakernel, NTHREADS, LDS_BYTES);
        if (per_cu < 1) { fprintf(stderr, "kernel_launch: occupancy query says %d blocks per CU\n", per_cu); per_cu = 1; }
        (void)hipGetLastError();
        grid = cus * per_cu;
        fprintf(stderr, "kernel_launch: grid %d (cus %d x %d)\n", grid, cus, per_cu);
    }
    if (grid < 0) return;
    hipMemsetAsync((char*)d_ws + WS_CTL, 0, 1 * MiB, stream);
    Args a{};
    for (int i = 0; i < 20; ++i) a.in[i] = (const float*)d_in[i];
    a.out = (float*)d_out; a.ws = (unsigned char*)d_ws; a.ph_lo = 0; a.ph_hi = 27; a.use_sync = 1; a.pad = 0;
    void* kargs[] = {&a};
    hipError_t e = hipLaunchCooperativeKernel((const void*)fwd_megakernel, dim3(grid), dim3(NTHREADS), kargs, LDS_BYTES, stream);
    if (e != hipSuccess) fprintf(stderr, "cooperative launch failed: %s (grid %d)\n", hipGetErrorString(e), grid);
}
```

```cpp
#include <hip/hip_runtime.h>
#include <hip/hip_cooperative_groups.h>
#include <cstdio>
#include <cstdint>
namespace cg = cooperative_groups;

#define LAS __attribute__((address_space(3)))
typedef unsigned short bf16_t;
typedef short bf16x8 __attribute__((ext_vector_type(8)));
typedef float f32x2 __attribute__((ext_vector_type(2)));
typedef float f32x4 __attribute__((ext_vector_type(4)));
typedef float f32x16 __attribute__((ext_vector_type(16)));
typedef unsigned u32x2 __attribute__((ext_vector_type(2)));
typedef unsigned u32x4 __attribute__((ext_vector_type(4)));

constexpr int NB = 4, SEQ = 2048, DM = 2048, MTOK = NB * SEQ, FF = 5632, DIN = 6160, PLE = 256, DEPTH = 2;
constexpr int PROJW = 4096;
constexpr int C_DQ = 0, C_DK = 768, C_MQ = 1536, C_MK = 2304, C_GQ = 3072, C_GK = 3328, C_GR = 3584;
constexpr int W_DQ = 0, W_DK = 768, W_DV = 1536, W_GQ = 2304, W_GK = 2560, W_GV = 2816, W_GR = 3328, W_GG = 3840, W_MQ = 3856, W_MK = 4624, W_MV = 5392;
constexpr float LN_EPS = 1e-5f;
constexpr float ALPHA = 1.4142135623730951f;
constexpr float LOG2E = 1.4426950408889634f;
constexpr float NEG_BIG = -1.0e30f;

constexpr size_t MiB = 1u << 20;
constexpr size_t WL_GU1 = 0, WL_D1 = 44 * MiB, WL_IN = 66 * MiB, WL_V = 82 * MiB, WL_OUT = 90 * MiB, WL_GU2 = 98 * MiB, WL_D2 = 142 * MiB, WL_PE = 164 * MiB, WL_PG = 165 * MiB, WL_GG = 173 * MiB, WL_SIZE = 174 * MiB;
constexpr size_t WS_CTL = 0;
constexpr size_t WS_W = 1 * MiB;
constexpr size_t WS_X = WS_W + 2 * WL_SIZE;
constexpr size_t WS_XB = WS_X + 64 * MiB;
constexpr size_t WS_H = WS_XB + 32 * MiB;
constexpr size_t WS_PROJ = WS_H + 88 * MiB;
constexpr size_t WS_VT = WS_PROJ + 64 * MiB;
constexpr size_t WS_MIX = WS_VT + 32 * MiB;
constexpr size_t WS_PB = WS_MIX + 32 * MiB;
constexpr size_t WS_R128 = WS_PB + 8 * MiB;
constexpr size_t WS_R64 = WS_R128 + 4 * MiB;
constexpr size_t WS_GG = WS_R64 + 2 * MiB;
constexpr size_t WS_QT = WS_GG + 1 * MiB;
constexpr size_t WS_KT = WS_QT + 4 * MiB;
constexpr size_t WS_KTT = WS_KT + 4 * MiB;
constexpr size_t WS_EL = WS_KTT + 4 * MiB;
constexpr size_t WS_KM = WS_EL + 1 * MiB;
constexpr size_t WS_OI = WS_KM + 1 * MiB;
constexpr size_t WS_DST = WS_OI + 16 * MiB;
constexpr size_t WS_SBT = WS_DST + 16 * MiB;
constexpr size_t WS_END = WS_SBT + 8 * MiB;

constexpr int LDS_BYTES = 147456;
constexpr int NWAVES = 8, NTHREADS = 512;

__device__ __forceinline__ float bf2f(bf16_t b) { return __uint_as_float(((unsigned)b) << 16); }
__device__ __forceinline__ float bflo(unsigned w) { return __uint_as_float(w << 16); }
__device__ __forceinline__ float bfhi(unsigned w) { return __uint_as_float(w & 0xffff0000u); }
typedef __bf16 bf16x2_t __attribute__((ext_vector_type(2)));
__device__ __forceinline__ unsigned pk_bf16(float lo, float hi) { f32x2 v = {lo, hi}; bf16x2_t b = __builtin_convertvector(v, bf16x2_t); return __builtin_bit_cast(unsigned, b); }
__device__ __forceinline__ float wave_sum(float v) {
#pragma unroll
    for (int o = 1; o < 64; o <<= 1) v += __shfl_xor(v, o);
    return v;
}
__device__ __forceinline__ float fexp2(float x) { return __builtin_amdgcn_exp2f(x); }
__device__ __forceinline__ float fsigmoid(float x) { return __builtin_amdgcn_rcpf(1.f + fexp2(-x * LOG2E)); }
__device__ __forceinline__ int crow(int reg, int h) { return (reg & 3) + 8 * (reg >> 2) + 4 * h; }
#define MFMA32(a, b, c) __builtin_amdgcn_mfma_f32_32x32x16_bf16((a), (b), (c), 0, 0, 0)
#define LDS_WAIT() asm volatile("s_waitcnt lgkmcnt(0)" ::: "memory")
__device__ __forceinline__ bf16x8 pack8(const f32x16& x, int s) {
    u32x4 p;
    p.x = pk_bf16(x[8 * s + 0], x[8 * s + 1]); p.y = pk_bf16(x[8 * s + 2], x[8 * s + 3]);
    p.z = pk_bf16(x[8 * s + 4], x[8 * s + 5]); p.w = pk_bf16(x[8 * s + 6], x[8 * s + 7]);
    return __builtin_bit_cast(bf16x8, p);
}

namespace pg8 {
constexpr int BM = 256, BK = 64, HALF = 128, HTB = HALF * BK * 2, STAGE_BYTES = 8 * HTB, NXCD = 8, WGM = 8;
__host__ __device__ __forceinline__ int lds_byte(int r, int c) { const int st = (r >> 4) * 2 + (c >> 5), rr = r & 15, cc = c & 31, ob = rr * 64 + cc * 2; return st * 1024 + (ob ^ (((ob >> 9) & 1) << 5)); }
__host__ __device__ __forceinline__ void stage_rc(int b, int& R, int& C) { const int st = b / 1024, sb = b % 1024, swz = sb ^ (((sb >> 9) & 1) << 5); R = (st >> 1) * 16 + swz / 64; C = (st & 1) * 32 + (swz % 64) / 2; }
__host__ __device__ __forceinline__ int perm32(int rho) { const int n = rho >> 4, i = rho & 15; return 8 * (i >> 2) + 4 * n + (i & 3); }
struct Unit { int pm, pn; };
struct Gemm { const bf16_t* A; const bf16_t* Bt; int M, N, K; };
struct StaticOrder {
    int nM, nN, nwg, G, c;
    __host__ __device__ void init(int M, int N, int G_, int c_) { nM = M / BM; nN = N / BM; nwg = nM * nN; G = G_; c = c_; }
    __host__ __device__ bool next(int i, Unit& u) const {
        const long L = (long)i * G + c; if (L >= nwg) return false;
        int wgid = (int)L; { const int q = nwg / NXCD, r = nwg % NXCD, xcd = wgid % NXCD, off = wgid / NXCD; wgid = (xcd < r ? xcd * (q + 1) : r * (q + 1) + (xcd - r) * q) + off; }
        const int nig = WGM * nN, gid = wgid / nig, fm = gid * WGM, gsz = (nM - fm) < WGM ? (nM - fm) : WGM;
        u.pm = fm + ((wgid % nig) % gsz); u.pn = (wgid % nig) / gsz; return true;
    }
    __device__ __forceinline__ void a_ready(const Unit&) const {}
    __device__ __forceinline__ void done(const Unit&) const {}
};

template <class Epi, class Sched, bool ALIGN_EPI = false, bool SP2 = false>
__device__ __forceinline__ void gemm_phase(LAS unsigned char* lds, const Gemm g, const Sched& S, const Epi& E, const int tid) {
    const int wid = __builtin_amdgcn_readfirstlane(tid >> 6), lane = tid & 63, wr = wid >> 2, wc = wid & 3, fr = lane & 15, fq = lane >> 4;
    const int K = g.K, nt = K / BK;
    unsigned voffA[2], voffB[2];
#pragma unroll
    for (int i = 0; i < 2; ++i) { int R, C; stage_rc(tid * 16 + i * 8192, R, C); const int Rb = Epi::PERM ? ((R & ~31) + perm32(R & 31)) : R;
        voffA[i] = (unsigned)(R * K + C) * 2u; voffB[i] = (unsigned)(Rb * K + C) * 2u; }
    const size_t kstep = (size_t)(BK * 2);
    const size_t hstep = (size_t)HALF * K * 2;
    const size_t tstep = 2 * hstep;
    const unsigned ldsw = (unsigned)wid * 1024u;
    const int aoff = lds_byte(wr * 64 + fr, fq * 8), boff = lds_byte(wc * 32 + fr, fq * 8);
#define PG8_SA(b, h) (((b) * 2 + (h)) * HTB)
#define PG8_SB(b, h) ((4 + (b) * 2 + (h)) * HTB)
#define PG8_STAGE(bufoff, gbase, voff) do { _Pragma("unroll") for (int _i = 0; _i < 2; ++_i) \
        __builtin_amdgcn_global_load_lds((const unsigned*)((const char*)(gbase) + (voff)[_i]), (LAS unsigned*)(lds + (bufoff) + ldsw + _i * 8192), 16, 0, 0); } while (0)
#define PG8_LDA(dst, b, h) do { _Pragma("unroll") for (int m = 0; m < 4; ++m) _Pragma("unroll") for (int k = 0; k < 2; ++k) dst[m][k] = *(const LAS bf16x8*)(lds + PG8_SA(b, h) + aoff + m * 2048 + k * 1024); } while (0)
#define PG8_LDB(dst, b, h) do { _Pragma("unroll") for (int n = 0; n < 2; ++n) _Pragma("unroll") for (int k = 0; k < 2; ++k) dst[n][k] = *(const LAS bf16x8*)(lds + PG8_SB(b, h) + boff + n * 2048 + k * 1024); } while (0)
#define PG8_MMA(ai, bj, At, Bt) do { __builtin_amdgcn_s_setprio(1); _Pragma("unroll") for (int m = 0; m < 4; ++m) _Pragma("unroll") for (int n = 0; n < 2; ++n) _Pragma("unroll") for (int k = 0; k < 2; ++k) \
        acc[ai][bj][m][n] = __builtin_amdgcn_mfma_f32_16x16x32_bf16(Bt[n][k], At[m][k], acc[ai][bj][m][n], 0, 0, 0); __builtin_amdgcn_s_setprio(0); } while (0)
#define PG8_WAIT_V(n) asm volatile("s_waitcnt vmcnt(" #n ")" ::: "memory")
#define PG8_WAIT_L(n) asm volatile("s_waitcnt lgkmcnt(" #n ")" ::: "memory")
#define PG8_BAR __builtin_amdgcn_s_barrier()
#define PG8_SCHED __builtin_amdgcn_sched_barrier(0)
    Unit cur, nxt; int ui = 0;
    if (!S.next(0, cur)) return;
    f32x4 acc[2][2][4][2];
#pragma unroll
    for (int a = 0; a < 2; ++a)
#pragma unroll
        for (int b = 0; b < 2; ++b)
#pragma unroll
            for (int m = 0; m < 4; ++m)
#pragma unroll
                for (int n = 0; n < 2; ++n) acc[a][b][m][n] = (f32x4){0.f, 0.f, 0.f, 0.f};
    bf16x8 At[4][2], B0[2][2], B1[2][2];
    const char* cA = (const char*)g.A + (size_t)cur.pm * tstep; const char* cB = (const char*)g.Bt + (size_t)cur.pn * tstep;
    S.a_ready(cur);
    if constexpr (SP2) {
        PG8_STAGE(PG8_SB(0, 0), cB, voffB); PG8_STAGE(PG8_SB(0, 1), cB + hstep, voffB); PG8_STAGE(PG8_SA(0, 0), cA, voffA); PG8_STAGE(PG8_SA(0, 1), cA + hstep, voffA);
        if (wr == 1) PG8_BAR;
        PG8_WAIT_V(2); PG8_BAR;
        PG8_STAGE(PG8_SB(1, 0), cB + kstep, voffB); PG8_STAGE(PG8_SA(1, 0), cA + kstep, voffA); PG8_STAGE(PG8_SB(1, 1), cB + hstep + kstep, voffB);
        PG8_WAIT_V(6); PG8_BAR;
    } else {
        PG8_STAGE(PG8_SB(0, 0), cB, voffB); PG8_STAGE(PG8_SA(0, 0), cA, voffA); PG8_STAGE(PG8_SB(0, 1), cB + hstep, voffB); PG8_STAGE(PG8_SA(0, 1), cA + hstep, voffA);
        if (wr == 1) PG8_BAR;
        PG8_WAIT_V(4); PG8_BAR;
        PG8_STAGE(PG8_SB(1, 0), cB + kstep, voffB); PG8_STAGE(PG8_SA(1, 0), cA + kstep, voffA); PG8_STAGE(PG8_SB(1, 1), cB + hstep + kstep, voffB);
        PG8_WAIT_V(6); PG8_BAR;
    }
    for (;;) {
        const bool has_next = S.next(ui + 1, nxt);
        const char* nA = has_next ? (const char*)g.A + (size_t)nxt.pm * tstep : cA; const char* nB = has_next ? (const char*)g.Bt + (size_t)nxt.pn * tstep : cB;
        for (int t = 0; t < nt; t += 2) {
            const bool last = (t == nt - 2);
            const char* a1 = cA + (size_t)(t + 1) * kstep;
            const char* a2 = last ? nA : cA + (size_t)(t + 2) * kstep; const char* b2 = last ? nB : cB + (size_t)(t + 2) * kstep;
            const char* a3 = a2 + kstep; const char* b3 = b2 + kstep;
            if (last && has_next) S.a_ready(nxt);
            if constexpr (SP2) {
            PG8_LDB(B0, 0, 0); PG8_LDB(B1, 0, 1); PG8_SCHED; PG8_LDA(At, 0, 0); PG8_STAGE(PG8_SA(1, 1), a1 + hstep, voffA);
            PG8_WAIT_V(8); PG8_WAIT_L(0); PG8_BAR; PG8_MMA(0, 0, At, B0); PG8_MMA(0, 1, At, B1); PG8_BAR; PG8_SCHED;
            PG8_LDA(At, 0, 1); PG8_STAGE(PG8_SB(0, 0), b2, voffB); PG8_STAGE(PG8_SB(0, 1), b2 + hstep, voffB); PG8_STAGE(PG8_SA(0, 0), a2, voffA);
            PG8_WAIT_V(8); PG8_WAIT_L(0); PG8_BAR; PG8_MMA(1, 0, At, B0); PG8_MMA(1, 1, At, B1); PG8_BAR; PG8_SCHED;
            PG8_LDB(B0, 1, 0); PG8_LDB(B1, 1, 1); PG8_SCHED; PG8_LDA(At, 1, 0); PG8_STAGE(PG8_SA(0, 1), a2 + hstep, voffA);
            PG8_WAIT_V(8); PG8_WAIT_L(0); PG8_BAR; PG8_MMA(0, 0, At, B0); PG8_MMA(0, 1, At, B1); PG8_BAR; PG8_SCHED;
            PG8_LDA(At, 1, 1); PG8_STAGE(PG8_SB(1, 0), b3, voffB); PG8_STAGE(PG8_SB(1, 1), b3 + hstep, voffB); PG8_STAGE(PG8_SA(1, 0), a3, voffA);
            PG8_WAIT_V(8); PG8_WAIT_L(0); PG8_BAR; PG8_MMA(1, 0, At, B0); PG8_MMA(1, 1, At, B1); PG8_BAR; PG8_SCHED;
            } else {
            PG8_LDB(B0, 0, 0); PG8_SCHED; PG8_LDA(At, 0, 0); PG8_STAGE(PG8_SA(1, 1), a1 + hstep, voffA);
            PG8_WAIT_L(8); PG8_BAR; PG8_WAIT_L(0); PG8_MMA(0, 0, At, B0); PG8_BAR; PG8_SCHED;
            PG8_LDB(B1, 0, 1); PG8_STAGE(PG8_SB(0, 0), b2, voffB);
            PG8_BAR; PG8_WAIT_L(0); PG8_MMA(0, 1, At, B1); PG8_BAR;
            PG8_LDA(At, 0, 1); PG8_STAGE(PG8_SA(0, 0), a2, voffA);
            PG8_BAR; PG8_WAIT_L(0); PG8_MMA(1, 0, At, B0); PG8_BAR; PG8_SCHED;
            PG8_STAGE(PG8_SB(0, 1), b2 + hstep, voffB);
            PG8_WAIT_V(6); PG8_BAR; PG8_MMA(1, 1, At, B1); PG8_BAR;
            PG8_LDB(B0, 1, 0); PG8_SCHED; PG8_LDA(At, 1, 0); PG8_STAGE(PG8_SA(0, 1), a2 + hstep, voffA);
            PG8_WAIT_L(8); PG8_BAR; PG8_WAIT_L(0); PG8_MMA(0, 0, At, B0); PG8_BAR; PG8_SCHED;
            PG8_LDB(B1, 1, 1); PG8_STAGE(PG8_SB(1, 0), b3, voffB);
            PG8_BAR; PG8_WAIT_L(0); PG8_MMA(0, 1, At, B1); PG8_BAR;
            PG8_LDA(At, 1, 1); PG8_STAGE(PG8_SA(1, 0), a3, voffA);
            PG8_BAR; PG8_WAIT_L(0); PG8_MMA(1, 0, At, B0); PG8_BAR; PG8_SCHED;
            PG8_STAGE(PG8_SB(1, 1), b3 + hstep, voffB);
            PG8_WAIT_V(6); PG8_BAR; PG8_MMA(1, 1, At, B1); PG8_BAR;
            }
        }
        if constexpr (ALIGN_EPI) { if (wr == 0) PG8_BAR; }
        E(acc, cur, wr, wc, fr, fq); S.done(cur);
        if (!has_next) break;
#pragma unroll
        for (int a = 0; a < 2; ++a)
#pragma unroll
            for (int b = 0; b < 2; ++b)
#pragma unroll
                for (int m = 0; m < 4; ++m)
#pragma unroll
                    for (int n = 0; n < 2; ++n) acc[a][b][m][n] = (f32x4){0.f, 0.f, 0.f, 0.f};
        cur = nxt; cA = nA; cB = nB; ++ui;
        if constexpr (ALIGN_EPI) { if (wr == 1) PG8_BAR; }
    }
    PG8_WAIT_V(0);
    if constexpr (!ALIGN_EPI) { if (wr == 0) PG8_BAR; }
    PG8_BAR;
#undef PG8_SA
#undef PG8_SB
#undef PG8_STAGE
#undef PG8_LDA
#undef PG8_LDB
#undef PG8_MMA
#undef PG8_WAIT_V
#undef PG8_WAIT_L
#undef PG8_BAR
#undef PG8_SCHED
}

typedef const f32x4 (&AccRef)[2][2][4][2];

struct EpiSwiGLU {
    static constexpr bool PERM = true;
    bf16_t* H;
    __device__ __forceinline__ void operator()(AccRef acc, const Unit& u, int wr, int wc, int fr, int fq) const {
        const int row0 = u.pm * BM + wr * 64 + fr, col0 = u.pn * 128 + wc * 32 + 8 * fq;
#pragma unroll
        for (int ai = 0; ai < 2; ++ai)
#pragma unroll
            for (int m = 0; m < 4; ++m) {
                float o[8];
#pragma unroll
                for (int n = 0; n < 2; ++n)
#pragma unroll
                    for (int j = 0; j < 4; ++j) { const float g = acc[ai][0][m][n][j], up = acc[ai][1][m][n][j]; o[4 * n + j] = g * fsigmoid(g) * up; }
                u32x4 w; w.x = pk_bf16(o[0], o[1]); w.y = pk_bf16(o[2], o[3]); w.z = pk_bf16(o[4], o[5]); w.w = pk_bf16(o[6], o[7]);
                *(u32x4*)(H + (size_t)(row0 + ai * HALF + m * 16) * FF + col0) = w;
            }
    }
};
struct EpiResid {
    static constexpr bool PERM = false;
    const float* src; float* dst; float alpha, beta;
    __device__ __forceinline__ void operator()(AccRef acc, const Unit& u, int wr, int wc, int fr, int fq) const {
        const int row0 = u.pm * BM + wr * 64 + fr, col0 = u.pn * BM + wc * 32 + 4 * fq;
#pragma unroll
        for (int ai = 0; ai < 2; ++ai)
#pragma unroll
            for (int m = 0; m < 4; ++m) { const size_t ro = (size_t)(row0 + ai * HALF + m * 16) * DM + col0;
#pragma unroll
                for (int bj = 0; bj < 2; ++bj)
#pragma unroll
                    for (int n = 0; n < 2; ++n) { const f32x4 xv = *(const f32x4*)(src + ro + bj * HALF + n * 16); *(f32x4*)(dst + ro + bj * HALF + n * 16) = xv * alpha + acc[ai][bj][m][n] * beta; } }
    }
};
struct EpiF32 {
    static constexpr bool PERM = false;
    float* C;
    __device__ __forceinline__ void operator()(AccRef acc, const Unit& u, int wr, int wc, int fr, int fq) const {
        const int row0 = u.pm * BM + wr * 64 + fr, col0 = u.pn * BM + wc * 32 + 4 * fq;
#pragma unroll
        for (int ai = 0; ai < 2; ++ai)
#pragma unroll
            for (int m = 0; m < 4; ++m) { const size_t ro = (size_t)(row0 + ai * HALF + m * 16) * DM + col0;
#pragma unroll
                for (int bj = 0; bj < 2; ++bj)
#pragma unroll
                    for (int n = 0; n < 2; ++n) *(f32x4*)(C + ro + bj * HALF + n * 16) = acc[ai][bj][m][n]; }
    }
};
struct EpiGate {
    static constexpr bool PERM = false;
    const float* src; float* dst; const float* E1; float alpha;
    __device__ __forceinline__ void operator()(AccRef acc, const Unit& u, int wr, int wc, int fr, int fq) const {
        const int row0 = u.pm * BM + wr * 64 + fr, col0 = u.pn * BM + wc * 32 + 4 * fq;
#pragma unroll
        for (int ai = 0; ai < 2; ++ai)
#pragma unroll
            for (int m = 0; m < 4; ++m) { const size_t ro = (size_t)(row0 + ai * HALF + m * 16) * DM + col0;
#pragma unroll
                for (int bj = 0; bj < 2; ++bj)
#pragma unroll
                    for (int n = 0; n < 2; ++n) { const size_t o = ro + bj * HALF + n * 16; const f32x4 xv = *(const f32x4*)(src + o), ev = *(const f32x4*)(E1 + o); const f32x4 a = acc[ai][bj][m][n];
                        f32x4 r; r.x = xv.x * alpha + ev.x * fsigmoid(a.x); r.y = xv.y * alpha + ev.y * fsigmoid(a.y); r.z = xv.z * alpha + ev.z * fsigmoid(a.z); r.w = xv.w * alpha + ev.w * fsigmoid(a.w);
                        *(f32x4*)(dst + o) = r; } }
    }
};
struct EpiVt {
    static constexpr bool PERM = false;
    bf16_t* VT;
    __device__ __forceinline__ void operator()(AccRef acc, const Unit& u, int wr, int wc, int fr, int fq) const {
        const int row0 = u.pm * BM + wr * 64 + fr, col0 = u.pn * BM + wc * 32 + 8 * (fq & 1) + 4 * (fq >> 1);
#pragma unroll
        for (int ai = 0; ai < 2; ++ai)
#pragma unroll
            for (int m = 0; m < 4; ++m) { bf16_t* rp = VT + (size_t)(row0 + ai * HALF + m * 16) * MTOK + col0;
#pragma unroll
                for (int bj = 0; bj < 2; ++bj)
#pragma unroll
                    for (int n = 0; n < 2; ++n) { const f32x4 a = acc[ai][bj][m][n]; u32x2 w; w.x = pk_bf16(a.x, a.y); w.y = pk_bf16(a.z, a.w); *(u32x2*)(rp + bj * HALF + n * 16) = w; } }
    }
};
struct EpiProj {
    static constexpr bool PERM = true;
    bf16_t* P; const float* rope128; const float* rope64;
    __device__ __forceinline__ void operator()(AccRef acc, const Unit& u, int wr, int wc, int fr, int fq) const {
        const int pn = u.pn, row0 = u.pm * BM + wr * 64 + fr;
        if (pn < 12) {
            const bool isdiff = pn < 6; const int pp = isdiff ? pn : pn - 6; const int g = pp / 3, tg = pp % 3;
            const float sc = (g == 0) ? (isdiff ? 0.125f * LOG2E : 0.08838834764831845f * LOG2E) : 1.f;
            int fbase, col1, half, rpitch; const float* rt0;
            if (isdiff) { fbase = 8 * fq; col1 = g * 768 + (tg * 4 + wc) * 64 + fbase; half = 32; rpitch = 64; rt0 = rope64; }
            else { fbase = 32 * (wc & 1) + 8 * fq; col1 = C_MQ + g * 768 + (tg * 2 + (wc >> 1)) * 128 + fbase; half = 64; rpitch = 128; rt0 = rope128; }
#pragma unroll
            for (int ai = 0; ai < 2; ++ai)
#pragma unroll
                for (int m = 0; m < 4; ++m) { const int row = row0 + ai * HALF + m * 16;
                    const f32x4* rt = (const f32x4*)(rt0 + (size_t)row * rpitch + 2 * fbase);
                    float o1[8], o2[8];
#pragma unroll
                    for (int q = 0; q < 4; ++q) { const f32x4 cs = rt[q];
#pragma unroll
                        for (int e = 0; e < 2; ++e) { const int idx = 2 * q + e; const float a = acc[ai][0][m][idx >> 2][idx & 3], b = acc[ai][1][m][idx >> 2][idx & 3];
                            const float c = e ? cs.z : cs.x, s = e ? cs.w : cs.y; o1[idx] = (a * c - b * s) * sc; o2[idx] = (b * c + a * s) * sc; } }
                    bf16_t* rp = P + (size_t)row * PROJW + col1;
                    u32x4 w; w.x = pk_bf16(o1[0], o1[1]); w.y = pk_bf16(o1[2], o1[3]); w.z = pk_bf16(o1[4], o1[5]); w.w = pk_bf16(o1[6], o1[7]); *(u32x4*)rp = w;
                    w.x = pk_bf16(o2[0], o2[1]); w.y = pk_bf16(o2[2], o2[3]); w.z = pk_bf16(o2[4], o2[5]); w.w = pk_bf16(o2[6], o2[7]); *(u32x4*)(rp + half) = w; }
        } else {
            const int col0 = C_GQ + (pn - 12) * 256 + wc * 32 + 8 * fq;
#pragma unroll
            for (int ai = 0; ai < 2; ++ai)
#pragma unroll
                for (int m = 0; m < 4; ++m) { bf16_t* rp = P + (size_t)(row0 + ai * HALF + m * 16) * PROJW + col0;
#pragma unroll
                    for (int bj = 0; bj < 2; ++bj) { const f32x4 v0 = acc[ai][bj][m][0], v1 = acc[ai][bj][m][1]; u32x4 w; w.x = pk_bf16(v0.x, v0.y); w.y = pk_bf16(v0.z, v0.w); w.z = pk_bf16(v1.x, v1.y); w.w = pk_bf16(v1.z, v1.w); *(u32x4*)(rp + bj * HALF) = w; } }
        }
    }
};
}

struct Args { const float* in[20]; float* out; unsigned char* ws; int ph_lo, ph_hi; int use_sync, pad; };

typedef const __attribute__((address_space(4))) Args* ArgsP;
struct Ctx { int tid, lane, wave, gw, NGW, G, bid; LAS unsigned char* lds; unsigned char* ws; };

__device__ __forceinline__ void transpose_item(const float* __restrict__ W, int ldw, int src_col0, bf16_t* WT, int K, int dst_row0, int k0, LAS float* scr, int lane) {
#pragma unroll 8
    for (int i = 0; i < 32; ++i) { const int kk = 2 * i + (lane >> 5); scr[kk * 33 + (lane & 31)] = W[(size_t)(k0 + kk) * ldw + src_col0 + (lane & 31)]; }
    LDS_WAIT();
    const int c = lane & 7;
#pragma unroll
    for (int j = 0; j < 4; ++j) { const int n = (lane >> 3) + 8 * j; const LAS float* s = scr + (8 * c) * 33 + n;
        u32x4 o; o.x = pk_bf16(s[0 * 33], s[1 * 33]); o.y = pk_bf16(s[2 * 33], s[3 * 33]); o.z = pk_bf16(s[4 * 33], s[5 * 33]); o.w = pk_bf16(s[6 * 33], s[7 * 33]);
        *(u32x4*)(WT + (size_t)(dst_row0 + n) * K + k0 + 8 * c) = o; }
    LDS_WAIT();
}
__device__ __forceinline__ int win_src_col(int gidx) {
    const int pn = gidx >> 3, w = gidx & 7;
    if (pn < 6) { const int g = pn / 3, tg = pn % 3, half = w >> 2, u = w & 3; return (g ? W_DK : W_DQ) + (tg * 4 + u) * 64 + half * 32; }
    if (pn < 12) { const int pp = pn - 6, g = pp / 3, tg = pp % 3, half = w >> 2, ww = w & 3; return (g ? W_MK : W_MQ) + (tg * 2 + (ww >> 1)) * 128 + half * 64 + (ww & 1) * 32; }
    if (pn == 12) return W_GQ + 32 * w;
    if (pn == 13) return W_GK + 32 * w;
    return W_GR + (pn - 14) * 256 + 32 * w;
}
__device__ __forceinline__ void prologue(ArgsP a, const Ctx& c) {
    LAS float* scr = (LAS float*)(c.lds + c.wave * 16384);
    constexpr int I_GU = 32 * 352, I_D = 88 * 64, I_IN = 32 * 128, I_SQ = 32 * 64, I_PE = 4 * 64;
    constexpr int PER_LAYER = 2 * I_GU + 2 * I_D + I_IN + 3 * I_SQ + I_PE;
    for (int it = c.gw; it < 2 * PER_LAYER; it += c.NGW) {
        const int l = it / PER_LAYER; int r = it - l * PER_LAYER;
        unsigned char* wl = c.ws + WS_W + (size_t)l * WL_SIZE;
        if (r < 2 * I_GU) {
            const int second = r >= I_GU; if (second) r -= I_GU;
            const int kb = r / 352, gidx = r % 352, pn = gidx >> 3, w = gidx & 7;
            const float* src = a->in[(second ? 13 : 10) + (w >> 2)] + (size_t)l * DM * FF;
            transpose_item(src, FF, 128 * pn + 32 * (w & 3), (bf16_t*)(wl + (second ? WL_GU2 : WL_GU1)), DM, 32 * gidx, 64 * kb, scr, c.lane); continue; }
        r -= 2 * I_GU;
        if (r < 2 * I_D) { const int second = r >= I_D; if (second) r -= I_D; const int kb = r / 64, nb = r % 64;
            transpose_item(a->in[second ? 15 : 12] + (size_t)l * FF * DM, DM, 32 * nb, (bf16_t*)(wl + (second ? WL_D2 : WL_D1)), FF, 32 * nb, 64 * kb, scr, c.lane); continue; }
        r -= 2 * I_D;
        if (r < I_IN) { const int kb = r / 128, gidx = r % 128;
            transpose_item(a->in[3] + (size_t)l * DM * DIN, DIN, win_src_col(gidx), (bf16_t*)(wl + WL_IN), DM, 32 * gidx, 64 * kb, scr, c.lane); continue; }
        r -= I_IN;
        if (r < I_SQ) { const int kb = r / 64, nb = r % 64, row0 = 32 * nb; const int sc = row0 < 768 ? W_DV + row0 : (row0 < 1280 ? W_GV + (row0 - 768) : W_MV + (row0 - 1280));
            transpose_item(a->in[3] + (size_t)l * DM * DIN, DIN, sc, (bf16_t*)(wl + WL_V), DM, row0, 64 * kb, scr, c.lane); continue; }
        r -= I_SQ;
        if (r < I_SQ) { const int kb = r / 64, nb = r % 64; transpose_item(a->in[4] + (size_t)l * DM * DM, DM, 32 * nb, (bf16_t*)(wl + WL_OUT), DM, 32 * nb, 64 * kb, scr, c.lane); continue; }
        r -= I_SQ;
        if (r < I_SQ) { const int kb = r / 64, nb = r % 64; transpose_item(a->in[17] + (size_t)l * DM * DM, DM, 32 * nb, (bf16_t*)(wl + WL_PG), DM, 32 * nb, 64 * kb, scr, c.lane); continue; }
        r -= I_SQ;
        { const int kb = r / 64, nb = r % 64; transpose_item(a->in[16] + (size_t)l * PLE * DM, DM, 32 * nb, (bf16_t*)(wl + WL_PE), PLE, 32 * nb, 64 * kb, scr, c.lane); }
    }
    { const float* x = a->in[0]; bf16_t* xb = (bf16_t*)(c.ws + WS_XB);
      for (int m = c.gw; m < MTOK; m += c.NGW) { const f32x4* xr = (const f32x4*)(x + (size_t)m * DM) + c.lane; u32x2* o = (u32x2*)(xb + (size_t)m * DM) + c.lane;
#pragma unroll
          for (int j = 0; j < 8; ++j) { const f32x4 v = xr[64 * j]; u32x2 w; w.x = pk_bf16(v.x, v.y); w.y = pk_bf16(v.z, v.w); o[64 * j] = w; } } }
    { const float* p = a->in[1]; bf16_t* pb = (bf16_t*)(c.ws + WS_PB);
      for (int m = c.gw; m < 2 * MTOK; m += c.NGW) { const f32x4 v = *((const f32x4*)(p + (size_t)m * PLE) + c.lane); u32x2 w; w.x = pk_bf16(v.x, v.y); w.y = pk_bf16(v.z, v.w); *((u32x2*)(pb + (size_t)m * PLE) + c.lane) = w; } }
    { const int* pos = (const int*)a->in[2]; float* r128 = (float*)(c.ws + WS_R128); float* r64 = (float*)(c.ws + WS_R64);
      const int gt = c.gw * 64 + c.lane, NT = c.NGW * 64;
      for (int idx = gt; idx < MTOK * 64; idx += NT) { const int m = idx >> 6, f = idx & 63;
          const float inv = exp2f(-(float)f * (13.287712379549449f / 64.f));
          const float ang = (float)pos[m] * inv;
          const double rev = (double)ang * 0.15915494309189535; const float fr = (float)(rev - rint(rev));
          const float cv = __builtin_amdgcn_cosf(fr), sv = __builtin_amdgcn_sinf(fr);
          r128[2 * idx] = cv; r128[2 * idx + 1] = sv;
          if ((f & 1) == 0) { const int i2 = m * 32 + (f >> 1); r64[2 * i2] = cv; r64[2 * i2 + 1] = sv; } } }
    { const int gt = c.gw * 64 + c.lane, NT = c.NGW * 64;
      for (int idx = gt; idx < 2 * 16 * DM; idx += NT) { const int l = idx / (16 * DM), rr = (idx / DM) & 15, k = idx % DM;
          ((bf16_t*)(c.ws + WS_W + (size_t)l * WL_SIZE + WL_GG))[rr * DM + k] = (bf16_t)(pk_bf16(a->in[3][(size_t)l * DM * DIN + (size_t)k * DIN + W_GG + rr], 0.f) & 0xffffu); } }
}

__device__ __forceinline__ void ln_phase(const Ctx& c, const float* z, float* xo, bf16_t* xbo, const float* g, const float* b) {
    for (int m = c.gw; m < MTOK; m += c.NGW) {
        const f32x4* zr = (const f32x4*)(z + (size_t)m * DM) + c.lane;
        f32x4 v[8]; float s = 0.f;
#pragma unroll
        for (int j = 0; j < 8; ++j) { v[j] = zr[64 * j]; s += (v[j].x + v[j].y) + (v[j].z + v[j].w); }
        const float mean = wave_sum(s) * (1.f / DM); float s2 = 0.f;
#pragma unroll
        for (int j = 0; j < 8; ++j) { v[j] = v[j] - mean; s2 += (v[j].x * v[j].x + v[j].y * v[j].y) + (v[j].z * v[j].z + v[j].w * v[j].w); }
        const float rstd = 1.f / sqrtf(wave_sum(s2) * (1.f / DM) + LN_EPS);
        f32x4* xr = (f32x4*)(xo + (size_t)m * DM) + c.lane;
#pragma unroll
        for (int j = 0; j < 8; ++j) { const f32x4 gv = ((const f32x4*)g)[c.lane + 64 * j], bv = ((const f32x4*)b)[c.lane + 64 * j]; const f32x4 o = v[j] * rstd * gv + bv; xr[64 * j] = o;
            if (xbo) { u32x2 w; w.x = pk_bf16(o.x, o.y); w.y = pk_bf16(o.z, o.w); ((u32x2*)(xbo + (size_t)m * DM) + c.lane)[64 * j] = w; } }
    }
}

__device__ __forceinline__ void gg_phase(const Ctx& c, const bf16_t* xb, const bf16_t* wgg, float* gg) {
    const int row = c.lane & 15, quad = c.lane >> 4;
    for (int t = c.gw; t < MTOK / 16; t += c.NGW) {
        f32x4 acc = {0.f, 0.f, 0.f, 0.f};
        const bf16_t* ap = xb + (size_t)(t * 16 + row) * DM + quad * 8; const bf16_t* bp = wgg + (size_t)row * DM + quad * 8;
#pragma unroll 8
        for (int k0 = 0; k0 < DM; k0 += 32) { const bf16x8 av = *(const bf16x8*)(ap + k0), bv = *(const bf16x8*)(bp + k0); acc = __builtin_amdgcn_mfma_f32_16x16x32_bf16(av, bv, acc, 0, 0, 0); }
#pragma unroll
        for (int j = 0; j < 4; ++j) gg[(size_t)(t * 16 + quad * 4 + j) * 16 + row] = acc[j];
    }
}

__device__ __forceinline__ int perm23(int t) { return (t & ~12) | ((t & 4) << 1) | ((t & 8) >> 1); }
__device__ __forceinline__ void post_phase(const Ctx& c, ArgsP a, int l) {
    const bf16_t* proj = (const bf16_t*)(c.ws + WS_PROJ); const float* gg = (const float*)(c.ws + WS_GG);
    bf16_t* QT = (bf16_t*)(c.ws + WS_QT); bf16_t* KT = (bf16_t*)(c.ws + WS_KT); bf16_t* KTT = (bf16_t*)(c.ws + WS_KTT);
    float* EL = (float*)(c.ws + WS_EL); bf16_t* KM = (bf16_t*)(c.ws + WS_KM);
    const float* gate_up = a->in[7] + (size_t)l * 16 * 256; const float* gate_b = a->in[8] + (size_t)l * 256;
    for (int task = c.gw; task < 512 + 192; task += c.NGW) {
        if (task < 512) {
            const int bh = task >> 5, ch = task & 31, b = bh >> 2, hh = bh & 3, k = c.lane;
            float up[16];
#pragma unroll
            for (int r = 0; r < 16; ++r) up[r] = gate_up[r * 256 + hh * 64 + k];
            const float bias = gate_b[hh * 64 + k];
            float cum = 0.f;
            const int tok0 = b * SEQ + ch * 64; const size_t rb = (size_t)bh * SEQ + ch * 64;
            for (int t8 = 0; t8 < 8; ++t8) {
                unsigned kk[8];
#pragma unroll
                for (int tt = 0; tt < 8; ++tt) { const int t = t8 * 8 + tt; const int tok = tok0 + t;
                    const f32x4* gp = (const f32x4*)(gg + (size_t)tok * 16);
                    float pre = bias;
#pragma unroll
                    for (int q = 0; q < 4; ++q) { const f32x4 gv = gp[q]; pre += gv.x * up[4 * q] + gv.y * up[4 * q + 1] + gv.z * up[4 * q + 2] + gv.w * up[4 * q + 3]; }
                    const float ls = fminf(pre, 0.f) - log1pf(expf(-fabsf(pre)));
                    cum += ls * (1.f / 16.f);
                    const float qv = bf2f(proj[(size_t)tok * PROJW + C_GQ + hh * 64 + k]), kv = bf2f(proj[(size_t)tok * PROJW + C_GK + hh * 64 + k]);
                    const float qt = qv * expf(cum) * 0.125f, kt = kv * expf(-cum);
                    const bf16_t qb = (bf16_t)(pk_bf16(qt, 0.f) & 0xffffu), kb = (bf16_t)(pk_bf16(kt, 0.f) & 0xffffu);
                    QT[(rb + t) * 64 + k] = qb; KT[(rb + t) * 64 + k] = kb; kk[tt] = kb; }
                bf16_t* dst = KTT + ((size_t)(bh * 32 + ch) * 64 + k) * 64 + (t8 >> 2) * 32;
                const int t8l = t8 & 3;
                u32x2 w0, w1; w0.x = kk[0] | (kk[1] << 16); w0.y = kk[2] | (kk[3] << 16); w1.x = kk[4] | (kk[5] << 16); w1.y = kk[6] | (kk[7] << 16);
                *(u32x2*)(dst + (t8l >> 1) * 16 + 0 * 8 + (t8l & 1) * 4) = w0;
                *(u32x2*)(dst + (t8l >> 1) * 16 + 1 * 8 + (t8l & 1) * 4) = w1;
            }
            EL[(size_t)(bh * 32 + ch) * 64 + k] = expf(cum);
            asm volatile("s_waitcnt vmcnt(0)" ::: "memory");
            {
                const int r = c.lane & 31, h = c.lane >> 5;
                const bf16_t* QTb = QT + rb * 64; const bf16_t* KTb = KT + rb * 64; const bf16_t* KTTb = KTT + (size_t)(bh * 32 + ch) * 4096;
                f32x16 x00, x01, x11;
#pragma unroll
                for (int i = 0; i < 16; ++i) { x00[i] = 0.f; x01[i] = 0.f; x11[i] = 0.f; }
#pragma unroll
                for (int ks = 0; ks < 4; ++ks) {
                    const bf16x8 k0 = *(const bf16x8*)(KTb + (size_t)r * 64 + 16 * ks + 8 * h), k1 = *(const bf16x8*)(KTb + (size_t)(32 + r) * 64 + 16 * ks + 8 * h);
                    const bf16x8 q0 = *(const bf16x8*)(QTb + (size_t)r * 64 + 16 * ks + 8 * h), q1 = *(const bf16x8*)(QTb + (size_t)(32 + r) * 64 + 16 * ks + 8 * h);
                    x00 = MFMA32(k0, q0, x00); x01 = MFMA32(k0, q1, x01); x11 = MFMA32(k1, q1, x11);
                }
#pragma unroll
                for (int i = 0; i < 16; ++i) if (crow(i, h) > r) { x00[i] = 0.f; x11[i] = 0.f; }
                const bf16x8 p00a = pack8(x00, 0), p00b = pack8(x00, 1), p01a = pack8(x01, 0), p01b = pack8(x01, 1), p11a = pack8(x11, 0), p11b = pack8(x11, 1);
                bf16x8 ka0[4], ka1[4];
#pragma unroll
                for (int ts = 0; ts < 4; ++ts) { ka0[ts] = *(const bf16x8*)(KTTb + (size_t)r * 64 + 16 * ts + 8 * h); ka1[ts] = *(const bf16x8*)(KTTb + (size_t)(32 + r) * 64 + 16 * ts + 8 * h); }
                float* OI = (float*)(c.ws + WS_OI) + (rb) * 128; float* DST = (float*)(c.ws + WS_DST) + (size_t)(bh * 32 + ch) * 8192;
                const bf16_t* VTb = (const bf16_t*)(c.ws + WS_VT) + (size_t)(768 + hh * 128 + r) * MTOK + (size_t)tok0 + 8 * h;
                for (int sl = 0; sl < 4; ++sl) {
                    bf16x8 vb[4];
#pragma unroll
                    for (int ts = 0; ts < 4; ++ts) vb[ts] = *(const bf16x8*)(VTb + (size_t)(32 * sl) * MTOK + 16 * ts);
                    f32x16 o0, o1, d0, d1;
#pragma unroll
                    for (int i = 0; i < 16; ++i) { o0[i] = 0.f; o1[i] = 0.f; d0[i] = 0.f; d1[i] = 0.f; }
                    o0 = MFMA32(vb[0], p00a, o0); o0 = MFMA32(vb[1], p00b, o0);
                    o1 = MFMA32(vb[0], p01a, o1); o1 = MFMA32(vb[1], p01b, o1); o1 = MFMA32(vb[2], p11a, o1); o1 = MFMA32(vb[3], p11b, o1);
#pragma unroll
                    for (int ts = 0; ts < 4; ++ts) { d0 = MFMA32(vb[ts], ka0[ts], d0); d1 = MFMA32(vb[ts], ka1[ts], d1); }
#pragma unroll
                    for (int q = 0; q < 4; ++q) { f32x4 v0, v1; v0.x = o0[4 * q]; v0.y = o0[4 * q + 1]; v0.z = o0[4 * q + 2]; v0.w = o0[4 * q + 3]; v1.x = o1[4 * q]; v1.y = o1[4 * q + 1]; v1.z = o1[4 * q + 2]; v1.w = o1[4 * q + 3];
                        *(f32x4*)(OI + (size_t)r * 128 + 32 * sl + 8 * q + 4 * h) = v0; *(f32x4*)(OI + (size_t)(32 + r) * 128 + 32 * sl + 8 * q + 4 * h) = v1; }
#pragma unroll
                    for (int i = 0; i < 16; ++i) { DST[(size_t)(32 * sl + crow(i, h)) * 64 + r] = d0[i]; DST[(size_t)(32 * sl + crow(i, h)) * 64 + 32 + r] = d1[i]; }
                }
            }
        } else {
            const int t2 = task - 512, b = t2 / 48, hd = (t2 / 8) % 6, blk = t2 & 7;
            const bf16_t* kp = proj + (size_t)(b * SEQ + blk * 256) * PROJW + C_MK + hd * 128 + 2 * c.lane;
            float s0 = 0.f, s1 = 0.f;
#pragma unroll 8
            for (int t = 0; t < 256; ++t) { const unsigned w = *(const unsigned*)(kp + (size_t)t * PROJW); s0 += bflo(w); s1 += bfhi(w); }
            *(unsigned*)(KM + (size_t)((b * 6 + hd) * 8 + blk) * 128 + 2 * c.lane) = pk_bf16(s0 * (1.f / 256.f), s1 * (1.f / 256.f));
        }
    }
}

template <int DQ, bool QLDS>
__device__ __forceinline__ void attn_pass(const bf16_t* qrow  , const bf16_t* kbase  , const bf16_t* vbase  ,
                                          int qt, int own, unsigned selmask, int r, int h, f32x16 (&O)[4], LAS unsigned char* wlds  ) {
    constexpr int NKS = DQ / 16;
    bf16x8 qf[QLDS ? 1 : NKS];
    if constexpr (QLDS) {
#pragma unroll
        for (int ks = 0; ks < NKS; ++ks) *(LAS bf16x8*)(wlds + ks * 1024) = *(const bf16x8*)(qrow + 16 * ks);
    } else {
#pragma unroll
        for (int ks = 0; ks < NKS; ++ks) qf[ks] = *(const bf16x8*)(qrow + 16 * ks);
    }
#pragma unroll
    for (int t = 0; t < 4; ++t)
#pragma unroll
        for (int i = 0; i < 16; ++i) O[t][i] = 0.f;
    unsigned bmask = 0u;
    for (int n = 0; n < own; ++n) if (__ballot((selmask >> n) & 1u) != 0ull) bmask |= 1u << n;
    bmask |= 0xffffff00u | (0xffu & ~((1u << own) - 1u));
    bmask = (unsigned)__builtin_amdgcn_readfirstlane((int)bmask);
    float m = NEG_BIG, l = 0.f;
    int kt = 8 * __builtin_ctz(bmask);
    bf16x8 kf[NKS];
    { const bf16_t* kp = kbase + (size_t)(kt * 32) * PROJW;
#pragma unroll
      for (int ks = 0; ks < NKS; ++ks) kf[ks] = *(const bf16x8*)(kp + 16 * ks); }
    while (kt <= qt) {
        int nk = kt + 1;
        if ((nk & 7) == 0) { const unsigned rem = bmask >> (nk >> 3); nk += 8 * __builtin_ctz(rem); }
        const int n = kt >> 3;
        const bool vis = (n >= own) || ((selmask >> n) & 1u);
        bf16x8 vf[8];
        const bf16_t* vp = vbase + kt * 32;
#pragma unroll
        for (int t = 0; t < 4; ++t) { vf[2 * t] = *(const bf16x8*)(vp + (size_t)(32 * t) * MTOK); vf[2 * t + 1] = *(const bf16x8*)(vp + (size_t)(32 * t) * MTOK + 16); }
        __builtin_amdgcn_sched_barrier(0);
        f32x16 s;
#pragma unroll
        for (int i = 0; i < 16; ++i) s[i] = 0.f;
        if constexpr (QLDS) {
            LAS unsigned char* ql = wlds; asm volatile("" : "+v"(ql));
#pragma unroll
            for (int ks = 0; ks < NKS; ++ks) { const bf16x8 qq = *(const LAS bf16x8*)(ql + ks * 1024); s = MFMA32(kf[ks], qq, s); }
        } else {
#pragma unroll
            for (int ks = 0; ks < NKS; ++ks) s = MFMA32(kf[ks], qf[ks], s);
        }
        __builtin_amdgcn_sched_barrier(0);
        { const int pk = nk <= qt ? nk : qt; const bf16_t* kp = kbase + (size_t)(pk * 32) * PROJW;
#pragma unroll
          for (int ks = 0; ks < NKS; ++ks) kf[ks] = *(const bf16x8*)(kp + 16 * ks); }
        __builtin_amdgcn_sched_barrier(0);
        if (kt == qt) {
#pragma unroll
            for (int i = 0; i < 16; ++i) if (crow(i, h) > r) s[i] = NEG_BIG;
        }
        if (!vis) {
#pragma unroll
            for (int i = 0; i < 16; ++i) s[i] = NEG_BIG;
        }
        float mx = s[0];
#pragma unroll
        for (int i = 1; i < 16; ++i) mx = fmaxf(mx, s[i]);
        mx = fmaxf(mx, __shfl_xor(mx, 32));
        if (__ballot(mx > m + 8.f) != 0ull) {
            const float mn = fmaxf(m, mx), alpha = fexp2(m - mn); m = mn; l *= alpha;
#pragma unroll
            for (int t = 0; t < 4; ++t) O[t] = O[t] * alpha;
        }
        float ls = 0.f;
#pragma unroll
        for (int i = 0; i < 16; ++i) { s[i] = fexp2(s[i] - m); ls += s[i]; }
        l += ls;
        const bf16x8 p0 = pack8(s, 0), p1 = pack8(s, 1);
#pragma unroll
        for (int t = 0; t < 4; ++t) { O[t] = MFMA32(vf[2 * t], p0, O[t]); O[t] = MFMA32(vf[2 * t + 1], p1, O[t]); }
        kt = nk;
    }
    l += __shfl_xor(l, 32);
    const float inv = 1.f / l;
#pragma unroll
    for (int t = 0; t < 4; ++t) O[t] = O[t] * inv;
}

__device__ __forceinline__ void store_o(bf16_t* orow  , const f32x16 (&O)[4]) {
#pragma unroll
    for (int t = 0; t < 4; ++t)
#pragma unroll
        for (int q = 0; q < 4; ++q) { u32x2 w; w.x = pk_bf16(O[t][4 * q], O[t][4 * q + 1]); w.y = pk_bf16(O[t][4 * q + 2], O[t][4 * q + 3]); *(u32x2*)(orow + 32 * t + 8 * q) = w; }
}

__device__ __forceinline__ void diff_task(const Ctx& c, ArgsP a, int l, int bh, int qt) {
    const int b = bh / 6, hd = bh % 6, r = c.lane & 31, h = c.lane >> 5;
    const bf16_t* proj = (const bf16_t*)(c.ws + WS_PROJ); const bf16_t* VT = (const bf16_t*)(c.ws + WS_VT); bf16_t* mix = (bf16_t*)(c.ws + WS_MIX);
    const float* lf = a->in[5] + (size_t)l * 256;
    const float d1 = wave_sum(lf[c.lane] * lf[64 + c.lane]), d2 = wave_sum(lf[128 + c.lane] * lf[192 + c.lane]);
    const float lam_init = 0.8f - 0.6f * expf(-0.3f * (float)l);
    const float lam = expf(d1) - expf(d2) + lam_init;
    const size_t tokq = (size_t)b * SEQ + qt * 32 + r;
    const bf16_t* kb = proj + ((size_t)b * SEQ + r) * PROJW + C_DK + hd * 128 + 8 * h;
    const bf16_t* vb = VT + (size_t)(hd * 128 + r) * MTOK + (size_t)b * SEQ + 8 * h;
    f32x16 O1[4];
    LAS unsigned char* wl = c.lds + c.wave * 16384 + c.lane * 16;
    {
        f32x16 O2[4];
        attn_pass<64, false>(proj + tokq * PROJW + C_DQ + hd * 128 + 64 + 8 * h, kb + 64, vb, qt, 0, 0u, r, h, O2, wl);
#pragma unroll
        for (int t = 0; t < 4; ++t)
#pragma unroll
            for (int q = 0; q < 4; ++q) { f32x4 v; v.x = O2[t][4 * q]; v.y = O2[t][4 * q + 1]; v.z = O2[t][4 * q + 2]; v.w = O2[t][4 * q + 3]; *(LAS f32x4*)(wl + (t * 4 + q) * 1024) = v; }
    }
    attn_pass<64, false>(proj + tokq * PROJW + C_DQ + hd * 128 + 8 * h, kb, vb, qt, 0, 0u, r, h, O1, wl);
    float ss = 0.f;
#pragma unroll
    for (int t = 0; t < 4; ++t)
#pragma unroll
        for (int q = 0; q < 4; ++q) { const f32x4 o2 = *(const LAS f32x4*)(wl + (t * 4 + q) * 1024);
            float v;
            v = O1[t][4 * q] - lam * o2.x; O1[t][4 * q] = v; ss += v * v;
            v = O1[t][4 * q + 1] - lam * o2.y; O1[t][4 * q + 1] = v; ss += v * v;
            v = O1[t][4 * q + 2] - lam * o2.z; O1[t][4 * q + 2] = v; ss += v * v;
            v = O1[t][4 * q + 3] - lam * o2.w; O1[t][4 * q + 3] = v; ss += v * v; }
    ss += __shfl_xor(ss, 32);
    const float rs = (1.f - lam_init) / sqrtf(ss * (1.f / 128.f) + LN_EPS);
    const float* gn = a->in[6] + (size_t)l * 128 + 4 * h;
#pragma unroll
    for (int t = 0; t < 4; ++t)
#pragma unroll
        for (int q = 0; q < 4; ++q) { const f32x4 gv = *(const f32x4*)(gn + 32 * t + 8 * q);
            O1[t][4 * q] *= rs * gv.x; O1[t][4 * q + 1] *= rs * gv.y; O1[t][4 * q + 2] *= rs * gv.z; O1[t][4 * q + 3] *= rs * gv.w; }
    store_o(mix + tokq * DM + hd * 128 + 4 * h, O1);
}

__device__ __forceinline__ void moba_task(const Ctx& c, int bh, int qt) {
    const int b = bh / 6, hd = bh % 6, r = c.lane & 31, h = c.lane >> 5;
    const bf16_t* proj = (const bf16_t*)(c.ws + WS_PROJ); const bf16_t* VT = (const bf16_t*)(c.ws + WS_VT); bf16_t* mix = (bf16_t*)(c.ws + WS_MIX);
    const bf16_t* KM = (const bf16_t*)(c.ws + WS_KM) + (size_t)(b * 6 + hd) * 8 * 128;
    const size_t tokq = (size_t)b * SEQ + qt * 32 + r;
    const bf16_t* qrow = proj + tokq * PROJW + C_MQ + hd * 128 + 8 * h;
    const int own = qt >> 3;
    unsigned selmask = 0u;
    if (own > 3) {
        f32x16 g;
#pragma unroll
        for (int i = 0; i < 16; ++i) g[i] = 0.f;
#pragma unroll
        for (int ks = 0; ks < 8; ++ks) { bf16x8 kf = {0, 0, 0, 0, 0, 0, 0, 0}; if (r < 8) kf = *(const bf16x8*)(KM + r * 128 + 16 * ks + 8 * h);
            const bf16x8 qf = *(const bf16x8*)(qrow + 16 * ks); g = MFMA32(kf, qf, g); }
        float gate[8];
#pragma unroll
        for (int i = 0; i < 4; ++i) { const float mine = g[i], other = __shfl_xor(mine, 32); gate[i] = h ? other : mine; gate[4 + i] = h ? mine : other; }
#pragma unroll
        for (int n = 0; n < 8; ++n) { int rank = 0;
#pragma unroll
            for (int mm = 0; mm < 8; ++mm) { if (mm == n) continue; const bool ahead = (gate[mm] > gate[n]) || (gate[mm] == gate[n] && mm < n); rank += (mm < own && ahead) ? 1 : 0; }
            if (n < own && rank < 3) selmask |= 1u << n; }
    } else selmask = 0xffu;
    f32x16 O[4];
    attn_pass<128, true>(qrow, proj + ((size_t)b * SEQ + r) * PROJW + C_MK + hd * 128 + 8 * h, VT + (size_t)(1280 + hd * 128 + r) * MTOK + (size_t)b * SEQ + 8 * h, qt, own, selmask, r, h, O, c.lds + c.wave * 16384 + c.lane * 16);
    store_o(mix + tokq * DM + 1280 + hd * 128 + 4 * h, O);
}

__device__ __forceinline__ void gla_scan_phase(const Ctx& c) {
    const float* DST = (const float*)(c.ws + WS_DST); const float* EL = (const float*)(c.ws + WS_EL); bf16_t* SBT = (bf16_t*)(c.ws + WS_SBT);
    for (int idx = c.gw * 64 + c.lane; idx < 16 * 8192; idx += c.NGW * 64) {
        const int bh = idx >> 13, e = idx & 8191, k = e & 63;
        float S = 0.f;
#pragma unroll 8
        for (int ch = 0; ch < 32; ++ch) {
            const size_t o = (size_t)(bh * 32 + ch) * 8192 + e;
            SBT[o] = (bf16_t)(pk_bf16(S, 0.f) & 0xffffu);
            S = EL[(size_t)(bh * 32 + ch) * 64 + k] * (S + DST[o]);
        }
    }
}
__device__ __forceinline__ void gla_final_task(const Ctx& c, ArgsP a, int l, int bh, int ch) {
    const int r = c.lane & 31, h = c.lane >> 5, b = bh >> 2, hh = bh & 3;
    const bf16_t* QT = (const bf16_t*)(c.ws + WS_QT) + ((size_t)bh * SEQ + ch * 64) * 64;
    const bf16_t* SBT = (const bf16_t*)(c.ws + WS_SBT) + (size_t)(bh * 32 + ch) * 8192;
    const float* OI = (const float*)(c.ws + WS_OI) + ((size_t)bh * SEQ + ch * 64) * 128;
    const bf16_t* proj = (const bf16_t*)(c.ws + WS_PROJ); bf16_t* mix = (bf16_t*)(c.ws + WS_MIX);
    const float* gn = a->in[9] + (size_t)l * 128 + 4 * h;
    for (int it = 0; it < 2; ++it) {
        f32x16 acc[4];
        const float* oi = OI + (size_t)(32 * it + r) * 128 + 4 * h;
#pragma unroll
        for (int dt = 0; dt < 4; ++dt)
#pragma unroll
            for (int q = 0; q < 4; ++q) { const f32x4 v = *(const f32x4*)(oi + 32 * dt + 8 * q); acc[dt][4 * q] = v.x; acc[dt][4 * q + 1] = v.y; acc[dt][4 * q + 2] = v.z; acc[dt][4 * q + 3] = v.w; }
#pragma unroll
        for (int ks = 0; ks < 4; ++ks) {
            const bf16x8 qf = *(const bf16x8*)(QT + (size_t)(32 * it + r) * 64 + 16 * ks + 8 * h);
#pragma unroll
            for (int dt = 0; dt < 4; ++dt) { const bf16x8 sf = *(const bf16x8*)(SBT + (size_t)(32 * dt + r) * 64 + 16 * ks + 8 * h); acc[dt] = MFMA32(sf, qf, acc[dt]); }
        }
        float ss = 0.f;
#pragma unroll
        for (int dt = 0; dt < 4; ++dt)
#pragma unroll
            for (int i = 0; i < 16; ++i) ss += acc[dt][i] * acc[dt][i];
        ss += __shfl_xor(ss, 32);
        const float rs = 1.f / sqrtf(ss * (1.f / 128.f) + LN_EPS);
        const size_t tok = (size_t)b * SEQ + ch * 64 + 32 * it + r;
        const bf16_t* gp = proj + tok * PROJW + C_GR + hh * 128 + 4 * h; bf16_t* mp = mix + tok * DM + 768 + hh * 128 + 4 * h;
#pragma unroll
        for (int dt = 0; dt < 4; ++dt)
#pragma unroll
            for (int q = 0; q < 4; ++q) { const u32x2 gw = *(const u32x2*)(gp + 32 * dt + 8 * q); const f32x4 gv = *(const f32x4*)(gn + 32 * dt + 8 * q);
                const float g0 = bflo(gw.x), g1 = bfhi(gw.x), g2 = bflo(gw.y), g3 = bfhi(gw.y);
                const float o0 = acc[dt][4 * q] * rs * gv.x * (g0 * fsigmoid(g0)), o1 = acc[dt][4 * q + 1] * rs * gv.y * (g1 * fsigmoid(g1));
                const float o2 = acc[dt][4 * q + 2] * rs * gv.z * (g2 * fsigmoid(g2)), o3 = acc[dt][4 * q + 3] * rs * gv.w * (g3 * fsigmoid(g3));
                u32x2 w; w.x = pk_bf16(o0, o1); w.y = pk_bf16(o2, o3); *(u32x2*)(mp + 32 * dt + 8 * q) = w; }
    }
}

__device__ __forceinline__ void attn_phase(const Ctx& c, ArgsP a, int l, int ctr_slot) {
    unsigned* ctr = (unsigned*)(c.ws + WS_CTL) + 64 * ctr_slot;
    for (;;) {
        int t = 0;
        if (c.lane == 0) t = (int)atomicAdd(ctr, 1u);
        t = __builtin_amdgcn_readfirstlane(t);
        if (t >= 3072 + 512) break;
        if (t >= 3072) { gla_final_task(c, a, l, (t - 3072) >> 5, (t - 3072) & 31); continue; }
        const int qt = 63 - t / 48, rem = t % 48;
        if (rem < 24) diff_task(c, a, l, rem, qt); else moba_task(c, rem - 24, qt);
    }
}

#define XB_TMO      128
#define XB_XCNT(j)  (256  + 64 * (j))
#define XB_XSUB(j)  (1280 + 64 * (j))
#define XB_XGEN(j)  (2304 + 64 * (j))
#define XB_TOP      3328
#define XB_TOPGEN   3392
#define XB_SPIN_CAP (1u << 22)
__device__ __forceinline__ unsigned xb_ld(unsigned* p)              { return __hip_atomic_load(p, __ATOMIC_RELAXED, __HIP_MEMORY_SCOPE_AGENT); }
__device__ __forceinline__ unsigned xb_add(unsigned* p, unsigned v) { return __hip_atomic_fetch_add(p, v, __ATOMIC_RELAXED, __HIP_MEMORY_SCOPE_AGENT); }
__device__ __forceinline__ unsigned xb_xcc_id() { return (unsigned)__builtin_amdgcn_s_getreg((3 << 11) | 20) & 0xFu; }
#define XB_SPIN(cond, bar) do { unsigned _sp = 0; while (cond) { __builtin_amdgcn_s_sleep(1); \
    if ((++_sp & 255u) == 0u) { if (xb_ld(&(bar)[XB_TMO])) break; if (_sp > XB_SPIN_CAP) { atomicAdd(&(bar)[XB_TMO], 1u); break; } } } } while (0)
__device__ __forceinline__ void xcd_barrier_complete(unsigned* bar, unsigned x, unsigned G, unsigned& nloc, unsigned& nx) {
    unsigned sum, cnt, mine, sp = 0u;
    for (;;) {
        sum = 0u; cnt = 0u; mine = 0u;
#pragma unroll
        for (unsigned j = 0; j < 16; ++j) { const unsigned cc = xb_ld(&bar[XB_XCNT(j)]); sum += cc; cnt += (cc > 0u) ? 1u : 0u; mine = (j == x) ? cc : mine; }
        if (sum == G) break;
        __builtin_amdgcn_s_sleep(1);
        if ((++sp & 255u) == 0u) { if (xb_ld(&bar[XB_TMO])) break; if (sp > XB_SPIN_CAP) { atomicAdd(&bar[XB_TMO], 1u); break; } }
    }
    nloc = mine > 0u ? mine : 1u; nx = cnt > 0u ? cnt : 1u;
}
__device__ __forceinline__ void xcd_barrier(unsigned* bar, volatile LAS unsigned* st, unsigned G) {
    asm volatile("s_waitcnt vmcnt(0)" ::: "memory");
    __syncthreads();
    if (threadIdx.x == 0) {
        const unsigned x = xb_xcc_id();
        __builtin_amdgcn_s_waitcnt(0);
        unsigned nloc = st[0], nx = st[1];
        if (nloc == 0u) { xcd_barrier_complete(bar, x, G, nloc, nx); st[0] = nloc; st[1] = nx; }
        const unsigned old = xb_add(&bar[XB_XSUB(x)], 1u);
        const unsigned gen = old / nloc;
        if (old + 1u == (gen + 1u) * nloc) {
            __builtin_amdgcn_fence(__ATOMIC_RELEASE, "agent");
            asm volatile("s_waitcnt vmcnt(0)" ::: "memory");
            const unsigned og = xb_add(&bar[XB_TOP], 1u);
            const unsigned tg = og / nx;
            if (og + 1u == (tg + 1u) * nx) xb_add(&bar[XB_TOPGEN], 1u);
            else XB_SPIN(xb_ld(&bar[XB_TOPGEN]) == tg, bar);
            __builtin_amdgcn_fence(__ATOMIC_ACQUIRE, "agent");
            xb_add(&bar[XB_XGEN(x)], 1u);
            asm volatile("s_waitcnt vmcnt(0)" ::: "memory");
        } else {
            XB_SPIN(xb_ld(&bar[XB_XGEN(x)]) == gen, bar);
            __builtin_amdgcn_fence(__ATOMIC_ACQUIRE, "agent");
            asm volatile("s_waitcnt vmcnt(0)" ::: "memory");
        }
    }
    __syncthreads();
}

__global__ void __launch_bounds__(NTHREADS, 2) fwd_megakernel(Args args) {
    extern __shared__ __attribute__((aligned(16))) unsigned char lds_raw[];
    cg::grid_group grid = cg::this_grid();
    ArgsP ap0 = (ArgsP)__builtin_amdgcn_kernarg_segment_ptr();
    const int ph_lo = ap0->ph_lo, ph_hi = ap0->ph_hi, use_sync = ap0->use_sync;
    {
        volatile LAS unsigned* st0 = (volatile LAS unsigned*)((LAS unsigned char*)lds_raw + 131072 + 512);
        if (threadIdx.x == 0) { st0[0] = 0u; st0[1] = 0u; (void)xb_add((unsigned*)(ap0->ws + WS_CTL) + 4096 + XB_XCNT(xb_xcc_id()), 1u); }
        __syncthreads();
    }
    for (int ph = ph_lo; ph < ph_hi; ++ph) {
        if (ph > ph_lo && use_sync) {
            if (ph == ph_lo + 1) grid.sync();
            else xcd_barrier((unsigned*)(ap0->ws + WS_CTL) + 4096, (volatile LAS unsigned*)((LAS unsigned char*)lds_raw + 131072 + 512), gridDim.x);
        }
        ArgsP ap = ap0; asm volatile("" : "+s"(ap));
        int tid_ = threadIdx.x; asm volatile("" : "+v"(tid_));
        unsigned char* ws = ap->ws;
        int bid_ = blockIdx.x, G_ = gridDim.x; asm volatile("" : "+s"(bid_), "+s"(G_));
        Ctx c; c.tid = tid_; c.lane = c.tid & 63; c.wave = __builtin_amdgcn_readfirstlane(c.tid >> 6); c.G = G_; c.bid = bid_;
        c.gw = c.bid * NWAVES + c.wave; c.NGW = c.G * NWAVES; c.lds = (LAS unsigned char*)lds_raw; c.ws = ws;
        float* X = (float*)(ws + WS_X); bf16_t* XB = (bf16_t*)(ws + WS_XB); bf16_t* HB = (bf16_t*)(ws + WS_H); float* E1 = (float*)(ws + WS_H);
        bf16_t* PROJ = (bf16_t*)(ws + WS_PROJ); bf16_t* VT = (bf16_t*)(ws + WS_VT); bf16_t* MIX = (bf16_t*)(ws + WS_MIX);
        if (ph == 0) { prologue(ap, c);
#ifdef DUP_PROLOGUE
            prologue(ap, c);
#endif
            continue; }
        const int l = (ph - 1) / 14; int s = (ph - 1) % 14;
        if (s == 5) { gla_scan_phase(c); continue; }
        if (s > 5) --s;
        unsigned char* wl = ws + WS_W + (size_t)l * WL_SIZE;
        const float* lng = ap->in[18] + (size_t)l * 4 * DM; const float* lnb = ap->in[19] + (size_t)l * 4 * DM;
        const float* xsrc = (l == 0 && s <= 1) ? ap->in[0] : X;
        if (s == 0 || s == 8) {
            pg8::Gemm g{XB, (const bf16_t*)(wl + (s == 0 ? WL_GU1 : WL_GU2)), MTOK, 2 * FF, DM}; pg8::StaticOrder S; S.init(MTOK, 2 * FF, c.G, c.bid);
            pg8::EpiSwiGLU E{HB};
            pg8::gemm_phase<pg8::EpiSwiGLU, pg8::StaticOrder, true, true>(c.lds, g, S, E, c.tid);
#ifdef DUP_GU
            if (s == 0) pg8::gemm_phase<pg8::EpiSwiGLU, pg8::StaticOrder, true, true>(c.lds, g, S, E, c.tid);
#endif
        } else if (s == 1 || s == 9) {
            pg8::Gemm g{HB, (const bf16_t*)(wl + (s == 1 ? WL_D1 : WL_D2)), MTOK, DM, FF}; pg8::StaticOrder S; S.init(MTOK, DM, c.G, c.bid);
            pg8::EpiResid E{xsrc, X, ALPHA, 0.5f};
            pg8::gemm_phase<pg8::EpiResid, pg8::StaticOrder, false, true>(c.lds, g, S, E, c.tid);
        } else if (s == 2 || s == 7 || s == 10 || s == 12) {
            const int which = (s == 2) ? 0 : (s == 7) ? 1 : (s == 10) ? 2 : 3;
            const bool final_ln = (l == DEPTH - 1 && s == 12);
            ln_phase(c, X, final_ln ? ap->out : X, final_ln ? nullptr : XB, lng + which * DM, lnb + which * DM);
        } else if (s == 3) {
            { pg8::Gemm g{XB, (const bf16_t*)(wl + WL_IN), MTOK, PROJW, DM}; pg8::StaticOrder S; S.init(MTOK, PROJW, c.G, c.bid);
              pg8::EpiProj E{PROJ, (const float*)(ws + WS_R128), (const float*)(ws + WS_R64)};
              pg8::gemm_phase<pg8::EpiProj, pg8::StaticOrder, true, true>(c.lds, g, S, E, c.tid);
#ifdef DUP_IN
              pg8::gemm_phase<pg8::EpiProj, pg8::StaticOrder, true, true>(c.lds, g, S, E, c.tid);
#endif
            }
            { pg8::Gemm g{(const bf16_t*)(wl + WL_V), XB, DM, MTOK, DM}; pg8::StaticOrder S; S.init(DM, MTOK, c.G, c.bid);
              pg8::EpiVt E{VT};
              pg8::gemm_phase<pg8::EpiVt, pg8::StaticOrder, false, true>(c.lds, g, S, E, c.tid); }
            gg_phase(c, XB, (const bf16_t*)(wl + WL_GG), (float*)(ws + WS_GG));
        } else if (s == 4) {
            post_phase(c, ap, l);
#ifdef DUP_POST
            post_phase(c, ap, l);
#endif
        } else if (s == 5) {
            attn_phase(c, ap, l, 1 + l);
#ifdef DUP_ATTN
            attn_phase(c, ap, l, 3 + l);
#endif
        } else if (s == 6) {
            pg8::Gemm g{MIX, (const bf16_t*)(wl + WL_OUT), MTOK, DM, DM}; pg8::StaticOrder S; S.init(MTOK, DM, c.G, c.bid);
            pg8::EpiResid E{X, X, ALPHA, 1.0f};
            pg8::gemm_phase<pg8::EpiResid, pg8::StaticOrder, false, true>(c.lds, g, S, E, c.tid);
        } else if (s == 11) {
            { pg8::Gemm g{(const bf16_t*)(ws + WS_PB) + (size_t)l * MTOK * PLE, (const bf16_t*)(wl + WL_PE), MTOK, DM, PLE}; pg8::StaticOrder S; S.init(MTOK, DM, c.G, c.bid);
              pg8::EpiF32 E{E1};
              pg8::gemm_phase<pg8::EpiF32, pg8::StaticOrder, false, true>(c.lds, g, S, E, c.tid); }
            { pg8::Gemm g{XB, (const bf16_t*)(wl + WL_PG), MTOK, DM, DM}; pg8::StaticOrder S; S.init(MTOK, DM, c.G, c.bid);
              pg8::EpiGate E{X, X, E1, ALPHA};
              pg8::gemm_phase<pg8::EpiGate, pg8::StaticOrder, false, true>(c.lds, g, S, E, c.tid); }
        }
    }
}

extern "C" void kernel_launch(void* const* d_in, const int* in_sizes, int n_in, void* d_out, int out_size, void* d_ws, size_t ws_size, hipStream_t stream) {
    static int grid = 0;
    if (grid == 0) {
        if (n_in != 20 || in_sizes[0] != MTOK * DM || out_size != MTOK * DM || ws_size < WS_END) {
            fprintf(stderr, "kernel_launch: unexpected shapes (n_in %d, in0 %d, out %d, ws %zu need %zu)\n", n_in, n_in > 0 ? in_sizes[0] : -1, out_size, ws_size, (size_t)WS_END); grid = -1; return; }
        int dev = 0, cus = 0, per_cu = 0;
        hipGetDevice(&dev); hipDeviceGetAttribute(&cus, hipDeviceAttributeMultiprocessorCount, dev);
        hipFuncSetAttribute((const void*)fwd_megakernel, hipFuncAttributeMaxDynamicSharedMemorySize, LDS_BYTES);
        hipOccupancyMaxActiveBlocksPerMultiprocessor(&per_cu, (const void*)fwd_megakernel, NTHREADS, LDS_BYTES);
        if (per_cu < 1) { fprintf(stderr, "kernel_launch: occupancy query says %d blocks per CU\n", per_cu); per_cu = 1; }
        (void)hipGetLastError();
        grid = cus * per_cu;
        fprintf(stderr, "kernel_launch: grid %d (cus %d x %d)\n", grid, cus, per_cu);
    }
    if (grid < 0) return;
    hipMemsetAsync((char*)d_ws + WS_CTL, 0, 1 * MiB, stream);
    Args a{};
    for (int i = 0; i < 20; ++i) a.in[i] = (const float*)d_in[i];
    a.out = (float*)d_out; a.ws = (unsigned char*)d_ws; a.ph_lo = 0; a.ph_hi = 29; a.use_sync = 1; a.pad = 0;
    void* kargs[] = {&a};
    hipError_t e = hipLaunchCooperativeKernel((const void*)fwd_megakernel, dim3(grid), dim3(NTHREADS), kargs, LDS_BYTES, stream);
    if (e != hipSuccess) fprintf(stderr, "cooperative launch failed: %s (grid %d)\n", hipGetErrorString(e), grid);
}
```

```cpp
#include <hip/hip_runtime.h>
#include <hip/hip_cooperative_groups.h>
#include <cstdio>
#include <cstdint>
namespace cg = cooperative_groups;

#define LAS __attribute__((address_space(3)))
typedef unsigned short bf16_t;
typedef short bf16x8 __attribute__((ext_vector_type(8)));
typedef float f32x2 __attribute__((ext_vector_type(2)));
typedef float f32x4 __attribute__((ext_vector_type(4)));
typedef float f32x16 __attribute__((ext_vector_type(16)));
typedef unsigned u32x2 __attribute__((ext_vector_type(2)));
typedef unsigned u32x4 __attribute__((ext_vector_type(4)));

constexpr int NB = 4, SEQ = 2048, DM = 2048, MTOK = NB * SEQ, FF = 5632, DIN = 6160, PLE = 256, DEPTH = 2;
constexpr int PROJW = 4096;
constexpr int C_DQ = 0, C_DK = 768, C_MQ = 1536, C_MK = 2304, C_GQ = 3072, C_GK = 3328, C_GR = 3584;
constexpr int W_DQ = 0, W_DK = 768, W_DV = 1536, W_GQ = 2304, W_GK = 2560, W_GV = 2816, W_GR = 3328, W_GG = 3840, W_MQ = 3856, W_MK = 4624, W_MV = 5392;
constexpr float LN_EPS = 1e-5f;
constexpr float ALPHA = 1.4142135623730951f;
constexpr float LOG2E = 1.4426950408889634f;
constexpr float NEG_BIG = -1.0e30f;

constexpr size_t MiB = 1u << 20;
constexpr size_t WL_GU1 = 0, WL_D1 = 44 * MiB, WL_IN = 66 * MiB, WL_V = 82 * MiB, WL_OUT = 90 * MiB, WL_GU2 = 98 * MiB, WL_D2 = 142 * MiB, WL_PE = 164 * MiB, WL_PG = 165 * MiB, WL_GG = 173 * MiB, WL_SIZE = 174 * MiB;
constexpr size_t WS_CTL = 0;
constexpr size_t WS_W = 1 * MiB;
constexpr size_t WS_X = WS_W + 2 * WL_SIZE;
constexpr size_t WS_XB = WS_X + 64 * MiB;
constexpr size_t WS_H = WS_XB + 32 * MiB;
constexpr size_t WS_PROJ = WS_H + 88 * MiB;
constexpr size_t WS_VT = WS_PROJ + 64 * MiB;
constexpr size_t WS_MIX = WS_VT + 32 * MiB;
constexpr size_t WS_PB = WS_MIX + 32 * MiB;
constexpr size_t WS_R128 = WS_PB + 8 * MiB;
constexpr size_t WS_R64 = WS_R128 + 4 * MiB;
constexpr size_t WS_GG = WS_R64 + 2 * MiB;
constexpr size_t WS_QT = WS_GG + 1 * MiB;
constexpr size_t WS_KT = WS_QT + 4 * MiB;
constexpr size_t WS_KTT = WS_KT + 4 * MiB;
constexpr size_t WS_EL = WS_KTT + 4 * MiB;
constexpr size_t WS_KM = WS_EL + 1 * MiB;
constexpr size_t WS_OI = WS_KM + 1 * MiB;
constexpr size_t WS_DST = WS_OI + 16 * MiB;
constexpr size_t WS_SBT = WS_DST + 16 * MiB;
constexpr size_t WS_END = WS_SBT + 8 * MiB;

constexpr int LDS_BYTES = 147456;
constexpr int NWAVES = 8, NTHREADS = 512;

__device__ __forceinline__ float bf2f(bf16_t b) { return __uint_as_float(((unsigned)b) << 16); }
__device__ __forceinline__ float bflo(unsigned w) { return __uint_as_float(w << 16); }
__device__ __forceinline__ float bfhi(unsigned w) { return __uint_as_float(w & 0xffff0000u); }
typedef __bf16 bf16x2_t __attribute__((ext_vector_type(2)));
__device__ __forceinline__ unsigned pk_bf16(float lo, float hi) { f32x2 v = {lo, hi}; bf16x2_t b = __builtin_convertvector(v, bf16x2_t); return __builtin_bit_cast(unsigned, b); }
__device__ __forceinline__ float wave_sum(float v) {
#pragma unroll
    for (int o = 1; o < 64; o <<= 1) v += __shfl_xor(v, o);
    return v;
}
__device__ __forceinline__ float fexp2(float x) { return __builtin_amdgcn_exp2f(x); }
__device__ __forceinline__ float fsigmoid(float x) { return __builtin_amdgcn_rcpf(1.f + fexp2(-x * LOG2E)); }
__device__ __forceinline__ int crow(int reg, int h) { return (reg & 3) + 8 * (reg >> 2) + 4 * h; }
#define MFMA32(a, b, c) __builtin_amdgcn_mfma_f32_32x32x16_bf16((a), (b), (c), 0, 0, 0)
#define LDS_WAIT() asm volatile("s_waitcnt lgkmcnt(0)" ::: "memory")
__device__ __forceinline__ bf16x8 pack8(const f32x16& x, int s) {
    u32x4 p;
    p.x = pk_bf16(x[8 * s + 0], x[8 * s + 1]); p.y = pk_bf16(x[8 * s + 2], x[8 * s + 3]);
    p.z = pk_bf16(x[8 * s + 4], x[8 * s + 5]); p.w = pk_bf16(x[8 * s + 6], x[8 * s + 7]);
    return __builtin_bit_cast(bf16x8, p);
}

namespace pg8 {
constexpr int BM = 256, BK = 64, HALF = 128, HTB = HALF * BK * 2, STAGE_BYTES = 8 * HTB, NXCD = 8, WGM = 8;
__host__ __device__ __forceinline__ int lds_byte(int r, int c) { const int st = (r >> 4) * 2 + (c >> 5), rr = r & 15, cc = c & 31, ob = rr * 64 + cc * 2; return st * 1024 + (ob ^ (((ob >> 9) & 1) << 5)); }
__host__ __device__ __forceinline__ void stage_rc(int b, int& R, int& C) { const int st = b / 1024, sb = b % 1024, swz = sb ^ (((sb >> 9) & 1) << 5); R = (st >> 1) * 16 + swz / 64; C = (st & 1) * 32 + (swz % 64) / 2; }
__host__ __device__ __forceinline__ int perm32(int rho) { const int n = rho >> 4, i = rho & 15; return 8 * (i >> 2) + 4 * n + (i & 3); }
struct Unit { int pm, pn; };
struct Gemm { const bf16_t* A; const bf16_t* Bt; int M, N, K; };
struct StaticOrder {
    int nM, nN, nwg, G, c;
    __host__ __device__ void init(int M, int N, int G_, int c_) { nM = M / BM; nN = N / BM; nwg = nM * nN; G = G_; c = c_; }
    __host__ __device__ bool next(int i, Unit& u) const {
        const long L = (long)i * G + c; if (L >= nwg) return false;
        int wgid = (int)L; { const int q = nwg / NXCD, r = nwg % NXCD, xcd = wgid % NXCD, off = wgid / NXCD; wgid = (xcd < r ? xcd * (q + 1) : r * (q + 1) + (xcd - r) * q) + off; }
        const int nig = WGM * nN, gid = wgid / nig, fm = gid * WGM, gsz = (nM - fm) < WGM ? (nM - fm) : WGM;
        u.pm = fm + ((wgid % nig) % gsz); u.pn = (wgid % nig) / gsz; return true;
    }
    __device__ __forceinline__ void a_ready(const Unit&) const {}
    __device__ __forceinline__ void done(const Unit&) const {}
};

template <class Epi, class Sched, bool ALIGN_EPI = false, bool SP2 = false>
__device__ __forceinline__ void gemm_phase(LAS unsigned char* lds, const Gemm g, const Sched& S, const Epi& E, const int tid) {
    const int wid = __builtin_amdgcn_readfirstlane(tid >> 6), lane = tid & 63, wr = wid >> 2, wc = wid & 3, fr = lane & 15, fq = lane >> 4;
    const int K = g.K, nt = K / BK;
    unsigned voffA[2], voffB[2];
#pragma unroll
    for (int i = 0; i < 2; ++i) { int R, C; stage_rc(tid * 16 + i * 8192, R, C); const int Rb = Epi::PERM ? ((R & ~31) + perm32(R & 31)) : R;
        voffA[i] = (unsigned)(R * K + C) * 2u; voffB[i] = (unsigned)(Rb * K + C) * 2u; }
    const size_t kstep = (size_t)(BK * 2);
    const size_t hstep = (size_t)HALF * K * 2;
    const size_t tstep = 2 * hstep;
    const unsigned ldsw = (unsigned)wid * 1024u;
    const int aoff = lds_byte(wr * 64 + fr, fq * 8), boff = lds_byte(wc * 32 + fr, fq * 8);
#define PG8_SA(b, h) (((b) * 2 + (h)) * HTB)
#define PG8_SB(b, h) ((4 + (b) * 2 + (h)) * HTB)
#define PG8_STAGE(bufoff, gbase, voff) do { _Pragma("unroll") for (int _i = 0; _i < 2; ++_i) \
        __builtin_amdgcn_global_load_lds((const unsigned*)((const char*)(gbase) + (voff)[_i]), (LAS unsigned*)(lds + (bufoff) + ldsw + _i * 8192), 16, 0, 0); } while (0)
#define PG8_LDA(dst, b, h) do { _Pragma("unroll") for (int m = 0; m < 4; ++m) _Pragma("unroll") for (int k = 0; k < 2; ++k) dst[m][k] = *(const LAS bf16x8*)(lds + PG8_SA(b, h) + aoff + m * 2048 + k * 1024); } while (0)
#define PG8_LDB(dst, b, h) do { _Pragma("unroll") for (int n = 0; n < 2; ++n) _Pragma("unroll") for (int k = 0; k < 2; ++k) dst[n][k] = *(const LAS bf16x8*)(lds + PG8_SB(b, h) + boff + n * 2048 + k * 1024); } while (0)
#define PG8_MMA(ai, bj, At, Bt) do { __builtin_amdgcn_s_setprio(1); _Pragma("unroll") for (int m = 0; m < 4; ++m) _Pragma("unroll") for (int n = 0; n < 2; ++n) _Pragma("unroll") for (int k = 0; k < 2; ++k) \
        acc[ai][bj][m][n] = __builtin_amdgcn_mfma_f32_16x16x32_bf16(Bt[n][k], At[m][k], acc[ai][bj][m][n], 0, 0, 0); __builtin_amdgcn_s_setprio(0); } while (0)
#define PG8_WAIT_V(n) asm volatile("s_waitcnt vmcnt(" #n ")" ::: "memory")
#define PG8_WAIT_L(n) asm volatile("s_waitcnt lgkmcnt(" #n ")" ::: "memory")
#define PG8_BAR __builtin_amdgcn_s_barrier()
#define PG8_SCHED __builtin_amdgcn_sched_barrier(0)
    Unit cur, nxt; int ui = 0;
    if (!S.next(0, cur)) return;
    f32x4 acc[2][2][4][2];
#pragma unroll
    for (int a = 0; a < 2; ++a)
#pragma unroll
        for (int b = 0; b < 2; ++b)
#pragma unroll
            for (int m = 0; m < 4; ++m)
#pragma unroll
                for (int n = 0; n < 2; ++n) acc[a][b][m][n] = (f32x4){0.f, 0.f, 0.f, 0.f};
    bf16x8 At[4][2], B0[2][2], B1[2][2];
    const char* cA = (const char*)g.A + (size_t)cur.pm * tstep; const char* cB = (const char*)g.Bt + (size_t)cur.pn * tstep;
    S.a_ready(cur);
    if constexpr (SP2) {
        PG8_STAGE(PG8_SB(0, 0), cB, voffB); PG8_STAGE(PG8_SB(0, 1), cB + hstep, voffB); PG8_STAGE(PG8_SA(0, 0), cA, voffA); PG8_STAGE(PG8_SA(0, 1), cA + hstep, voffA);
        if (wr == 1) PG8_BAR;
        PG8_WAIT_V(2); PG8_BAR;
        PG8_STAGE(PG8_SB(1, 0), cB + kstep, voffB); PG8_STAGE(PG8_SA(1, 0), cA + kstep, voffA); PG8_STAGE(PG8_SB(1, 1), cB + hstep + kstep, voffB);
        PG8_WAIT_V(6); PG8_BAR;
    } else {
        PG8_STAGE(PG8_SB(0, 0), cB, voffB); PG8_STAGE(PG8_SA(0, 0), cA, voffA); PG8_STAGE(PG8_SB(0, 1), cB + hstep, voffB); PG8_STAGE(PG8_SA(0, 1), cA + hstep, voffA);
        if (wr == 1) PG8_BAR;
        PG8_WAIT_V(4); PG8_BAR;
        PG8_STAGE(PG8_SB(1, 0), cB + kstep, voffB); PG8_STAGE(PG8_SA(1, 0), cA + kstep, voffA); PG8_STAGE(PG8_SB(1, 1), cB + hstep + kstep, voffB);
        PG8_WAIT_V(6); PG8_BAR;
    }
    for (;;) {
        const bool has_next = S.next(ui + 1, nxt);
        const char* nA = has_next ? (const char*)g.A + (size_t)nxt.pm * tstep : cA; const char* nB = has_next ? (const char*)g.Bt + (size_t)nxt.pn * tstep : cB;
        for (int t = 0; t < nt; t += 2) {
            const bool last = (t == nt - 2);
            const char* a1 = cA + (size_t)(t + 1) * kstep;
            const char* a2 = last ? nA : cA + (size_t)(t + 2) * kstep; const char* b2 = last ? nB : cB + (size_t)(t + 2) * kstep;
            const char* a3 = a2 + kstep; const char* b3 = b2 + kstep;
            if (last && has_next) S.a_ready(nxt);
            if constexpr (SP2) {
            PG8_LDB(B0, 0, 0); PG8_LDB(B1, 0, 1); PG8_SCHED; PG8_LDA(At, 0, 0); PG8_STAGE(PG8_SA(1, 1), a1 + hstep, voffA);
            PG8_WAIT_V(8); PG8_WAIT_L(0); PG8_BAR; PG8_MMA(0, 0, At, B0); PG8_MMA(0, 1, At, B1); PG8_BAR; PG8_SCHED;
            PG8_LDA(At, 0, 1); PG8_STAGE(PG8_SB(0, 0), b2, voffB); PG8_STAGE(PG8_SB(0, 1), b2 + hstep, voffB); PG8_STAGE(PG8_SA(0, 0), a2, voffA);
            PG8_WAIT_V(8); PG8_WAIT_L(0); PG8_BAR; PG8_MMA(1, 0, At, B0); PG8_MMA(1, 1, At, B1); PG8_BAR; PG8_SCHED;
            PG8_LDB(B0, 1, 0); PG8_LDB(B1, 1, 1); PG8_SCHED; PG8_LDA(At, 1, 0); PG8_STAGE(PG8_SA(0, 1), a2 + hstep, voffA);
            PG8_WAIT_V(8); PG8_WAIT_L(0); PG8_BAR; PG8_MMA(0, 0, At, B0); PG8_MMA(0, 1, At, B1); PG8_BAR; PG8_SCHED;
            PG8_LDA(At, 1, 1); PG8_STAGE(PG8_SB(1, 0), b3, voffB); PG8_STAGE(PG8_SB(1, 1), b3 + hstep, voffB); PG8_STAGE(PG8_SA(1, 0), a3, voffA);
            PG8_WAIT_V(8); PG8_WAIT_L(0); PG8_BAR; PG8_MMA(1, 0, At, B0); PG8_MMA(1, 1, At, B1); PG8_BAR; PG8_SCHED;
            } else {
            PG8_LDB(B0, 0, 0); PG8_SCHED; PG8_LDA(At, 0, 0); PG8_STAGE(PG8_SA(1, 1), a1 + hstep, voffA);
            PG8_WAIT_L(8); PG8_BAR; PG8_WAIT_L(0); PG8_MMA(0, 0, At, B0); PG8_BAR; PG8_SCHED;
            PG8_LDB(B1, 0, 1); PG8_STAGE(PG8_SB(0, 0), b2, voffB);
            PG8_BAR; PG8_WAIT_L(0); PG8_MMA(0, 1, At, B1); PG8_BAR;
            PG8_LDA(At, 0, 1); PG8_STAGE(PG8_SA(0, 0), a2, voffA);
            PG8_BAR; PG8_WAIT_L(0); PG8_MMA(1, 0, At, B0); PG8_BAR; PG8_SCHED;
            PG8_STAGE(PG8_SB(0, 1), b2 + hstep, voffB);
            PG8_WAIT_V(6); PG8_BAR; PG8_MMA(1, 1, At, B1); PG8_BAR;
            PG8_LDB(B0, 1, 0); PG8_SCHED; PG8_LDA(At, 1, 0); PG8_STAGE(PG8_SA(0, 1), a2 + hstep, voffA);
            PG8_WAIT_L(8); PG8_BAR; PG8_WAIT_L(0); PG8_MMA(0, 0, At, B0); PG8_BAR; PG8_SCHED;
            PG8_LDB(B1, 1, 1); PG8_STAGE(PG8_SB(1, 0), b3, voffB);
            PG8_BAR; PG8_WAIT_L(0); PG8_MMA(0, 1, At, B1); PG8_BAR;
            PG8_LDA(At, 1, 1); PG8_STAGE(PG8_SA(1, 0), a3, voffA);
            PG8_BAR; PG8_WAIT_L(0); PG8_MMA(1, 0, At, B0); PG8_BAR; PG8_SCHED;
            PG8_STAGE(PG8_SB(1, 1), b3 + hstep, voffB);
            PG8_WAIT_V(6); PG8_BAR; PG8_MMA(1, 1, At, B1); PG8_BAR;
            }
        }
        if constexpr (ALIGN_EPI) { if (wr == 0) PG8_BAR; }
        E(acc, cur, wr, wc, fr, fq); S.done(cur);
        if (!has_next) break;
#pragma unroll
        for (int a = 0; a < 2; ++a)
#pragma unroll
            for (int b = 0; b < 2; ++b)
#pragma unroll
                for (int m = 0; m < 4; ++m)
#pragma unroll
                    for (int n = 0; n < 2; ++n) acc[a][b][m][n] = (f32x4){0.f, 0.f, 0.f, 0.f};
        cur = nxt; cA = nA; cB = nB; ++ui;
        if constexpr (ALIGN_EPI) { if (wr == 1) PG8_BAR; }
    }
    PG8_WAIT_V(0);
    if constexpr (!ALIGN_EPI) { if (wr == 0) PG8_BAR; }
    PG8_BAR;
#undef PG8_SA
#undef PG8_SB
#undef PG8_STAGE
#undef PG8_LDA
#undef PG8_LDB
#undef PG8_MMA
#undef PG8_WAIT_V
#undef PG8_WAIT_L
#undef PG8_BAR
#undef PG8_SCHED
}

typedef const f32x4 (&AccRef)[2][2][4][2];

struct EpiSwiGLU {
    static constexpr bool PERM = true;
    bf16_t* H;
    __device__ __forceinline__ void operator()(AccRef acc, const Unit& u, int wr, int wc, int fr, int fq) const {
        const int row0 = u.pm * BM + wr * 64 + fr, col0 = u.pn * 128 + wc * 32 + 8 * fq;
#pragma unroll
        for (int ai = 0; ai < 2; ++ai)
#pragma unroll
            for (int m = 0; m < 4; ++m) {
                float o[8];
#pragma unroll
                for (int n = 0; n < 2; ++n)
#pragma unroll
                    for (int j = 0; j < 4; ++j) { const float g = acc[ai][0][m][n][j], up = acc[ai][1][m][n][j]; o[4 * n + j] = g * fsigmoid(g) * up; }
                u32x4 w; w.x = pk_bf16(o[0], o[1]); w.y = pk_bf16(o[2], o[3]); w.z = pk_bf16(o[4], o[5]); w.w = pk_bf16(o[6], o[7]);
                *(u32x4*)(H + (size_t)(row0 + ai * HALF + m * 16) * FF + col0) = w;
            }
    }
};
struct EpiResid {
    static constexpr bool PERM = false;
    const float* src; float* dst; float alpha, beta;
    __device__ __forceinline__ void operator()(AccRef acc, const Unit& u, int wr, int wc, int fr, int fq) const {
        const int row0 = u.pm * BM + wr * 64 + fr, col0 = u.pn * BM + wc * 32 + 4 * fq;
#pragma unroll
        for (int ai = 0; ai < 2; ++ai)
#pragma unroll
            for (int m = 0; m < 4; ++m) { const size_t ro = (size_t)(row0 + ai * HALF + m * 16) * DM + col0;
#pragma unroll
                for (int bj = 0; bj < 2; ++bj)
#pragma unroll
                    for (int n = 0; n < 2; ++n) { const f32x4 xv = *(const f32x4*)(src + ro + bj * HALF + n * 16); *(f32x4*)(dst + ro + bj * HALF + n * 16) = xv * alpha + acc[ai][bj][m][n] * beta; } }
    }
};
struct EpiF32 {
    static constexpr bool PERM = false;
    float* C;
    __device__ __forceinline__ void operator()(AccRef acc, const Unit& u, int wr, int wc, int fr, int fq) const {
        const int row0 = u.pm * BM + wr * 64 + fr, col0 = u.pn * BM + wc * 32 + 4 * fq;
#pragma unroll
        for (int ai = 0; ai < 2; ++ai)
#pragma unroll
            for (int m = 0; m < 4; ++m) { const size_t ro = (size_t)(row0 + ai * HALF + m * 16) * DM + col0;
#pragma unroll
                for (int bj = 0; bj < 2; ++bj)
#pragma unroll
                    for (int n = 0; n < 2; ++n) *(f32x4*)(C + ro + bj * HALF + n * 16) = acc[ai][bj][m][n]; }
    }
};
struct EpiGate {
    static constexpr bool PERM = false;
    const float* src; float* dst; const float* E1; float alpha;
    __device__ __forceinline__ void operator()(AccRef acc, const Unit& u, int wr, int wc, int fr, int fq) const {
        const int row0 = u.pm * BM + wr * 64 + fr, col0 = u.pn * BM + wc * 32 + 4 * fq;
#pragma unroll
        for (int ai = 0; ai < 2; ++ai)
#pragma unroll
            for (int m = 0; m < 4; ++m) { const size_t ro = (size_t)(row0 + ai * HALF + m * 16) * DM + col0;
#pragma unroll
                for (int bj = 0; bj < 2; ++bj)
#pragma unroll
                    for (int n = 0; n < 2; ++n) { const size_t o = ro + bj * HALF + n * 16; const f32x4 xv = *(const f32x4*)(src + o), ev = *(const f32x4*)(E1 + o); const f32x4 a = acc[ai][bj][m][n];
                        f32x4 r; r.x = xv.x * alpha + ev.x * fsigmoid(a.x); r.y = xv.y * alpha + ev.y * fsigmoid(a.y); r.z = xv.z * alpha + ev.z * fsigmoid(a.z); r.w = xv.w * alpha + ev.w * fsigmoid(a.w);
                        *(f32x4*)(dst + o) = r; } }
    }
};
struct EpiVt {
    static constexpr bool PERM = false;
    bf16_t* VT;
    __device__ __forceinline__ void operator()(AccRef acc, const Unit& u, int wr, int wc, int fr, int fq) const {
        const int row0 = u.pm * BM + wr * 64 + fr, col0 = u.pn * BM + wc * 32 + 8 * (fq & 1) + 4 * (fq >> 1);
#pragma unroll
        for (int ai = 0; ai < 2; ++ai)
#pragma unroll
            for (int m = 0; m < 4; ++m) { bf16_t* rp = VT + (size_t)(row0 + ai * HALF + m * 16) * MTOK + col0;
#pragma unroll
                for (int bj = 0; bj < 2; ++bj)
#pragma unroll
                    for (int n = 0; n < 2; ++n) { const f32x4 a = acc[ai][bj][m][n]; u32x2 w; w.x = pk_bf16(a.x, a.y); w.y = pk_bf16(a.z, a.w); *(u32x2*)(rp + bj * HALF + n * 16) = w; } }
    }
};
struct EpiProj {
    static constexpr bool PERM = true;
    bf16_t* P; const float* rope128; const float* rope64;
    __device__ __forceinline__ void operator()(AccRef acc, const Unit& u, int wr, int wc, int fr, int fq) const {
        const int pn = u.pn, row0 = u.pm * BM + wr * 64 + fr;
        if (pn < 12) {
            const bool isdiff = pn < 6; const int pp = isdiff ? pn : pn - 6; const int g = pp / 3, tg = pp % 3;
            const float sc = (g == 0) ? (isdiff ? 0.125f * LOG2E : 0.08838834764831845f * LOG2E) : 1.f;
            int fbase, col1, half, rpitch; const float* rt0;
            if (isdiff) { fbase = 8 * fq; col1 = g * 768 + (tg * 4 + wc) * 64 + fbase; half = 32; rpitch = 64; rt0 = rope64; }
            else { fbase = 32 * (wc & 1) + 8 * fq; col1 = C_MQ + g * 768 + (tg * 2 + (wc >> 1)) * 128 + fbase; half = 64; rpitch = 128; rt0 = rope128; }
#pragma unroll
            for (int ai = 0; ai < 2; ++ai)
#pragma unroll
                for (int m = 0; m < 4; ++m) { const int row = row0 + ai * HALF + m * 16;
                    const f32x4* rt = (const f32x4*)(rt0 + (size_t)row * rpitch + 2 * fbase);
                    float o1[8], o2[8];
#pragma unroll
                    for (int q = 0; q < 4; ++q) { const f32x4 cs = rt[q];
#pragma unroll
                        for (int e = 0; e < 2; ++e) { const int idx = 2 * q + e; const float a = acc[ai][0][m][idx >> 2][idx & 3], b = acc[ai][1][m][idx >> 2][idx & 3];
                            const float c = e ? cs.z : cs.x, s = e ? cs.w : cs.y; o1[idx] = (a * c - b * s) * sc; o2[idx] = (b * c + a * s) * sc; } }
                    bf16_t* rp = P + (size_t)row * PROJW + col1;
                    u32x4 w; w.x = pk_bf16(o1[0], o1[1]); w.y = pk_bf16(o1[2], o1[3]); w.z = pk_bf16(o1[4], o1[5]); w.w = pk_bf16(o1[6], o1[7]); *(u32x4*)rp = w;
                    w.x = pk_bf16(o2[0], o2[1]); w.y = pk_bf16(o2[2], o2[3]); w.z = pk_bf16(o2[4], o2[5]); w.w = pk_bf16(o2[6], o2[7]); *(u32x4*)(rp + half) = w; }
        } else {
            const int col0 = C_GQ + (pn - 12) * 256 + wc * 32 + 8 * fq;
#pragma unroll
            for (int ai = 0; ai < 2; ++ai)
#pragma unroll
                for (int m = 0; m < 4; ++m) { bf16_t* rp = P + (size_t)(row0 + ai * HALF + m * 16) * PROJW + col0;
#pragma unroll
                    for (int bj = 0; bj < 2; ++bj) { const f32x4 v0 = acc[ai][bj][m][0], v1 = acc[ai][bj][m][1]; u32x4 w; w.x = pk_bf16(v0.x, v0.y); w.y = pk_bf16(v0.z, v0.w); w.z = pk_bf16(v1.x, v1.y); w.w = pk_bf16(v1.z, v1.w); *(u32x4*)(rp + bj * HALF) = w; } }
        }
    }
};
}

struct Args { const float* in[20]; float* out; unsigned char* ws; int ph_lo, ph_hi; int use_sync, pad; };

typedef const __attribute__((address_space(4))) Args* ArgsP;
struct Ctx { int tid, lane, wave, gw, NGW, G, bid; LAS unsigned char* lds; unsigned char* ws; };

__device__ __forceinline__ void transpose_item(const float* __restrict__ W, int ldw, int src_col0, bf16_t* WT, int K, int dst_row0, int k0, LAS float* scr, int lane) {
#pragma unroll 8
    for (int i = 0; i < 32; ++i) { const int kk = 2 * i + (lane >> 5); scr[kk * 33 + (lane & 31)] = W[(size_t)(k0 + kk) * ldw + src_col0 + (lane & 31)]; }
    LDS_WAIT();
    const int c = lane & 7;
#pragma unroll
    for (int j = 0; j < 4; ++j) { const int n = (lane >> 3) + 8 * j; const LAS float* s = scr + (8 * c) * 33 + n;
        u32x4 o; o.x = pk_bf16(s[0 * 33], s[1 * 33]); o.y = pk_bf16(s[2 * 33], s[3 * 33]); o.z = pk_bf16(s[4 * 33], s[5 * 33]); o.w = pk_bf16(s[6 * 33], s[7 * 33]);
        *(u32x4*)(WT + (size_t)(dst_row0 + n) * K + k0 + 8 * c) = o; }
    LDS_WAIT();
}
__device__ __forceinline__ int win_src_col(int gidx) {
    const int pn = gidx >> 3, w = gidx & 7;
    if (pn < 6) { const int g = pn / 3, tg = pn % 3, half = w >> 2, u = w & 3; return (g ? W_DK : W_DQ) + (tg * 4 + u) * 64 + half * 32; }
    if (pn < 12) { const int pp = pn - 6, g = pp / 3, tg = pp % 3, half = w >> 2, ww = w & 3; return (g ? W_MK : W_MQ) + (tg * 2 + (ww >> 1)) * 128 + half * 64 + (ww & 1) * 32; }
    if (pn == 12) return W_GQ + 32 * w;
    if (pn == 13) return W_GK + 32 * w;
    return W_GR + (pn - 14) * 256 + 32 * w;
}
__device__ __forceinline__ void prologue(ArgsP a, const Ctx& c) {
    LAS float* scr = (LAS float*)(c.lds + c.wave * 16384);
    constexpr int I_GU = 32 * 352, I_D = 88 * 64, I_IN = 32 * 128, I_SQ = 32 * 64, I_PE = 4 * 64;
    constexpr int PER_LAYER = 2 * I_GU + 2 * I_D + I_IN + 3 * I_SQ + I_PE;
    for (int it = c.gw; it < 2 * PER_LAYER; it += c.NGW) {
        const int l = it / PER_LAYER; int r = it - l * PER_LAYER;
        unsigned char* wl = c.ws + WS_W + (size_t)l * WL_SIZE;
        if (r < 2 * I_GU) {
            const int second = r >= I_GU; if (second) r -= I_GU;
            const int kb = r / 352, gidx = r % 352, pn = gidx >> 3, w = gidx & 7;
            const float* src = a->in[(second ? 13 : 10) + (w >> 2)] + (size_t)l * DM * FF;
            transpose_item(src, FF, 128 * pn + 32 * (w & 3), (bf16_t*)(wl + (second ? WL_GU2 : WL_GU1)), DM, 32 * gidx, 64 * kb, scr, c.lane); continue; }
        r -= 2 * I_GU;
        if (r < 2 * I_D) { const int second = r >= I_D; if (second) r -= I_D; const int kb = r / 64, nb = r % 64;
            transpose_item(a->in[second ? 15 : 12] + (size_t)l * FF * DM, DM, 32 * nb, (bf16_t*)(wl + (second ? WL_D2 : WL_D1)), FF, 32 * nb, 64 * kb, scr, c.lane); continue; }
        r -= 2 * I_D;
        if (r < I_IN) { const int kb = r / 128, gidx = r % 128;
            transpose_item(a->in[3] + (size_t)l * DM * DIN, DIN, win_src_col(gidx), (bf16_t*)(wl + WL_IN), DM, 32 * gidx, 64 * kb, scr, c.lane); continue; }
        r -= I_IN;
        if (r < I_SQ) { const int kb = r / 64, nb = r % 64, row0 = 32 * nb; const int sc = row0 < 768 ? W_DV + row0 : (row0 < 1280 ? W_GV + (row0 - 768) : W_MV + (row0 - 1280));
            transpose_item(a->in[3] + (size_t)l * DM * DIN, DIN, sc, (bf16_t*)(wl + WL_V), DM, row0, 64 * kb, scr, c.lane); continue; }
        r -= I_SQ;
        if (r < I_SQ) { const int kb = r / 64, nb = r % 64; transpose_item(a->in[4] + (size_t)l * DM * DM, DM, 32 * nb, (bf16_t*)(wl + WL_OUT), DM, 32 * nb, 64 * kb, scr, c.lane); continue; }
        r -= I_SQ;
        if (r < I_SQ) { const int kb = r / 64, nb = r % 64; transpose_item(a->in[17] + (size_t)l * DM * DM, DM, 32 * nb, (bf16_t*)(wl + WL_PG), DM, 32 * nb, 64 * kb, scr, c.lane); continue; }
        r -= I_SQ;
        { const int kb = r / 64, nb = r % 64; transpose_item(a->in[16] + (size_t)l * PLE * DM, DM, 32 * nb, (bf16_t*)(wl + WL_PE), PLE, 32 * nb, 64 * kb, scr, c.lane); }
    }
    { const float* x = a->in[0]; bf16_t* xb = (bf16_t*)(c.ws + WS_XB);
      for (int m = c.gw; m < MTOK; m += c.NGW) { const f32x4* xr = (const f32x4*)(x + (size_t)m * DM) + c.lane; u32x2* o = (u32x2*)(xb + (size_t)m * DM) + c.lane;
#pragma unroll
          for (int j = 0; j < 8; ++j) { const f32x4 v = xr[64 * j]; u32x2 w; w.x = pk_bf16(v.x, v.y); w.y = pk_bf16(v.z, v.w); o[64 * j] = w; } } }
    { const float* p = a->in[1]; bf16_t* pb = (bf16_t*)(c.ws + WS_PB);
      for (int m = c.gw; m < 2 * MTOK; m += c.NGW) { const f32x4 v = *((const f32x4*)(p + (size_t)m * PLE) + c.lane); u32x2 w; w.x = pk_bf16(v.x, v.y); w.y = pk_bf16(v.z, v.w); *((u32x2*)(pb + (size_t)m * PLE) + c.lane) = w; } }
    { const int* pos = (const int*)a->in[2]; float* r128 = (float*)(c.ws + WS_R128); float* r64 = (float*)(c.ws + WS_R64);
      const int gt = c.gw * 64 + c.lane, NT = c.NGW * 64;
      for (int idx = gt; idx < MTOK * 64; idx += NT) { const int m = idx >> 6, f = idx & 63;
          const float inv = exp2f(-(float)f * (13.287712379549449f / 64.f));
          const float ang = (float)pos[m] * inv;
          const double rev = (double)ang * 0.15915494309189535; const float fr = (float)(rev - rint(rev));
          const float cv = __builtin_amdgcn_cosf(fr), sv = __builtin_amdgcn_sinf(fr);
          r128[2 * idx] = cv; r128[2 * idx + 1] = sv;
          if ((f & 1) == 0) { const int i2 = m * 32 + (f >> 1); r64[2 * i2] = cv; r64[2 * i2 + 1] = sv; } } }
    { const int gt = c.gw * 64 + c.lane, NT = c.NGW * 64;
      for (int idx = gt; idx < 2 * 16 * DM; idx += NT) { const int l = idx / (16 * DM), rr = (idx / DM) & 15, k = idx % DM;
          ((bf16_t*)(c.ws + WS_W + (size_t)l * WL_SIZE + WL_GG))[rr * DM + k] = (bf16_t)(pk_bf16(a->in[3][(size_t)l * DM * DIN + (size_t)k * DIN + W_GG + rr], 0.f) & 0xffffu); } }
}

__device__ __forceinline__ void ln_phase(const Ctx& c, const float* z, float* xo, bf16_t* xbo, const float* g, const float* b) {
    for (int m = c.gw; m < MTOK; m += c.NGW) {
        const f32x4* zr = (const f32x4*)(z + (size_t)m * DM) + c.lane;
        f32x4 v[8]; float s = 0.f;
#pragma unroll
        for (int j = 0; j < 8; ++j) { v[j] = zr[64 * j]; s += (v[j].x + v[j].y) + (v[j].z + v[j].w); }
        const float mean = wave_sum(s) * (1.f / DM); float s2 = 0.f;
#pragma unroll
        for (int j = 0; j < 8; ++j) { v[j] = v[j] - mean; s2 += (v[j].x * v[j].x + v[j].y * v[j].y) + (v[j].z * v[j].z + v[j].w * v[j].w); }
        const float rstd = 1.f / sqrtf(wave_sum(s2) * (1.f / DM) + LN_EPS);
        f32x4* xr = (f32x4*)(xo + (size_t)m * DM) + c.lane;
#pragma unroll
        for (int j = 0; j < 8; ++j) { const f32x4 gv = ((const f32x4*)g)[c.lane + 64 * j], bv = ((const f32x4*)b)[c.lane + 64 * j]; const f32x4 o = v[j] * rstd * gv + bv; xr[64 * j] = o;
            if (xbo) { u32x2 w; w.x = pk_bf16(o.x, o.y); w.y = pk_bf16(o.z, o.w); ((u32x2*)(xbo + (size_t)m * DM) + c.lane)[64 * j] = w; } }
    }
}

__device__ __forceinline__ void gg_phase(const Ctx& c, const bf16_t* xb, const bf16_t* wgg, float* gg) {
    const int row = c.lane & 15, quad = c.lane >> 4;
    for (int t = c.gw; t < MTOK / 16; t += c.NGW) {
        f32x4 acc = {0.f, 0.f, 0.f, 0.f};
        const bf16_t* ap = xb + (size_t)(t * 16 + row) * DM + quad * 8; const bf16_t* bp = wgg + (size_t)row * DM + quad * 8;
#pragma unroll 8
        for (int k0 = 0; k0 < DM; k0 += 32) { const bf16x8 av = *(const bf16x8*)(ap + k0), bv = *(const bf16x8*)(bp + k0); acc = __builtin_amdgcn_mfma_f32_16x16x32_bf16(av, bv, acc, 0, 0, 0); }
#pragma unroll
        for (int j = 0; j < 4; ++j) gg[(size_t)(t * 16 + quad * 4 + j) * 16 + row] = acc[j];
    }
}

__device__ __forceinline__ int perm23(int t) { return (t & ~12) | ((t & 4) << 1) | ((t & 8) >> 1); }
__device__ __forceinline__ void post_phase(const Ctx& c, ArgsP a, int l) {
    const bf16_t* proj = (const bf16_t*)(c.ws + WS_PROJ); const float* gg = (const float*)(c.ws + WS_GG);
    bf16_t* QT = (bf16_t*)(c.ws + WS_QT); bf16_t* KT = (bf16_t*)(c.ws + WS_KT); bf16_t* KTT = (bf16_t*)(c.ws + WS_KTT);
    float* EL = (float*)(c.ws + WS_EL); bf16_t* KM = (bf16_t*)(c.ws + WS_KM);
    const float* gate_up = a->in[7] + (size_t)l * 16 * 256; const float* gate_b = a->in[8] + (size_t)l * 256;
    for (int task = c.gw; task < 512 + 192; task += c.NGW) {
        if (task < 512) {
            const int bh = task >> 5, ch = task & 31, b = bh >> 2, hh = bh & 3, k = c.lane;
            float up[16];
#pragma unroll
            for (int r = 0; r < 16; ++r) up[r] = gate_up[r * 256 + hh * 64 + k];
            const float bias = gate_b[hh * 64 + k];
            float cum = 0.f;
            const int tok0 = b * SEQ + ch * 64; const size_t rb = (size_t)bh * SEQ + ch * 64;
            for (int t8 = 0; t8 < 8; ++t8) {
                unsigned kk[8];
#pragma unroll
                for (int tt = 0; tt < 8; ++tt) { const int t = t8 * 8 + tt; const int tok = tok0 + t;
                    const f32x4* gp = (const f32x4*)(gg + (size_t)tok * 16);
                    float pre = bias;
#pragma unroll
                    for (int q = 0; q < 4; ++q) { const f32x4 gv = gp[q]; pre += gv.x * up[4 * q] + gv.y * up[4 * q + 1] + gv.z * up[4 * q + 2] + gv.w * up[4 * q + 3]; }
                    const float ls = fminf(pre, 0.f) - log1pf(expf(-fabsf(pre)));
                    cum += ls * (1.f / 16.f);
                    const float qv = bf2f(proj[(size_t)tok * PROJW + C_GQ + hh * 64 + k]), kv = bf2f(proj[(size_t)tok * PROJW + C_GK + hh * 64 + k]);
                    const float qt = qv * expf(cum) * 0.125f, kt = kv * expf(-cum);
                    const bf16_t qb = (bf16_t)(pk_bf16(qt, 0.f) & 0xffffu), kb = (bf16_t)(pk_bf16(kt, 0.f) & 0xffffu);
                    QT[(rb + t) * 64 + k] = qb; KT[(rb + t) * 64 + k] = kb; kk[tt] = kb; }
                bf16_t* dst = KTT + ((size_t)(bh * 32 + ch) * 64 + k) * 64 + (t8 >> 2) * 32;
                const int t8l = t8 & 3;
                u32x2 w0, w1; w0.x = kk[0] | (kk[1] << 16); w0.y = kk[2] | (kk[3] << 16); w1.x = kk[4] | (kk[5] << 16); w1.y = kk[6] | (kk[7] << 16);
                *(u32x2*)(dst + (t8l >> 1) * 16 + 0 * 8 + (t8l & 1) * 4) = w0;
                *(u32x2*)(dst + (t8l >> 1) * 16 + 1 * 8 + (t8l & 1) * 4) = w1;
            }
            EL[(size_t)(bh * 32 + ch) * 64 + k] = expf(cum);
            asm volatile("s_waitcnt vmcnt(0)" ::: "memory");
            {
                const int r = c.lane & 31, h = c.lane >> 5;
                const bf16_t* QTb = QT + rb * 64; const bf16_t* KTb = KT + rb * 64; const bf16_t* KTTb = KTT + (size_t)(bh * 32 + ch) * 4096;
                f32x16 x00, x01, x11;
#pragma unroll
                for (int i = 0; i < 16; ++i) { x00[i] = 0.f; x01[i] = 0.f; x11[i] = 0.f; }
#pragma unroll
                for (int ks = 0; ks < 4; ++ks) {
                    const bf16x8 k0 = *(const bf16x8*)(KTb + (size_t)r * 64 + 16 * ks + 8 * h), k1 = *(const bf16x8*)(KTb + (size_t)(32 + r) * 64 + 16 * ks + 8 * h);
                    const bf16x8 q0 = *(const bf16x8*)(QTb + (size_t)r * 64 + 16 * ks + 8 * h), q1 = *(const bf16x8*)(QTb + (size_t)(32 + r) * 64 + 16 * ks + 8 * h);
                    x00 = MFMA32(k0, q0, x00); x01 = MFMA32(k0, q1, x01); x11 = MFMA32(k1, q1, x11);
                }
#pragma unroll
                for (int i = 0; i < 16; ++i) if (crow(i, h) > r) { x00[i] = 0.f; x11[i] = 0.f; }
                const bf16x8 p00a = pack8(x00, 0), p00b = pack8(x00, 1), p01a = pack8(x01, 0), p01b = pack8(x01, 1), p11a = pack8(x11, 0), p11b = pack8(x11, 1);
                bf16x8 ka0[4], ka1[4];
#pragma unroll
                for (int ts = 0; ts < 4; ++ts) { ka0[ts] = *(const bf16x8*)(KTTb + (size_t)r * 64 + 16 * ts + 8 * h); ka1[ts] = *(const bf16x8*)(KTTb + (size_t)(32 + r) * 64 + 16 * ts + 8 * h); }
                float* OI = (float*)(c.ws + WS_OI) + (rb) * 128; float* DST = (float*)(c.ws + WS_DST) + (size_t)(bh * 32 + ch) * 8192;
                const bf16_t* VTb = (const bf16_t*)(c.ws + WS_VT) + (size_t)(768 + hh * 128 + r) * MTOK + (size_t)tok0 + 8 * h;
                for (int sl = 0; sl < 4; ++sl) {
                    bf16x8 vb[4];
#pragma unroll
                    for (int ts = 0; ts < 4; ++ts) vb[ts] = *(const bf16x8*)(VTb + (size_t)(32 * sl) * MTOK + 16 * ts);
                    f32x16 o0, o1, d0, d1;
#pragma unroll
                    for (int i = 0; i < 16; ++i) { o0[i] = 0.f; o1[i] = 0.f; d0[i] = 0.f; d1[i] = 0.f; }
                    o0 = MFMA32(vb[0], p00a, o0); o0 = MFMA32(vb[1], p00b, o0);
                    o1 = MFMA32(vb[0], p01a, o1); o1 = MFMA32(vb[1], p01b, o1); o1 = MFMA32(vb[2], p11a, o1); o1 = MFMA32(vb[3], p11b, o1);
#pragma unroll
                    for (int ts = 0; ts < 4; ++ts) { d0 = MFMA32(vb[ts], ka0[ts], d0); d1 = MFMA32(vb[ts], ka1[ts], d1); }
#pragma unroll
                    for (int q = 0; q < 4; ++q) { f32x4 v0, v1; v0.x = o0[4 * q]; v0.y = o0[4 * q + 1]; v0.z = o0[4 * q + 2]; v0.w = o0[4 * q + 3]; v1.x = o1[4 * q]; v1.y = o1[4 * q + 1]; v1.z = o1[4 * q + 2]; v1.w = o1[4 * q + 3];
                        *(f32x4*)(OI + (size_t)r * 128 + 32 * sl + 8 * q + 4 * h) = v0; *(f32x4*)(OI + (size_t)(32 + r) * 128 + 32 * sl + 8 * q + 4 * h) = v1; }
#pragma unroll
                    for (int i = 0; i < 16; ++i) { DST[(size_t)(32 * sl + crow(i, h)) * 64 + r] = d0[i]; DST[(size_t)(32 * sl + crow(i, h)) * 64 + 32 + r] = d1[i]; }
                }
            }
        } else {
            const int t2 = task - 512, b = t2 / 48, hd = (t2 / 8) % 6, blk = t2 & 7;
            const bf16_t* kp = proj + (size_t)(b * SEQ + blk * 256) * PROJW + C_MK + hd * 128 + 2 * c.lane;
            float s0 = 0.f, s1 = 0.f;
#pragma unroll 8
            for (int t = 0; t < 256; ++t) { const unsigned w = *(const unsigned*)(kp + (size_t)t * PROJW); s0 += bflo(w); s1 += bfhi(w); }
            *(unsigned*)(KM + (size_t)((b * 6 + hd) * 8 + blk) * 128 + 2 * c.lane) = pk_bf16(s0 * (1.f / 256.f), s1 * (1.f / 256.f));
        }
    }
}

template <int DQ, bool QLDS>
__device__ __forceinline__ void attn_pass(const bf16_t* qrow  , const bf16_t* kbase  , const bf16_t* vbase  ,
                                          int qt, int own, unsigned selmask, int r, int h, f32x16 (&O)[4], LAS unsigned char* wlds  ) {
    constexpr int NKS = DQ / 16;
    bf16x8 qf[QLDS ? 1 : NKS];
    if constexpr (QLDS) {
#pragma unroll
        for (int ks = 0; ks < NKS; ++ks) *(LAS bf16x8*)(wlds + ks * 1024) = *(const bf16x8*)(qrow + 16 * ks);
    } else {
#pragma unroll
        for (int ks = 0; ks < NKS; ++ks) qf[ks] = *(const bf16x8*)(qrow + 16 * ks);
    }
#pragma unroll
    for (int t = 0; t < 4; ++t)
#pragma unroll
        for (int i = 0; i < 16; ++i) O[t][i] = 0.f;
    unsigned bmask = 0u;
    for (int n = 0; n < own; ++n) if (__ballot((selmask >> n) & 1u) != 0ull) bmask |= 1u << n;
    bmask |= 0xffffff00u | (0xffu & ~((1u << own) - 1u));
    bmask = (unsigned)__builtin_amdgcn_readfirstlane((int)bmask);
    float m = NEG_BIG, l = 0.f;
    int kt = 8 * __builtin_ctz(bmask);
    bf16x8 kf[NKS], vf[8];
    { const bf16_t* kp = kbase + (size_t)(kt * 32) * PROJW;
#pragma unroll
      for (int ks = 0; ks < NKS; ++ks) kf[ks] = *(const bf16x8*)(kp + 16 * ks);
      const bf16_t* vp = vbase + kt * 32;
#pragma unroll
      for (int t = 0; t < 4; ++t) { vf[2 * t] = *(const bf16x8*)(vp + (size_t)(32 * t) * MTOK); vf[2 * t + 1] = *(const bf16x8*)(vp + (size_t)(32 * t) * MTOK + 16); } }
    while (kt <= qt) {
        int nk = kt + 1;
        if ((nk & 7) == 0) { const unsigned rem = bmask >> (nk >> 3); nk += 8 * __builtin_ctz(rem); }
        const int pk = nk <= qt ? nk : qt;
        const int n = kt >> 3;
        const bool vis = (n >= own) || ((selmask >> n) & 1u);
        f32x16 s;
#pragma unroll
        for (int i = 0; i < 16; ++i) s[i] = 0.f;
        if constexpr (QLDS) {
            LAS unsigned char* ql = wlds; asm volatile("" : "+v"(ql));
#pragma unroll
            for (int ks = 0; ks < NKS; ++ks) { const bf16x8 qq = *(const LAS bf16x8*)(ql + ks * 1024); s = MFMA32(kf[ks], qq, s); }
        } else {
#pragma unroll
            for (int ks = 0; ks < NKS; ++ks) s = MFMA32(kf[ks], qf[ks], s);
        }
        __builtin_amdgcn_sched_barrier(0);
        { const bf16_t* kp = kbase + (size_t)(pk * 32) * PROJW;
#pragma unroll
          for (int ks = 0; ks < NKS; ++ks) kf[ks] = *(const bf16x8*)(kp + 16 * ks); }
        __builtin_amdgcn_sched_barrier(0);
        if (kt == qt) {
#pragma unroll
            for (int i = 0; i < 16; ++i) if (crow(i, h) > r) s[i] = NEG_BIG;
        }
        if (!vis) {
#pragma unroll
            for (int i = 0; i < 16; ++i) s[i] = NEG_BIG;
        }
        float mx = fmaxf(fmaxf(fmaxf(s[0], s[1]), fmaxf(s[2], s[3])), fmaxf(fmaxf(s[4], s[5]), fmaxf(s[6], s[7])));
        mx = fmaxf(mx, fmaxf(fmaxf(fmaxf(s[8], s[9]), fmaxf(s[10], s[11])), fmaxf(fmaxf(s[12], s[13]), fmaxf(s[14], s[15]))));
        if (__ballot(mx > m + 8.f) != 0ull) {
            mx = fmaxf(mx, __shfl_xor(mx, 32));
            const float mn = fmaxf(m, mx), alpha = fexp2(m - mn); m = mn; l *= alpha;
#pragma unroll
            for (int t = 0; t < 4; ++t) O[t] = O[t] * alpha;
        }
#pragma unroll
        for (int i = 0; i < 16; ++i) s[i] = fexp2(s[i] - m);
        l += ((s[0] + s[1]) + (s[2] + s[3])) + ((s[4] + s[5]) + (s[6] + s[7])) + ((s[8] + s[9]) + (s[10] + s[11])) + ((s[12] + s[13]) + (s[14] + s[15]));
        const bf16x8 p0 = pack8(s, 0), p1 = pack8(s, 1);
#pragma unroll
        for (int t = 0; t < 4; ++t) { O[t] = MFMA32(vf[2 * t], p0, O[t]); O[t] = MFMA32(vf[2 * t + 1], p1, O[t]); }
        __builtin_amdgcn_sched_barrier(0);
        { const bf16_t* vp = vbase + pk * 32;
#pragma unroll
          for (int t = 0; t < 4; ++t) { vf[2 * t] = *(const bf16x8*)(vp + (size_t)(32 * t) * MTOK); vf[2 * t + 1] = *(const bf16x8*)(vp + (size_t)(32 * t) * MTOK + 16); } }
        kt = nk;
    }
    l += __shfl_xor(l, 32);
    const float inv = 1.f / l;
#pragma unroll
    for (int t = 0; t < 4; ++t) O[t] = O[t] * inv;
}

__device__ __forceinline__ void store_o(bf16_t* orow  , const f32x16 (&O)[4]) {
#pragma unroll
    for (int t = 0; t < 4; ++t)
#pragma unroll
        for (int q = 0; q < 4; ++q) { u32x2 w; w.x = pk_bf16(O[t][4 * q], O[t][4 * q + 1]); w.y = pk_bf16(O[t][4 * q + 2], O[t][4 * q + 3]); *(u32x2*)(orow + 32 * t + 8 * q) = w; }
}

__device__ __forceinline__ void diff_task(const Ctx& c, ArgsP a, int l, int bh, int qt) {
    const int b = bh / 6, hd = bh % 6, r = c.lane & 31, h = c.lane >> 5;
    const bf16_t* proj = (const bf16_t*)(c.ws + WS_PROJ); const bf16_t* VT = (const bf16_t*)(c.ws + WS_VT); bf16_t* mix = (bf16_t*)(c.ws + WS_MIX);
    const float* lf = a->in[5] + (size_t)l * 256;
    const float d1 = wave_sum(lf[c.lane] * lf[64 + c.lane]), d2 = wave_sum(lf[128 + c.lane] * lf[192 + c.lane]);
    const float lam_init = 0.8f - 0.6f * expf(-0.3f * (float)l);
    const float lam = expf(d1) - expf(d2) + lam_init;
    const size_t tokq = (size_t)b * SEQ + qt * 32 + r;
    const bf16_t* kb = proj + ((size_t)b * SEQ + r) * PROJW + C_DK + hd * 128 + 8 * h;
    const bf16_t* vb = VT + (size_t)(hd * 128 + r) * MTOK + (size_t)b * SEQ + 8 * h;
    f32x16 O1[4];
    LAS unsigned char* wl = c.lds + c.wave * 16384 + c.lane * 16;
    {
        f32x16 O2[4];
        attn_pass<64, false>(proj + tokq * PROJW + C_DQ + hd * 128 + 64 + 8 * h, kb + 64, vb, qt, 0, 0u, r, h, O2, wl);
#pragma unroll
        for (int t = 0; t < 4; ++t)
#pragma unroll
            for (int q = 0; q < 4; ++q) { f32x4 v; v.x = O2[t][4 * q]; v.y = O2[t][4 * q + 1]; v.z = O2[t][4 * q + 2]; v.w = O2[t][4 * q + 3]; *(LAS f32x4*)(wl + (t * 4 + q) * 1024) = v; }
    }
    attn_pass<64, false>(proj + tokq * PROJW + C_DQ + hd * 128 + 8 * h, kb, vb, qt, 0, 0u, r, h, O1, wl);
    float ss = 0.f;
#pragma unroll
    for (int t = 0; t < 4; ++t)
#pragma unroll
        for (int q = 0; q < 4; ++q) { const f32x4 o2 = *(const LAS f32x4*)(wl + (t * 4 + q) * 1024);
            float v;
            v = O1[t][4 * q] - lam * o2.x; O1[t][4 * q] = v; ss += v * v;
            v = O1[t][4 * q + 1] - lam * o2.y; O1[t][4 * q + 1] = v; ss += v * v;
            v = O1[t][4 * q + 2] - lam * o2.z; O1[t][4 * q + 2] = v; ss += v * v;
            v = O1[t][4 * q + 3] - lam * o2.w; O1[t][4 * q + 3] = v; ss += v * v; }
    ss += __shfl_xor(ss, 32);
    const float rs = (1.f - lam_init) / sqrtf(ss * (1.f / 128.f) + LN_EPS);
    const float* gn = a->in[6] + (size_t)l * 128 + 4 * h;
#pragma unroll
    for (int t = 0; t < 4; ++t)
#pragma unroll
        for (int q = 0; q < 4; ++q) { const f32x4 gv = *(const f32x4*)(gn + 32 * t + 8 * q);
            O1[t][4 * q] *= rs * gv.x; O1[t][4 * q + 1] *= rs * gv.y; O1[t][4 * q + 2] *= rs * gv.z; O1[t][4 * q + 3] *= rs * gv.w; }
    store_o(mix + tokq * DM + hd * 128 + 4 * h, O1);
}

__device__ __forceinline__ void moba_task(const Ctx& c, int bh, int qt) {
    const int b = bh / 6, hd = bh % 6, r = c.lane & 31, h = c.lane >> 5;
    const bf16_t* proj = (const bf16_t*)(c.ws + WS_PROJ); const bf16_t* VT = (const bf16_t*)(c.ws + WS_VT); bf16_t* mix = (bf16_t*)(c.ws + WS_MIX);
    const bf16_t* KM = (const bf16_t*)(c.ws + WS_KM) + (size_t)(b * 6 + hd) * 8 * 128;
    const size_t tokq = (size_t)b * SEQ + qt * 32 + r;
    const bf16_t* qrow = proj + tokq * PROJW + C_MQ + hd * 128 + 8 * h;
    const int own = qt >> 3;
    unsigned selmask = 0u;
    if (own > 3) {
        f32x16 g;
#pragma unroll
        for (int i = 0; i < 16; ++i) g[i] = 0.f;
#pragma unroll
        for (int ks = 0; ks < 8; ++ks) { bf16x8 kf = {0, 0, 0, 0, 0, 0, 0, 0}; if (r < 8) kf = *(const bf16x8*)(KM + r * 128 + 16 * ks + 8 * h);
            const bf16x8 qf = *(const bf16x8*)(qrow + 16 * ks); g = MFMA32(kf, qf, g); }
        float gate[8];
#pragma unroll
        for (int i = 0; i < 4; ++i) { const float mine = g[i], other = __shfl_xor(mine, 32); gate[i] = h ? other : mine; gate[4 + i] = h ? mine : other; }
#pragma unroll
        for (int n = 0; n < 8; ++n) { int rank = 0;
#pragma unroll
            for (int mm = 0; mm < 8; ++mm) { if (mm == n) continue; const bool ahead = (gate[mm] > gate[n]) || (gate[mm] == gate[n] && mm < n); rank += (mm < own && ahead) ? 1 : 0; }
            if (n < own && rank < 3) selmask |= 1u << n; }
    } else selmask = 0xffu;
    f32x16 O[4];
    attn_pass<128, true>(qrow, proj + ((size_t)b * SEQ + r) * PROJW + C_MK + hd * 128 + 8 * h, VT + (size_t)(1280 + hd * 128 + r) * MTOK + (size_t)b * SEQ + 8 * h, qt, own, selmask, r, h, O, c.lds + c.wave * 16384 + c.lane * 16);
    store_o(mix + tokq * DM + 1280 + hd * 128 + 4 * h, O);
}

__device__ __forceinline__ void gla_scan_phase(const Ctx& c) {
    const float* DST = (const float*)(c.ws + WS_DST); const float* EL = (const float*)(c.ws + WS_EL); bf16_t* SBT = (bf16_t*)(c.ws + WS_SBT);
    for (int idx = c.gw * 64 + c.lane; idx < 16 * 8192; idx += c.NGW * 64) {
        const int bh = idx >> 13, e = idx & 8191, k = e & 63;
        float S = 0.f;
#pragma unroll 8
        for (int ch = 0; ch < 32; ++ch) {
            const size_t o = (size_t)(bh * 32 + ch) * 8192 + e;
            SBT[o] = (bf16_t)(pk_bf16(S, 0.f) & 0xffffu);
            S = EL[(size_t)(bh * 32 + ch) * 64 + k] * (S + DST[o]);
        }
    }
}
__device__ __forceinline__ void gla_final_task(const Ctx& c, ArgsP a, int l, int bh, int ch) {
    const int r = c.lane & 31, h = c.lane >> 5, b = bh >> 2, hh = bh & 3;
    const bf16_t* QT = (const bf16_t*)(c.ws + WS_QT) + ((size_t)bh * SEQ + ch * 64) * 64;
    const bf16_t* SBT = (const bf16_t*)(c.ws + WS_SBT) + (size_t)(bh * 32 + ch) * 8192;
    const float* OI = (const float*)(c.ws + WS_OI) + ((size_t)bh * SEQ + ch * 64) * 128;
    const bf16_t* proj = (const bf16_t*)(c.ws + WS_PROJ); bf16_t* mix = (bf16_t*)(c.ws + WS_MIX);
    const float* gn = a->in[9] + (size_t)l * 128 + 4 * h;
    for (int it = 0; it < 2; ++it) {
        f32x16 acc[4];
        const float* oi = OI + (size_t)(32 * it + r) * 128 + 4 * h;
#pragma unroll
        for (int dt = 0; dt < 4; ++dt)
#pragma unroll
            for (int q = 0; q < 4; ++q) { const f32x4 v = *(const f32x4*)(oi + 32 * dt + 8 * q); acc[dt][4 * q] = v.x; acc[dt][4 * q + 1] = v.y; acc[dt][4 * q + 2] = v.z; acc[dt][4 * q + 3] = v.w; }
#pragma unroll
        for (int ks = 0; ks < 4; ++ks) {
            const bf16x8 qf = *(const bf16x8*)(QT + (size_t)(32 * it + r) * 64 + 16 * ks + 8 * h);
#pragma unroll
            for (int dt = 0; dt < 4; ++dt) { const bf16x8 sf = *(const bf16x8*)(SBT + (size_t)(32 * dt + r) * 64 + 16 * ks + 8 * h); acc[dt] = MFMA32(sf, qf, acc[dt]); }
        }
        float ss = 0.f;
#pragma unroll
        for (int dt = 0; dt < 4; ++dt)
#pragma unroll
            for (int i = 0; i < 16; ++i) ss += acc[dt][i] * acc[dt][i];
        ss += __shfl_xor(ss, 32);
        const float rs = 1.f / sqrtf(ss * (1.f / 128.f) + LN_EPS);
        const size_t tok = (size_t)b * SEQ + ch * 64 + 32 * it + r;
        const bf16_t* gp = proj + tok * PROJW + C_GR + hh * 128 + 4 * h; bf16_t* mp = mix + tok * DM + 768 + hh * 128 + 4 * h;
#pragma unroll
        for (int dt = 0; dt < 4; ++dt)
#pragma unroll
            for (int q = 0; q < 4; ++q) { const u32x2 gw = *(const u32x2*)(gp + 32 * dt + 8 * q); const f32x4 gv = *(const f32x4*)(gn + 32 * dt + 8 * q);
                const float g0 = bflo(gw.x), g1 = bfhi(gw.x), g2 = bflo(gw.y), g3 = bfhi(gw.y);
                const float o0 = acc[dt][4 * q] * rs * gv.x * (g0 * fsigmoid(g0)), o1 = acc[dt][4 * q + 1] * rs * gv.y * (g1 * fsigmoid(g1));
                const float o2 = acc[dt][4 * q + 2] * rs * gv.z * (g2 * fsigmoid(g2)), o3 = acc[dt][4 * q + 3] * rs * gv.w * (g3 * fsigmoid(g3));
                u32x2 w; w.x = pk_bf16(o0, o1); w.y = pk_bf16(o2, o3); *(u32x2*)(mp + 32 * dt + 8 * q) = w; }
    }
}

__device__ __forceinline__ void attn_phase(const Ctx& c, ArgsP a, int l, int ctr_slot) {
    unsigned* ctr0 = (unsigned*)(c.ws + WS_CTL) + 64 * ctr_slot;
    const int myq = (int)(__builtin_amdgcn_s_getreg((3 << 11) | 20) & 7u);
    for (int qi = 0; qi < 8; ++qi) {
        const int q = (myq + qi) & 7;
        unsigned* ctr = ctr0 + 64 * q;
        for (;;) {
            int t = 0;
            if (c.lane == 0) t = (int)atomicAdd(ctr, 1u);
            t = __builtin_amdgcn_readfirstlane(t);
            if (t >= 448) break;
            if (t >= 384) { const int f = (t - 384) * 8 + q; gla_final_task(c, a, l, f >> 5, f & 31); continue; }
            const int grp = t / 192, u = t % 192, qt = 63 - u / 3, j = grp * 3 + u % 3, hh48 = j * 8 + q;
            if (hh48 < 24) diff_task(c, a, l, hh48, qt); else moba_task(c, hh48 - 24, qt);
        }
    }
}

#define XB_TMO      128
#define XB_XCNT(j)  (256  + 64 * (j))
#define XB_XSUB(j)  (1280 + 64 * (j))
#define XB_XGEN(j)  (2304 + 64 * (j))
#define XB_TOP      3328
#define XB_TOPGEN   3392
#define XB_SPIN_CAP (1u << 22)
__device__ __forceinline__ unsigned xb_ld(unsigned* p)              { return __hip_atomic_load(p, __ATOMIC_RELAXED, __HIP_MEMORY_SCOPE_AGENT); }
__device__ __forceinline__ unsigned xb_add(unsigned* p, unsigned v) { return __hip_atomic_fetch_add(p, v, __ATOMIC_RELAXED, __HIP_MEMORY_SCOPE_AGENT); }
__device__ __forceinline__ unsigned xb_xcc_id() { return (unsigned)__builtin_amdgcn_s_getreg((3 << 11) | 20) & 0xFu; }
#define XB_SPIN(cond, bar) do { unsigned _sp = 0; while (cond) { __builtin_amdgcn_s_sleep(1); \
    if ((++_sp & 255u) == 0u) { if (xb_ld(&(bar)[XB_TMO])) break; if (_sp > XB_SPIN_CAP) { atomicAdd(&(bar)[XB_TMO], 1u); break; } } } } while (0)
__device__ __forceinline__ void xcd_barrier_complete(unsigned* bar, unsigned x, unsigned G, unsigned& nloc, unsigned& nx) {
    unsigned sum, cnt, mine, sp = 0u;
    for (;;) {
        sum = 0u; cnt = 0u; mine = 0u;
#pragma unroll
        for (unsigned j = 0; j < 16; ++j) { const unsigned cc = xb_ld(&bar[XB_XCNT(j)]); sum += cc; cnt += (cc > 0u) ? 1u : 0u; mine = (j == x) ? cc : mine; }
        if (sum == G) break;
        __builtin_amdgcn_s_sleep(1);
        if ((++sp & 255u) == 0u) { if (xb_ld(&bar[XB_TMO])) break; if (sp > XB_SPIN_CAP) { atomicAdd(&bar[XB_TMO], 1u); break; } }
    }
    nloc = mine > 0u ? mine : 1u; nx = cnt > 0u ? cnt : 1u;
}
__device__ __forceinline__ void xcd_barrier(unsigned* bar, volatile LAS unsigned* st, unsigned G) {
    asm volatile("s_waitcnt vmcnt(0)" ::: "memory");
    __syncthreads();
    if (threadIdx.x == 0) {
        const unsigned x = xb_xcc_id();
        __builtin_amdgcn_s_waitcnt(0);
        unsigned nloc = st[0], nx = st[1];
        if (nloc == 0u) { xcd_barrier_complete(bar, x, G, nloc, nx); st[0] = nloc; st[1] = nx; }
        const unsigned old = xb_add(&bar[XB_XSUB(x)], 1u);
        const unsigned gen = old / nloc;
        if (old + 1u == (gen + 1u) * nloc) {
            __builtin_amdgcn_fence(__ATOMIC_RELEASE, "agent");
            asm volatile("s_waitcnt vmcnt(0)" ::: "memory");
            const unsigned og = xb_add(&bar[XB_TOP], 1u);
            const unsigned tg = og / nx;
            if (og + 1u == (tg + 1u) * nx) xb_add(&bar[XB_TOPGEN], 1u);
            else XB_SPIN(xb_ld(&bar[XB_TOPGEN]) == tg, bar);
            __builtin_amdgcn_fence(__ATOMIC_ACQUIRE, "agent");
            xb_add(&bar[XB_XGEN(x)], 1u);
            asm volatile("s_waitcnt vmcnt(0)" ::: "memory");
        } else {
            XB_SPIN(xb_ld(&bar[XB_XGEN(x)]) == gen, bar);
            __builtin_amdgcn_fence(__ATOMIC_ACQUIRE, "agent");
            asm volatile("s_waitcnt vmcnt(0)" ::: "memory");
        }
    }
    __syncthreads();
}

__global__ void __launch_bounds__(NTHREADS, 2) fwd_megakernel(Args args) {
    extern __shared__ __attribute__((aligned(16))) unsigned char lds_raw[];
    cg::grid_group grid = cg::this_grid();
    ArgsP ap0 = (ArgsP)__builtin_amdgcn_kernarg_segment_ptr();
    const int ph_lo = ap0->ph_lo, ph_hi = ap0->ph_hi, use_sync = ap0->use_sync;
    {
        volatile LAS unsigned* st0 = (volatile LAS unsigned*)((LAS unsigned char*)lds_raw + 131072 + 512);
        if (threadIdx.x == 0) { st0[0] = 0u; st0[1] = 0u; (void)xb_add((unsigned*)(ap0->ws + WS_CTL) + 4096 + XB_XCNT(xb_xcc_id()), 1u); }
        __syncthreads();
    }
    for (int ph = ph_lo; ph < ph_hi; ++ph) {
        if (ph > ph_lo && use_sync) {
            if (ph == ph_lo + 1) grid.sync();
            else xcd_barrier((unsigned*)(ap0->ws + WS_CTL) + 4096, (volatile LAS unsigned*)((LAS unsigned char*)lds_raw + 131072 + 512), gridDim.x);
        }
        ArgsP ap = ap0; asm volatile("" : "+s"(ap));
        int tid_ = threadIdx.x; asm volatile("" : "+v"(tid_));
        unsigned char* ws = ap->ws;
        int bid_ = blockIdx.x, G_ = gridDim.x; asm volatile("" : "+s"(bid_), "+s"(G_));
        Ctx c; c.tid = tid_; c.lane = c.tid & 63; c.wave = __builtin_amdgcn_readfirstlane(c.tid >> 6); c.G = G_; c.bid = bid_;
        c.gw = c.bid * NWAVES + c.wave; c.NGW = c.G * NWAVES; c.lds = (LAS unsigned char*)lds_raw; c.ws = ws;
        float* X = (float*)(ws + WS_X); bf16_t* XB = (bf16_t*)(ws + WS_XB); bf16_t* HB = (bf16_t*)(ws + WS_H); float* E1 = (float*)(ws + WS_H);
        bf16_t* PROJ = (bf16_t*)(ws + WS_PROJ); bf16_t* VT = (bf16_t*)(ws + WS_VT); bf16_t* MIX = (bf16_t*)(ws + WS_MIX);
        if (ph == 0) { prologue(ap, c);
#ifdef DUP_PROLOGUE
            prologue(ap, c);
#endif
            continue; }
        const int l = (ph - 1) / 14; int s = (ph - 1) % 14;
        if (s == 5) { gla_scan_phase(c); continue; }
        if (s > 5) --s;
        unsigned char* wl = ws + WS_W + (size_t)l * WL_SIZE;
        const float* lng = ap->in[18] + (size_t)l * 4 * DM; const float* lnb = ap->in[19] + (size_t)l * 4 * DM;
        const float* xsrc = (l == 0 && s <= 1) ? ap->in[0] : X;
        if (s == 0 || s == 8) {
            pg8::Gemm g{XB, (const bf16_t*)(wl + (s == 0 ? WL_GU1 : WL_GU2)), MTOK, 2 * FF, DM}; pg8::StaticOrder S; S.init(MTOK, 2 * FF, c.G, c.bid);
            pg8::EpiSwiGLU E{HB};
            pg8::gemm_phase<pg8::EpiSwiGLU, pg8::StaticOrder, true, true>(c.lds, g, S, E, c.tid);
#ifdef DUP_GU
            if (s == 0) pg8::gemm_phase<pg8::EpiSwiGLU, pg8::StaticOrder, true, true>(c.lds, g, S, E, c.tid);
#endif
        } else if (s == 1 || s == 9) {
            pg8::Gemm g{HB, (const bf16_t*)(wl + (s == 1 ? WL_D1 : WL_D2)), MTOK, DM, FF}; pg8::StaticOrder S; S.init(MTOK, DM, c.G, c.bid);
            pg8::EpiResid E{xsrc, X, ALPHA, 0.5f};
            pg8::gemm_phase<pg8::EpiResid, pg8::StaticOrder, false, true>(c.lds, g, S, E, c.tid);
        } else if (s == 2 || s == 7 || s == 10 || s == 12) {
            const int which = (s == 2) ? 0 : (s == 7) ? 1 : (s == 10) ? 2 : 3;
            const bool final_ln = (l == DEPTH - 1 && s == 12);
            ln_phase(c, X, final_ln ? ap->out : X, final_ln ? nullptr : XB, lng + which * DM, lnb + which * DM);
        } else if (s == 3) {
            { pg8::Gemm g{XB, (const bf16_t*)(wl + WL_IN), MTOK, PROJW, DM}; pg8::StaticOrder S; S.init(MTOK, PROJW, c.G, c.bid);
              pg8::EpiProj E{PROJ, (const float*)(ws + WS_R128), (const float*)(ws + WS_R64)};
              pg8::gemm_phase<pg8::EpiProj, pg8::StaticOrder, true, true>(c.lds, g, S, E, c.tid);
#ifdef DUP_IN
              pg8::gemm_phase<pg8::EpiProj, pg8::StaticOrder, true, true>(c.lds, g, S, E, c.tid);
#endif
            }
            { pg8::Gemm g{(const bf16_t*)(wl + WL_V), XB, DM, MTOK, DM}; pg8::StaticOrder S; S.init(DM, MTOK, c.G, c.bid);
              pg8::EpiVt E{VT};
              pg8::gemm_phase<pg8::EpiVt, pg8::StaticOrder, false, true>(c.lds, g, S, E, c.tid); }
            gg_phase(c, XB, (const bf16_t*)(wl + WL_GG), (float*)(ws + WS_GG));
        } else if (s == 4) {
            post_phase(c, ap, l);
#ifdef DUP_POST
            post_phase(c, ap, l);
#endif
        } else if (s == 5) {
            attn_phase(c, ap, l, 1 + 16 * l);
#ifdef DUP_ATTN
            attn_phase(c, ap, l, 9 + 16 * l);
#endif
        } else if (s == 6) {
            pg8::Gemm g{MIX, (const bf16_t*)(wl + WL_OUT), MTOK, DM, DM}; pg8::StaticOrder S; S.init(MTOK, DM, c.G, c.bid);
            pg8::EpiResid E{X, X, ALPHA, 1.0f};
            pg8::gemm_phase<pg8::EpiResid, pg8::StaticOrder, false, true>(c.lds, g, S, E, c.tid);
        } else if (s == 11) {
            { pg8::Gemm g{(const bf16_t*)(ws + WS_PB) + (size_t)l * MTOK * PLE, (const bf16_t*)(wl + WL_PE), MTOK, DM, PLE}; pg8::StaticOrder S; S.init(MTOK, DM, c.G, c.bid);
              pg8::EpiF32 E{E1};
              pg8::gemm_phase<pg8::EpiF32, pg8::StaticOrder, false, true>(c.lds, g, S, E, c.tid); }
            { pg8::Gemm g{XB, (const bf16_t*)(wl + WL_PG), MTOK, DM, DM}; pg8::StaticOrder S; S.init(MTOK, DM, c.G, c.bid);
              pg8::EpiGate E{X, X, E1, ALPHA};
              pg8::gemm_phase<pg8::EpiGate, pg8::StaticOrder, false, true>(c.lds, g, S, E, c.tid); }
        }
    }
}

extern "C" void kernel_launch(void* const* d_in, const int* in_sizes, int n_in, void* d_out, int out_size, void* d_ws, size_t ws_size, hipStream_t stream) {
    static int grid = 0;
    if (grid == 0) {
        if (n_in != 20 || in_sizes[0] != MTOK * DM || out_size != MTOK * DM || ws_size < WS_END) {
            fprintf(stderr, "kernel_launch: unexpected shapes (n_in %d, in0 %d, out %d, ws %zu need %zu)\n", n_in, n_in > 0 ? in_sizes[0] : -1, out_size, ws_size, (size_t)WS_END); grid = -1; return; }
        int dev = 0, cus = 0, per_cu = 0;
        hipGetDevice(&dev); hipDeviceGetAttribute(&cus, hipDeviceAttributeMultiprocessorCount, dev);
        hipFuncSetAttribute((const void*)fwd_megakernel, hipFuncAttributeMaxDynamicSharedMemorySize, LDS_BYTES);
        hipOccupancyMaxActiveBlocksPerMultiprocessor(&per_cu, (const void*)fwd_megakernel, NTHREADS, LDS_BYTES);
        if (per_cu < 1) { fprintf(stderr, "kernel_launch: occupancy query says %d blocks per CU\n", per_cu); per_cu = 1; }
        (void)hipGetLastError();
        grid = cus * per_cu;
        fprintf(stderr, "kernel_launch: grid %d (cus %d x %d)\n", grid, cus, per_cu);
    }
    if (grid < 0) return;
    hipMemsetAsync((char*)d_ws + WS_CTL, 0, 1 * MiB, stream);
    Args a{};
    for (int i = 0; i < 20; ++i) a.in[i] = (const float*)d_in[i];
    a.out = (float*)d_out; a.ws = (unsigned char*)d_ws; a.ph_lo = 0; a.ph_hi = 29; a.use_sync = 1; a.pad = 0;
    void* kargs[] = {&a};
    hipError_t e = hipLaunchCooperativeKernel((const void*)fwd_megakernel, dim3(grid), dim3(NTHREADS), kargs, LDS_BYTES, stream);
    if (e != hipSuccess) fprintf(stderr, "cooperative launch failed: %s (grid %d)\n", hipGetErrorString(e), grid);
}
```

```cpp
#include <hip/hip_runtime.h>
#include <hip/hip_cooperative_groups.h>
#include <cstdio>
#include <cstdint>
namespace cg = cooperative_groups;

#define LAS __attribute__((address_space(3)))
typedef unsigned short bf16_t;
typedef short bf16x8 __attribute__((ext_vector_type(8)));
typedef float f32x2 __attribute__((ext_vector_type(2)));
typedef float f32x4 __attribute__((ext_vector_type(4)));
typedef float f32x16 __attribute__((ext_vector_type(16)));
typedef unsigned u32x2 __attribute__((ext_vector_type(2)));
typedef unsigned u32x4 __attribute__((ext_vector_type(4)));

constexpr int NB = 4, SEQ = 2048, DM = 2048, MTOK = NB * SEQ, FF = 5632, DIN = 6160, PLE = 256, DEPTH = 2;
constexpr int PROJW = 4096, PROJP = 4160, VTP = 8256;
constexpr int C_DQ = 0, C_DK = 768, C_MQ = 1536, C_MK = 2304, C_GQ = 3072, C_GK = 3328, C_GR = 3584;
constexpr int W_DQ = 0, W_DK = 768, W_DV = 1536, W_GQ = 2304, W_GK = 2560, W_GV = 2816, W_GR = 3328, W_GG = 3840, W_MQ = 3856, W_MK = 4624, W_MV = 5392;
constexpr float LN_EPS = 1e-5f;
constexpr float ALPHA = 1.4142135623730951f;
constexpr float LOG2E = 1.4426950408889634f;
constexpr float NEG_BIG = -1.0e30f;

constexpr size_t MiB = 1u << 20;
constexpr size_t WL_GU1 = 0, WL_D1 = 44 * MiB, WL_IN = 66 * MiB, WL_V = 82 * MiB, WL_OUT = 90 * MiB, WL_GU2 = 98 * MiB, WL_D2 = 142 * MiB, WL_PE = 164 * MiB, WL_PG = 165 * MiB, WL_GG = 173 * MiB, WL_SIZE = 174 * MiB;
constexpr size_t WS_CTL = 0;
constexpr size_t WS_W = 1 * MiB;
constexpr size_t WS_X = WS_W + 2 * WL_SIZE;
constexpr size_t WS_XB = WS_X + 64 * MiB;
constexpr size_t WS_H = WS_XB + 32 * MiB;
constexpr size_t WS_PROJ = WS_H + 88 * MiB;
constexpr size_t WS_VT = WS_PROJ + 66 * MiB;
constexpr size_t WS_MIX = WS_VT + 33 * MiB;
constexpr size_t WS_PB = WS_MIX + 32 * MiB;
constexpr size_t WS_R128 = WS_PB + 8 * MiB;
constexpr size_t WS_R64 = WS_R128 + 4 * MiB;
constexpr size_t WS_GG = WS_R64 + 2 * MiB;
constexpr size_t WS_QT = WS_GG + 1 * MiB;
constexpr size_t WS_KT = WS_QT + 4 * MiB;
constexpr size_t WS_KTT = WS_KT + 4 * MiB;
constexpr size_t WS_EL = WS_KTT + 4 * MiB;
constexpr size_t WS_KM = WS_EL + 1 * MiB;
constexpr size_t WS_OI = WS_KM + 1 * MiB;
constexpr size_t WS_DST = WS_OI + 16 * MiB;
constexpr size_t WS_SBT = WS_DST + 16 * MiB;
constexpr size_t WS_KFD = WS_SBT + 8 * MiB;
constexpr size_t WS_KFM = WS_KFD + 12 * MiB;
constexpr size_t WS_END = WS_KFM + 12 * MiB;

constexpr int LDS_BYTES = 147456;
constexpr int NWAVES = 8, NTHREADS = 512;

__device__ __forceinline__ size_t vf_block(int b, int u, int tile) { return (size_t)((b * 16 + u) * 64 + tile) * 4096; }
__device__ __forceinline__ size_t kfd_block(int b, int sk, int tile) { return (size_t)((b * 12 + sk) * 64 + tile) * 2048; }
__device__ __forceinline__ size_t kfm_block(int b, int hd, int tile) { return (size_t)((b * 6 + hd) * 64 + tile) * 4096; }
__device__ __forceinline__ float bf2f(bf16_t b) { return __uint_as_float(((unsigned)b) << 16); }
__device__ __forceinline__ float bflo(unsigned w) { return __uint_as_float(w << 16); }
__device__ __forceinline__ float bfhi(unsigned w) { return __uint_as_float(w & 0xffff0000u); }
typedef __bf16 bf16x2_t __attribute__((ext_vector_type(2)));
__device__ __forceinline__ unsigned pk_bf16(float lo, float hi) { f32x2 v = {lo, hi}; bf16x2_t b = __builtin_convertvector(v, bf16x2_t); return __builtin_bit_cast(unsigned, b); }
__device__ __forceinline__ float wave_sum(float v) {
#pragma unroll
    for (int o = 1; o < 64; o <<= 1) v += __shfl_xor(v, o);
    return v;
}
__device__ __forceinline__ float fexp2(float x) { return __builtin_amdgcn_exp2f(x); }
__device__ __forceinline__ float fsigmoid(float x) { return __builtin_amdgcn_rcpf(1.f + fexp2(-x * LOG2E)); }
__device__ __forceinline__ int crow(int reg, int h) { return (reg & 3) + 8 * (reg >> 2) + 4 * h; }
#define MFMA32(a, b, c) __builtin_amdgcn_mfma_f32_32x32x16_bf16((a), (b), (c), 0, 0, 0)
#define LDS_WAIT() asm volatile("s_waitcnt lgkmcnt(0)" ::: "memory")
__device__ __forceinline__ bf16x8 pack8(const f32x16& x, int s) {
    u32x4 p;
    p.x = pk_bf16(x[8 * s + 0], x[8 * s + 1]); p.y = pk_bf16(x[8 * s + 2], x[8 * s + 3]);
    p.z = pk_bf16(x[8 * s + 4], x[8 * s + 5]); p.w = pk_bf16(x[8 * s + 6], x[8 * s + 7]);
    return __builtin_bit_cast(bf16x8, p);
}

namespace pg8 {
constexpr int BM = 256, BK = 64, HALF = 128, HTB = HALF * BK * 2, STAGE_BYTES = 8 * HTB, NXCD = 8, WGM = 8;
__host__ __device__ __forceinline__ int lds_byte(int r, int c) { const int st = (r >> 4) * 2 + (c >> 5), rr = r & 15, cc = c & 31, ob = rr * 64 + cc * 2; return st * 1024 + (ob ^ (((ob >> 9) & 1) << 5)); }
__host__ __device__ __forceinline__ void stage_rc(int b, int& R, int& C) { const int st = b / 1024, sb = b % 1024, swz = sb ^ (((sb >> 9) & 1) << 5); R = (st >> 1) * 16 + swz / 64; C = (st & 1) * 32 + (swz % 64) / 2; }
__host__ __device__ __forceinline__ int perm32(int rho) { const int n = rho >> 4, i = rho & 15; return 8 * (i >> 2) + 4 * n + (i & 3); }
struct Unit { int pm, pn; };
struct Gemm { const bf16_t* A; const bf16_t* Bt; int M, N, K; };
struct StaticOrder {
    int nM, nN, nwg, G, c;
    __host__ __device__ void init(int M, int N, int G_, int c_) { nM = M / BM; nN = N / BM; nwg = nM * nN; G = G_; c = c_; }
    __host__ __device__ bool next(int i, Unit& u) const {
        const long L = (long)i * G + c; if (L >= nwg) return false;
        int wgid = (int)L; { const int q = nwg / NXCD, r = nwg % NXCD, xcd = wgid % NXCD, off = wgid / NXCD; wgid = (xcd < r ? xcd * (q + 1) : r * (q + 1) + (xcd - r) * q) + off; }
        const int nig = WGM * nN, gid = wgid / nig, fm = gid * WGM, gsz = (nM - fm) < WGM ? (nM - fm) : WGM;
        u.pm = fm + ((wgid % nig) % gsz); u.pn = (wgid % nig) / gsz; return true;
    }
    __device__ __forceinline__ void a_ready(const Unit&) const {}
    __device__ __forceinline__ void done(const Unit&) const {}
};

template <class Epi, class Sched, bool ALIGN_EPI = false, bool SP2 = false>
__device__ __forceinline__ void gemm_phase(LAS unsigned char* lds, const Gemm g, const Sched& S, const Epi& E, const int tid) {
    const int wid = __builtin_amdgcn_readfirstlane(tid >> 6), lane = tid & 63, wr = wid >> 2, wc = wid & 3, fr = lane & 15, fq = lane >> 4;
    const int K = g.K, nt = K / BK;
    unsigned voffA[2], voffB[2];
#pragma unroll
    for (int i = 0; i < 2; ++i) { int R, C; stage_rc(tid * 16 + i * 8192, R, C); const int Rb = Epi::PERM ? ((R & ~31) + perm32(R & 31)) : R;
        voffA[i] = (unsigned)(R * K + C) * 2u; voffB[i] = (unsigned)(Rb * K + C) * 2u; }
    const size_t kstep = (size_t)(BK * 2);
    const size_t hstep = (size_t)HALF * K * 2;
    const size_t tstep = 2 * hstep;
    const unsigned ldsw = (unsigned)wid * 1024u;
    const int aoff = lds_byte(wr * 64 + fr, fq * 8), boff = lds_byte(wc * 32 + fr, fq * 8);
#define PG8_SA(b, h) (((b) * 2 + (h)) * HTB)
#define PG8_SB(b, h) ((4 + (b) * 2 + (h)) * HTB)
#define PG8_STAGE(bufoff, gbase, voff) do { _Pragma("unroll") for (int _i = 0; _i < 2; ++_i) \
        __builtin_amdgcn_global_load_lds((const unsigned*)((const char*)(gbase) + (voff)[_i]), (LAS unsigned*)(lds + (bufoff) + ldsw + _i * 8192), 16, 0, 0); } while (0)
#define PG8_LDA(dst, b, h) do { _Pragma("unroll") for (int m = 0; m < 4; ++m) _Pragma("unroll") for (int k = 0; k < 2; ++k) dst[m][k] = *(const LAS bf16x8*)(lds + PG8_SA(b, h) + aoff + m * 2048 + k * 1024); } while (0)
#define PG8_LDB(dst, b, h) do { _Pragma("unroll") for (int n = 0; n < 2; ++n) _Pragma("unroll") for (int k = 0; k < 2; ++k) dst[n][k] = *(const LAS bf16x8*)(lds + PG8_SB(b, h) + boff + n * 2048 + k * 1024); } while (0)
#define PG8_MMA(ai, bj, At, Bt) do { __builtin_amdgcn_s_setprio(1); _Pragma("unroll") for (int m = 0; m < 4; ++m) _Pragma("unroll") for (int n = 0; n < 2; ++n) _Pragma("unroll") for (int k = 0; k < 2; ++k) \
        acc[ai][bj][m][n] = __builtin_amdgcn_mfma_f32_16x16x32_bf16(Bt[n][k], At[m][k], acc[ai][bj][m][n], 0, 0, 0); __builtin_amdgcn_s_setprio(0); } while (0)
#define PG8_WAIT_V(n) asm volatile("s_waitcnt vmcnt(" #n ")" ::: "memory")
#define PG8_WAIT_L(n) asm volatile("s_waitcnt lgkmcnt(" #n ")" ::: "memory")
#define PG8_BAR __builtin_amdgcn_s_barrier()
#define PG8_SCHED __builtin_amdgcn_sched_barrier(0)
    Unit cur, nxt; int ui = 0;
    if (!S.next(0, cur)) return;
    f32x4 acc[2][2][4][2];
#pragma unroll
    for (int a = 0; a < 2; ++a)
#pragma unroll
        for (int b = 0; b < 2; ++b)
#pragma unroll
            for (int m = 0; m < 4; ++m)
#pragma unroll
                for (int n = 0; n < 2; ++n) acc[a][b][m][n] = (f32x4){0.f, 0.f, 0.f, 0.f};
    bf16x8 At[4][2], B0[2][2], B1[2][2];
    const char* cA = (const char*)g.A + (size_t)cur.pm * tstep; const char* cB = (const char*)g.Bt + (size_t)cur.pn * tstep;
    S.a_ready(cur);
    if constexpr (SP2) {
        PG8_STAGE(PG8_SB(0, 0), cB, voffB); PG8_STAGE(PG8_SB(0, 1), cB + hstep, voffB); PG8_STAGE(PG8_SA(0, 0), cA, voffA); PG8_STAGE(PG8_SA(0, 1), cA + hstep, voffA);
        if (wr == 1) PG8_BAR;
        PG8_WAIT_V(2); PG8_BAR;
        PG8_STAGE(PG8_SB(1, 0), cB + kstep, voffB); PG8_STAGE(PG8_SA(1, 0), cA + kstep, voffA); PG8_STAGE(PG8_SB(1, 1), cB + hstep + kstep, voffB);
        PG8_WAIT_V(6); PG8_BAR;
    } else {
        PG8_STAGE(PG8_SB(0, 0), cB, voffB); PG8_STAGE(PG8_SA(0, 0), cA, voffA); PG8_STAGE(PG8_SB(0, 1), cB + hstep, voffB); PG8_STAGE(PG8_SA(0, 1), cA + hstep, voffA);
        if (wr == 1) PG8_BAR;
        PG8_WAIT_V(4); PG8_BAR;
        PG8_STAGE(PG8_SB(1, 0), cB + kstep, voffB); PG8_STAGE(PG8_SA(1, 0), cA + kstep, voffA); PG8_STAGE(PG8_SB(1, 1), cB + hstep + kstep, voffB);
        PG8_WAIT_V(6); PG8_BAR;
    }
    for (;;) {
        const bool has_next = S.next(ui + 1, nxt);
        const char* nA = has_next ? (const char*)g.A + (size_t)nxt.pm * tstep : cA; const char* nB = has_next ? (const char*)g.Bt + (size_t)nxt.pn * tstep : cB;
        for (int t = 0; t < nt; t += 2) {
            const bool last = (t == nt - 2);
            const char* a1 = cA + (size_t)(t + 1) * kstep;
            const char* a2 = last ? nA : cA + (size_t)(t + 2) * kstep; const char* b2 = last ? nB : cB + (size_t)(t + 2) * kstep;
            const char* a3 = a2 + kstep; const char* b3 = b2 + kstep;
            if (last && has_next) S.a_ready(nxt);
            if constexpr (SP2) {
            PG8_LDB(B0, 0, 0); PG8_LDB(B1, 0, 1); PG8_SCHED; PG8_LDA(At, 0, 0); PG8_STAGE(PG8_SA(1, 1), a1 + hstep, voffA);
            PG8_WAIT_V(8); PG8_WAIT_L(0); PG8_BAR; PG8_MMA(0, 0, At, B0); PG8_MMA(0, 1, At, B1); PG8_BAR; PG8_SCHED;
            PG8_LDA(At, 0, 1); PG8_STAGE(PG8_SB(0, 0), b2, voffB); PG8_STAGE(PG8_SB(0, 1), b2 + hstep, voffB); PG8_STAGE(PG8_SA(0, 0), a2, voffA);
            PG8_WAIT_V(8); PG8_WAIT_L(0); PG8_BAR; PG8_MMA(1, 0, At, B0); PG8_MMA(1, 1, At, B1); PG8_BAR; PG8_SCHED;
            PG8_LDB(B0, 1, 0); PG8_LDB(B1, 1, 1); PG8_SCHED; PG8_LDA(At, 1, 0); PG8_STAGE(PG8_SA(0, 1), a2 + hstep, voffA);
            PG8_WAIT_V(8); PG8_WAIT_L(0); PG8_BAR; PG8_MMA(0, 0, At, B0); PG8_MMA(0, 1, At, B1); PG8_BAR; PG8_SCHED;
            PG8_LDA(At, 1, 1); PG8_STAGE(PG8_SB(1, 0), b3, voffB); PG8_STAGE(PG8_SB(1, 1), b3 + hstep, voffB); PG8_STAGE(PG8_SA(1, 0), a3, voffA);
            PG8_WAIT_V(8); PG8_WAIT_L(0); PG8_BAR; PG8_MMA(1, 0, At, B0); PG8_MMA(1, 1, At, B1); PG8_BAR; PG8_SCHED;
            } else {
            PG8_LDB(B0, 0, 0); PG8_SCHED; PG8_LDA(At, 0, 0); PG8_STAGE(PG8_SA(1, 1), a1 + hstep, voffA);
            PG8_WAIT_L(8); PG8_BAR; PG8_WAIT_L(0); PG8_MMA(0, 0, At, B0); PG8_BAR; PG8_SCHED;
            PG8_LDB(B1, 0, 1); PG8_STAGE(PG8_SB(0, 0), b2, voffB);
            PG8_BAR; PG8_WAIT_L(0); PG8_MMA(0, 1, At, B1); PG8_BAR;
            PG8_LDA(At, 0, 1); PG8_STAGE(PG8_SA(0, 0), a2, voffA);
            PG8_BAR; PG8_WAIT_L(0); PG8_MMA(1, 0, At, B0); PG8_BAR; PG8_SCHED;
            PG8_STAGE(PG8_SB(0, 1), b2 + hstep, voffB);
            PG8_WAIT_V(6); PG8_BAR; PG8_MMA(1, 1, At, B1); PG8_BAR;
            PG8_LDB(B0, 1, 0); PG8_SCHED; PG8_LDA(At, 1, 0); PG8_STAGE(PG8_SA(0, 1), a2 + hstep, voffA);
            PG8_WAIT_L(8); PG8_BAR; PG8_WAIT_L(0); PG8_MMA(0, 0, At, B0); PG8_BAR; PG8_SCHED;
            PG8_LDB(B1, 1, 1); PG8_STAGE(PG8_SB(1, 0), b3, voffB);
            PG8_BAR; PG8_WAIT_L(0); PG8_MMA(0, 1, At, B1); PG8_BAR;
            PG8_LDA(At, 1, 1); PG8_STAGE(PG8_SA(1, 0), a3, voffA);
            PG8_BAR; PG8_WAIT_L(0); PG8_MMA(1, 0, At, B0); PG8_BAR; PG8_SCHED;
            PG8_STAGE(PG8_SB(1, 1), b3 + hstep, voffB);
            PG8_WAIT_V(6); PG8_BAR; PG8_MMA(1, 1, At, B1); PG8_BAR;
            }
        }
        if constexpr (ALIGN_EPI) { if (wr == 0) PG8_BAR; }
        E(acc, cur, wr, wc, fr, fq); S.done(cur);
        if (!has_next) break;
#pragma unroll
        for (int a = 0; a < 2; ++a)
#pragma unroll
            for (int b = 0; b < 2; ++b)
#pragma unroll
                for (int m = 0; m < 4; ++m)
#pragma unroll
                    for (int n = 0; n < 2; ++n) acc[a][b][m][n] = (f32x4){0.f, 0.f, 0.f, 0.f};
        cur = nxt; cA = nA; cB = nB; ++ui;
        if constexpr (ALIGN_EPI) { if (wr == 1) PG8_BAR; }
    }
    PG8_WAIT_V(0);
    if constexpr (!ALIGN_EPI) { if (wr == 0) PG8_BAR; }
    PG8_BAR;
#undef PG8_SA
#undef PG8_SB
#undef PG8_STAGE
#undef PG8_LDA
#undef PG8_LDB
#undef PG8_MMA
#undef PG8_WAIT_V
#undef PG8_WAIT_L
#undef PG8_BAR
#undef PG8_SCHED
}

typedef const f32x4 (&AccRef)[2][2][4][2];

struct EpiSwiGLU {
    static constexpr bool PERM = true;
    bf16_t* H;
    __device__ __forceinline__ void operator()(AccRef acc, const Unit& u, int wr, int wc, int fr, int fq) const {
        const int row0 = u.pm * BM + wr * 64 + fr, col0 = u.pn * 128 + wc * 32 + 8 * fq;
#pragma unroll
        for (int ai = 0; ai < 2; ++ai)
#pragma unroll
            for (int m = 0; m < 4; ++m) {
                float o[8];
#pragma unroll
                for (int n = 0; n < 2; ++n)
#pragma unroll
                    for (int j = 0; j < 4; ++j) { const float g = acc[ai][0][m][n][j], up = acc[ai][1][m][n][j]; o[4 * n + j] = g * fsigmoid(g) * up; }
                u32x4 w; w.x = pk_bf16(o[0], o[1]); w.y = pk_bf16(o[2], o[3]); w.z = pk_bf16(o[4], o[5]); w.w = pk_bf16(o[6], o[7]);
                *(u32x4*)(H + (size_t)(row0 + ai * HALF + m * 16) * FF + col0) = w;
            }
    }
};
struct EpiResid {
    static constexpr bool PERM = false;
    const float* src; float* dst; float alpha, beta; const float* stats; const float* g; const float* b;
    __device__ __forceinline__ void operator()(AccRef acc, const Unit& u, int wr, int wc, int fr, int fq) const {
        const int row0 = u.pm * BM + wr * 64 + fr, col0 = u.pn * BM + wc * 32 + 4 * fq;
        f32x4 gv[2][2], bv[2][2];
        if (stats) {
#pragma unroll
            for (int bj = 0; bj < 2; ++bj)
#pragma unroll
                for (int n = 0; n < 2; ++n) { gv[bj][n] = *(const f32x4*)(g + col0 + bj * HALF + n * 16); bv[bj][n] = *(const f32x4*)(b + col0 + bj * HALF + n * 16); }
        }
#pragma unroll
        for (int ai = 0; ai < 2; ++ai)
#pragma unroll
            for (int m = 0; m < 4; ++m) { const int row = row0 + ai * HALF + m * 16; const size_t ro = (size_t)row * DM + col0;
                f32x2 st = {0.f, 1.f}; if (stats) st = *(const f32x2*)(stats + 2 * row);
#pragma unroll
                for (int bj = 0; bj < 2; ++bj)
#pragma unroll
                    for (int n = 0; n < 2; ++n) { f32x4 xv = *(const f32x4*)(src + ro + bj * HALF + n * 16);
                        if (stats) xv = (xv - st.x) * st.y * gv[bj][n] + bv[bj][n];
                        *(f32x4*)(dst + ro + bj * HALF + n * 16) = xv * alpha + acc[ai][bj][m][n] * beta; } }
    }
};
struct EpiF32 {
    static constexpr bool PERM = false;
    float* C;
    __device__ __forceinline__ void operator()(AccRef acc, const Unit& u, int wr, int wc, int fr, int fq) const {
        const int row0 = u.pm * BM + wr * 64 + fr, col0 = u.pn * BM + wc * 32 + 4 * fq;
#pragma unroll
        for (int ai = 0; ai < 2; ++ai)
#pragma unroll
            for (int m = 0; m < 4; ++m) { const size_t ro = (size_t)(row0 + ai * HALF + m * 16) * DM + col0;
#pragma unroll
                for (int bj = 0; bj < 2; ++bj)
#pragma unroll
                    for (int n = 0; n < 2; ++n) *(f32x4*)(C + ro + bj * HALF + n * 16) = acc[ai][bj][m][n]; }
    }
};
struct EpiGate {
    static constexpr bool PERM = false;
    const float* src; float* dst; const float* E1; float alpha; const float* stats; const float* g; const float* b;
    __device__ __forceinline__ void operator()(AccRef acc, const Unit& u, int wr, int wc, int fr, int fq) const {
        const int row0 = u.pm * BM + wr * 64 + fr, col0 = u.pn * BM + wc * 32 + 4 * fq;
        f32x4 gv[2][2], bv[2][2];
#pragma unroll
        for (int bj = 0; bj < 2; ++bj)
#pragma unroll
            for (int n = 0; n < 2; ++n) { gv[bj][n] = *(const f32x4*)(g + col0 + bj * HALF + n * 16); bv[bj][n] = *(const f32x4*)(b + col0 + bj * HALF + n * 16); }
#pragma unroll
        for (int ai = 0; ai < 2; ++ai)
#pragma unroll
            for (int m = 0; m < 4; ++m) { const int row = row0 + ai * HALF + m * 16; const size_t ro = (size_t)row * DM + col0;
                const f32x2 st = *(const f32x2*)(stats + 2 * row);
#pragma unroll
                for (int bj = 0; bj < 2; ++bj)
#pragma unroll
                    for (int n = 0; n < 2; ++n) { const size_t o = ro + bj * HALF + n * 16; const f32x4 ev = *(const f32x4*)(E1 + o); const f32x4 a = acc[ai][bj][m][n];
                        const f32x4 xv = (*(const f32x4*)(src + o) - st.x) * st.y * gv[bj][n] + bv[bj][n];
                        f32x4 r; r.x = xv.x * alpha + ev.x * fsigmoid(a.x); r.y = xv.y * alpha + ev.y * fsigmoid(a.y); r.z = xv.z * alpha + ev.z * fsigmoid(a.z); r.w = xv.w * alpha + ev.w * fsigmoid(a.w);
                        *(f32x4*)(dst + o) = r; } }
    }
};
struct EpiVt {
    static constexpr bool PERM = false;
    bf16_t* VF;
    __device__ __forceinline__ void operator()(AccRef acc, const Unit& u, int wr, int wc, int fr, int fq) const {
        const int row0 = u.pm * BM + wr * 64 + fr;
#pragma unroll
        for (int ai = 0; ai < 2; ++ai)
#pragma unroll
            for (int m = 0; m < 4; ++m) { const int row = row0 + ai * HALF + m * 16, uu = row >> 7, t = (row >> 5) & 3, r = row & 31;
#pragma unroll
                for (int bj = 0; bj < 2; ++bj) { const int T = u.pn * 8 + bj * 4 + wc, bb = T >> 6, tile = T & 63;
                    bf16_t* bp = VF + vf_block(bb, uu, tile) + (size_t)(t * 2) * 512 + ((fq & 1) * 32 + r) * 8 + 4 * (fq >> 1);
#pragma unroll
                    for (int n = 0; n < 2; ++n) { const f32x4 a = acc[ai][bj][m][n]; u32x2 w; w.x = pk_bf16(a.x, a.y); w.y = pk_bf16(a.z, a.w); *(u32x2*)(bp + n * 512) = w; } } }
    }
};
struct EpiProj {
    static constexpr bool PERM = true;
    bf16_t* P; const float* rope128; const float* rope64; bf16_t* KFD; bf16_t* KFM;
    __device__ __forceinline__ void operator()(AccRef acc, const Unit& u, int wr, int wc, int fr, int fq) const {
        const int pn = u.pn, row0 = u.pm * BM + wr * 64 + fr;
        if (pn < 12) {
            const bool isdiff = pn < 6; const int pp = isdiff ? pn : pn - 6; const int g = pp / 3, tg = pp % 3;
            const float sc = (g == 0) ? (isdiff ? 0.125f * LOG2E : 0.08838834764831845f * LOG2E) : 1.f;
            int fbase, col1, half, rpitch; const float* rt0;
            if (isdiff) { fbase = 8 * fq; col1 = g * 768 + (tg * 4 + wc) * 64 + fbase; half = 32; rpitch = 64; rt0 = rope64; }
            else { fbase = 32 * (wc & 1) + 8 * fq; col1 = C_MQ + g * 768 + (tg * 2 + (wc >> 1)) * 128 + fbase; half = 64; rpitch = 128; rt0 = rope128; }
#pragma unroll
            for (int ai = 0; ai < 2; ++ai)
#pragma unroll
                for (int m = 0; m < 4; ++m) { const int row = row0 + ai * HALF + m * 16;
                    const f32x4* rt = (const f32x4*)(rt0 + (size_t)row * rpitch + 2 * fbase);
                    float o1[8], o2[8];
#pragma unroll
                    for (int q = 0; q < 4; ++q) { const f32x4 cs = rt[q];
#pragma unroll
                        for (int e = 0; e < 2; ++e) { const int idx = 2 * q + e; const float a = acc[ai][0][m][idx >> 2][idx & 3], b = acc[ai][1][m][idx >> 2][idx & 3];
                            const float c = e ? cs.z : cs.x, s = e ? cs.w : cs.y; o1[idx] = (a * c - b * s) * sc; o2[idx] = (b * c + a * s) * sc; } }
                    bf16_t* rp = P + (size_t)row * PROJP + col1;
                    u32x4 w1, w2; w1.x = pk_bf16(o1[0], o1[1]); w1.y = pk_bf16(o1[2], o1[3]); w1.z = pk_bf16(o1[4], o1[5]); w1.w = pk_bf16(o1[6], o1[7]);
                    w2.x = pk_bf16(o2[0], o2[1]); w2.y = pk_bf16(o2[2], o2[3]); w2.z = pk_bf16(o2[4], o2[5]); w2.w = pk_bf16(o2[6], o2[7]);
                    if (g == 0 || !isdiff) { *(u32x4*)rp = w1; *(u32x4*)(rp + half) = w2; }
                    if (g == 1) {
                        const int bb = row >> 11, tile = (row >> 5) & 63, lslot = ((fq & 1) * 32 + (row & 31)) * 8;
                        if (isdiff) { bf16_t* kp = KFD + kfd_block(bb, tg * 4 + wc, tile) + lslot; const int ks = fq >> 1; *(u32x4*)(kp + ks * 512) = w1; *(u32x4*)(kp + (ks + 2) * 512) = w2; }
                        else { bf16_t* kp = KFM + kfm_block(bb, tg * 2 + (wc >> 1), tile) + lslot; const int ks = 2 * (wc & 1) + (fq >> 1); *(u32x4*)(kp + ks * 512) = w1; *(u32x4*)(kp + (ks + 4) * 512) = w2; } } }
        } else {
            const int col0 = C_GQ + (pn - 12) * 256 + wc * 32 + 8 * fq;
#pragma unroll
            for (int ai = 0; ai < 2; ++ai)
#pragma unroll
                for (int m = 0; m < 4; ++m) { bf16_t* rp = P + (size_t)(row0 + ai * HALF + m * 16) * PROJP + col0;
#pragma unroll
                    for (int bj = 0; bj < 2; ++bj) { const f32x4 v0 = acc[ai][bj][m][0], v1 = acc[ai][bj][m][1]; u32x4 w; w.x = pk_bf16(v0.x, v0.y); w.y = pk_bf16(v0.z, v0.w); w.z = pk_bf16(v1.x, v1.y); w.w = pk_bf16(v1.z, v1.w); *(u32x4*)(rp + bj * HALF) = w; } }
        }
    }
};
}

struct Args { const float* in[20]; float* out; unsigned char* ws; int ph_lo, ph_hi; int use_sync, pad; };

typedef const __attribute__((address_space(4))) Args* ArgsP;
struct Ctx { int tid, lane, wave, gw, NGW, G, bid; LAS unsigned char* lds; unsigned char* ws; };

__device__ __forceinline__ void transpose_item(const float* __restrict__ W, int ldw, int src_col0, bf16_t* WT, int K, int dst_row0, int k0, LAS float* scr, int lane) {
    float tmp[32];
#pragma unroll
    for (int i = 0; i < 32; ++i) tmp[i] = __builtin_nontemporal_load(W + (size_t)(k0 + 2 * i + (lane >> 5)) * ldw + src_col0 + (lane & 31));
#pragma unroll
    for (int i = 0; i < 32; ++i) scr[(2 * i + (lane >> 5)) * 33 + (lane & 31)] = tmp[i];
    LDS_WAIT();
    const int c = lane & 7;
#pragma unroll
    for (int j = 0; j < 4; ++j) { const int n = (lane >> 3) + 8 * j; const LAS float* s = scr + (8 * c) * 33 + n;
        u32x4 o; o.x = pk_bf16(s[0 * 33], s[1 * 33]); o.y = pk_bf16(s[2 * 33], s[3 * 33]); o.z = pk_bf16(s[4 * 33], s[5 * 33]); o.w = pk_bf16(s[6 * 33], s[7 * 33]);
        *(u32x4*)(WT + (size_t)(dst_row0 + n) * K + k0 + 8 * c) = o; }
    LDS_WAIT();
}
__device__ __forceinline__ int win_src_col(int gidx) {
    const int pn = gidx >> 3, w = gidx & 7;
    if (pn < 6) { const int g = pn / 3, tg = pn % 3, half = w >> 2, u = w & 3; return (g ? W_DK : W_DQ) + (tg * 4 + u) * 64 + half * 32; }
    if (pn < 12) { const int pp = pn - 6, g = pp / 3, tg = pp % 3, half = w >> 2, ww = w & 3; return (g ? W_MK : W_MQ) + (tg * 2 + (ww >> 1)) * 128 + half * 64 + (ww & 1) * 32; }
    if (pn == 12) return W_GQ + 32 * w;
    if (pn == 13) return W_GK + 32 * w;
    return W_GR + (pn - 14) * 256 + 32 * w;
}
constexpr int I_GU = 32 * 352, I_D = 88 * 64, I_IN = 32 * 128, I_SQ = 32 * 64, I_PE = 4 * 64;
constexpr int PER_LAYER = 2 * I_GU + 2 * I_D + I_IN + 3 * I_SQ + I_PE;
__device__ __forceinline__ int tail_cnt(int k) { return k == 0 ? 14336 : k == 1 ? 8192 : k == 2 ? 15360 : 2048; }
__device__ __forceinline__ int tail_item(int k, int i) {
    return k == 0 ? i : k == 1 ? 22528 + i : k == 2 ? (i < 8192 ? 14336 + i : 30720 + (i - 8192)) : 41984 + i; }
constexpr int DEFER_LO = 37888, DEFER_PG0 = 41984, DEFER_PG1 = 44032;
__device__ __forceinline__ void convert_item(ArgsP a, const Ctx& c, int it, LAS float* scr) {
    {
        const int l = it / PER_LAYER; int r = it - l * PER_LAYER;
        unsigned char* wl = c.ws + WS_W + (size_t)l * WL_SIZE;
        if (r < 2 * I_GU) {
            const int second = r >= I_GU; if (second) r -= I_GU;
            const int kb = r / 352, gidx = r % 352, pn = gidx >> 3, w = gidx & 7;
            const float* src = a->in[(second ? 13 : 10) + (w >> 2)] + (size_t)l * DM * FF;
            transpose_item(src, FF, 128 * pn + 32 * (w & 3), (bf16_t*)(wl + (second ? WL_GU2 : WL_GU1)), DM, 32 * gidx, 64 * kb, scr, c.lane); return; }
        r -= 2 * I_GU;
        if (r < 2 * I_D) { const int second = r >= I_D; if (second) r -= I_D; const int kb = r / 64, nb = r % 64;
            transpose_item(a->in[second ? 15 : 12] + (size_t)l * FF * DM, DM, 32 * nb, (bf16_t*)(wl + (second ? WL_D2 : WL_D1)), FF, 32 * nb, 64 * kb, scr, c.lane); return; }
        r -= 2 * I_D;
        if (r < I_IN) { const int kb = r / 128, gidx = r % 128;
            transpose_item(a->in[3] + (size_t)l * DM * DIN, DIN, win_src_col(gidx), (bf16_t*)(wl + WL_IN), DM, 32 * gidx, 64 * kb, scr, c.lane); return; }
        r -= I_IN;
        if (r < I_SQ) { const int kb = r / 64, nb = r % 64, row0 = 32 * nb; const int sc = row0 < 768 ? W_DV + row0 : (row0 < 1280 ? W_GV + (row0 - 768) : W_MV + (row0 - 1280));
            transpose_item(a->in[3] + (size_t)l * DM * DIN, DIN, sc, (bf16_t*)(wl + WL_V), DM, row0, 64 * kb, scr, c.lane); return; }
        r -= I_SQ;
        if (r < I_SQ) { const int kb = r / 64, nb = r % 64; transpose_item(a->in[4] + (size_t)l * DM * DM, DM, 32 * nb, (bf16_t*)(wl + WL_OUT), DM, 32 * nb, 64 * kb, scr, c.lane); return; }
        r -= I_SQ;
        if (r < I_SQ) { const int kb = r / 64, nb = r % 64; transpose_item(a->in[17] + (size_t)l * DM * DM, DM, 32 * nb, (bf16_t*)(wl + WL_PG), DM, 32 * nb, 64 * kb, scr, c.lane); return; }
        r -= I_SQ;
        { const int kb = r / 64, nb = r % 64; transpose_item(a->in[16] + (size_t)l * PLE * DM, DM, 32 * nb, (bf16_t*)(wl + WL_PE), PLE, 32 * nb, 64 * kb, scr, c.lane); }
    }
}
__device__ __forceinline__ void prologue(ArgsP a, const Ctx& c) {
    LAS float* scr = (LAS float*)(c.lds + c.wave * 16384);
    constexpr int N_MID = DEFER_PG0 - DEFER_LO, N_PRO = PER_LAYER + N_MID + (PER_LAYER - DEFER_PG1);
    for (int j = c.gw; j < N_PRO; j += c.NGW) {
        const int it = j < PER_LAYER ? j : (j < PER_LAYER + N_MID ? PER_LAYER + DEFER_LO + (j - PER_LAYER) : PER_LAYER + DEFER_PG1 + (j - PER_LAYER - N_MID));
        convert_item(a, c, it, scr);
    }
    { const float* x = a->in[0]; bf16_t* xb = (bf16_t*)(c.ws + WS_XB);
      for (int m = c.gw; m < MTOK; m += c.NGW) { const f32x4* xr = (const f32x4*)(x + (size_t)m * DM) + c.lane; u32x2* o = (u32x2*)(xb + (size_t)m * DM) + c.lane;
#pragma unroll
          for (int j = 0; j < 8; ++j) { const f32x4 v = xr[64 * j]; u32x2 w; w.x = pk_bf16(v.x, v.y); w.y = pk_bf16(v.z, v.w); o[64 * j] = w; } } }
    { const float* p = a->in[1]; bf16_t* pb = (bf16_t*)(c.ws + WS_PB);
      for (int m = c.gw; m < 2 * MTOK; m += c.NGW) { const f32x4 v = *((const f32x4*)(p + (size_t)m * PLE) + c.lane); u32x2 w; w.x = pk_bf16(v.x, v.y); w.y = pk_bf16(v.z, v.w); *((u32x2*)(pb + (size_t)m * PLE) + c.lane) = w; } }
    { const int* pos = (const int*)a->in[2]; float* r128 = (float*)(c.ws + WS_R128); float* r64 = (float*)(c.ws + WS_R64);
      const int gt = c.gw * 64 + c.lane, NT = c.NGW * 64;
      for (int idx = gt; idx < MTOK * 64; idx += NT) { const int m = idx >> 6, f = idx & 63;
          const float inv = exp2f(-(float)f * (13.287712379549449f / 64.f));
          const float ang = (float)pos[m] * inv;
          const double rev = (double)ang * 0.15915494309189535; const float fr = (float)(rev - rint(rev));
          const float cv = __builtin_amdgcn_cosf(fr), sv = __builtin_amdgcn_sinf(fr);
          r128[2 * idx] = cv; r128[2 * idx + 1] = sv;
          if ((f & 1) == 0) { const int i2 = m * 32 + (f >> 1); r64[2 * i2] = cv; r64[2 * i2 + 1] = sv; } } }
    { const int gt = c.gw * 64 + c.lane, NT = c.NGW * 64;
      for (int idx = gt; idx < 2 * 16 * DM; idx += NT) { const int l = idx / (16 * DM), rr = (idx / DM) & 15, k = idx % DM;
          ((bf16_t*)(c.ws + WS_W + (size_t)l * WL_SIZE + WL_GG))[rr * DM + k] = (bf16_t)(pk_bf16(a->in[3][(size_t)l * DM * DIN + (size_t)k * DIN + W_GG + rr], 0.f) & 0xffffu); } }
}

__device__ __forceinline__ void ln_phase(const Ctx& c, const float* z, float* xo, bf16_t* xbo, float* stats, const float* g, const float* b) {
    for (int m = c.gw; m < MTOK; m += 2 * c.NGW) {
        const int m1 = m + c.NGW; const bool two = m1 < MTOK;
        const f32x4* zr0 = (const f32x4*)(z + (size_t)m * DM) + c.lane; const f32x4* zr1 = (const f32x4*)(z + (size_t)(two ? m1 : m) * DM) + c.lane;
        f32x4 v0[8], v1[8]; float s0 = 0.f, s1 = 0.f;
#pragma unroll
        for (int j = 0; j < 8; ++j) { v0[j] = __builtin_nontemporal_load(zr0 + 64 * j); v1[j] = __builtin_nontemporal_load(zr1 + 64 * j); }
#pragma unroll
        for (int j = 0; j < 8; ++j) { s0 += (v0[j].x + v0[j].y) + (v0[j].z + v0[j].w); s1 += (v1[j].x + v1[j].y) + (v1[j].z + v1[j].w); }
        const float mean0 = wave_sum(s0) * (1.f / DM), mean1 = wave_sum(s1) * (1.f / DM); float q0 = 0.f, q1 = 0.f;
#pragma unroll
        for (int j = 0; j < 8; ++j) { v0[j] = v0[j] - mean0; v1[j] = v1[j] - mean1;
            q0 += (v0[j].x * v0[j].x + v0[j].y * v0[j].y) + (v0[j].z * v0[j].z + v0[j].w * v0[j].w); q1 += (v1[j].x * v1[j].x + v1[j].y * v1[j].y) + (v1[j].z * v1[j].z + v1[j].w * v1[j].w); }
        const float rstd0 = 1.f / sqrtf(wave_sum(q0) * (1.f / DM) + LN_EPS), rstd1 = 1.f / sqrtf(wave_sum(q1) * (1.f / DM) + LN_EPS);
        if (c.lane == 0) { f32x2 st = {mean0, rstd0}; *(f32x2*)(stats + 2 * m) = st; if (two) { f32x2 st1 = {mean1, rstd1}; *(f32x2*)(stats + 2 * m1) = st1; } }
#pragma unroll
        for (int j = 0; j < 8; ++j) { const f32x4 gv = ((const f32x4*)g)[c.lane + 64 * j], bv = ((const f32x4*)b)[c.lane + 64 * j];
            const f32x4 o0 = v0[j] * rstd0 * gv + bv, o1 = v1[j] * rstd1 * gv + bv;
            if (xo) { ((f32x4*)(xo + (size_t)m * DM) + c.lane)[64 * j] = o0; if (two) ((f32x4*)(xo + (size_t)m1 * DM) + c.lane)[64 * j] = o1; }
            if (xbo) { u32x2 w; w.x = pk_bf16(o0.x, o0.y); w.y = pk_bf16(o0.z, o0.w); ((u32x2*)(xbo + (size_t)m * DM) + c.lane)[64 * j] = w;
                if (two) { u32x2 w1; w1.x = pk_bf16(o1.x, o1.y); w1.y = pk_bf16(o1.z, o1.w); ((u32x2*)(xbo + (size_t)m1 * DM) + c.lane)[64 * j] = w1; } } }
    }
}

__device__ __forceinline__ void gg_phase(const Ctx& c, const bf16_t* xb, const bf16_t* wgg, float* gg) {
    const int row = c.lane & 15, quad = c.lane >> 4;
    for (int t = c.wave * c.G + c.bid; t < MTOK / 16; t += c.NGW) {
        f32x4 acc = {0.f, 0.f, 0.f, 0.f};
        const bf16_t* ap = xb + (size_t)(t * 16 + row) * DM + quad * 8; const bf16_t* bp = wgg + (size_t)row * DM + quad * 8;
#pragma unroll 16
        for (int k0 = 0; k0 < DM; k0 += 32) { const bf16x8 av = *(const bf16x8*)(ap + k0), bv = *(const bf16x8*)(bp + k0); acc = __builtin_amdgcn_mfma_f32_16x16x32_bf16(av, bv, acc, 0, 0, 0); }
#pragma unroll
        for (int j = 0; j < 4; ++j) gg[(size_t)(t * 16 + quad * 4 + j) * 16 + row] = acc[j];
    }
}

__device__ __forceinline__ int perm23(int t) { return (t & ~12) | ((t & 4) << 1) | ((t & 8) >> 1); }
__device__ __forceinline__ void post_phase(const Ctx& c, ArgsP a, int l) {
    const bf16_t* proj = (const bf16_t*)(c.ws + WS_PROJ); const float* gg = (const float*)(c.ws + WS_GG);
    bf16_t* QT = (bf16_t*)(c.ws + WS_QT); bf16_t* KT = (bf16_t*)(c.ws + WS_KT); bf16_t* KTT = (bf16_t*)(c.ws + WS_KTT);
    float* EL = (float*)(c.ws + WS_EL); bf16_t* KM = (bf16_t*)(c.ws + WS_KM);
    const float* gate_up = a->in[7] + (size_t)l * 16 * 256; const float* gate_b = a->in[8] + (size_t)l * 256;
    for (int task = c.gw; task < 512 + 192; task += c.NGW) {
        if (task < 512) {
            const int bh = task >> 5, ch = task & 31, b = bh >> 2, hh = bh & 3, k = c.lane;
            float up[16];
#pragma unroll
            for (int r = 0; r < 16; ++r) up[r] = gate_up[r * 256 + hh * 64 + k];
            const float bias = gate_b[hh * 64 + k];
            float cum = 0.f;
            const int tok0 = b * SEQ + ch * 64; const size_t rb = (size_t)bh * SEQ + ch * 64;
            for (int t8 = 0; t8 < 8; ++t8) {
                unsigned kk[8];
#pragma unroll
                for (int tt = 0; tt < 8; ++tt) { const int t = t8 * 8 + tt; const int tok = tok0 + t;
                    const f32x4* gp = (const f32x4*)(gg + (size_t)tok * 16);
                    float pre = bias;
#pragma unroll
                    for (int q = 0; q < 4; ++q) { const f32x4 gv = gp[q]; pre += gv.x * up[4 * q] + gv.y * up[4 * q + 1] + gv.z * up[4 * q + 2] + gv.w * up[4 * q + 3]; }
                    const float ls = -0.6931471805599453f * __builtin_amdgcn_logf(1.f + fexp2(-pre * LOG2E));
                    cum += ls * (1.f / 16.f);
                    const float qv = bf2f(proj[(size_t)tok * PROJP + C_GQ + hh * 64 + k]), kv = bf2f(proj[(size_t)tok * PROJP + C_GK + hh * 64 + k]);
                    const float ec = fexp2(cum * LOG2E); const float qt = qv * ec * 0.125f, kt = kv * __builtin_amdgcn_rcpf(ec);
                    const bf16_t qb = (bf16_t)(pk_bf16(qt, 0.f) & 0xffffu), kb = (bf16_t)(pk_bf16(kt, 0.f) & 0xffffu);
                    QT[(rb + t) * 64 + k] = qb; KT[(rb + t) * 64 + k] = kb; kk[tt] = kb; }
                bf16_t* dst = KTT + ((size_t)(bh * 32 + ch) * 64 + k) * 64 + (t8 >> 2) * 32;
                const int t8l = t8 & 3;
                u32x2 w0, w1; w0.x = kk[0] | (kk[1] << 16); w0.y = kk[2] | (kk[3] << 16); w1.x = kk[4] | (kk[5] << 16); w1.y = kk[6] | (kk[7] << 16);
                *(u32x2*)(dst + (t8l >> 1) * 16 + 0 * 8 + (t8l & 1) * 4) = w0;
                *(u32x2*)(dst + (t8l >> 1) * 16 + 1 * 8 + (t8l & 1) * 4) = w1;
            }
            EL[(size_t)(bh * 32 + ch) * 64 + k] = fexp2(cum * LOG2E);
            asm volatile("s_waitcnt vmcnt(0)" ::: "memory");
            {
                const int r = c.lane & 31, h = c.lane >> 5;
                const bf16_t* QTb = QT + rb * 64; const bf16_t* KTb = KT + rb * 64; const bf16_t* KTTb = KTT + (size_t)(bh * 32 + ch) * 4096;
                f32x16 x00, x01, x11;
#pragma unroll
                for (int i = 0; i < 16; ++i) { x00[i] = 0.f; x01[i] = 0.f; x11[i] = 0.f; }
#pragma unroll
                for (int ks = 0; ks < 4; ++ks) {
                    const bf16x8 k0 = *(const bf16x8*)(KTb + (size_t)r * 64 + 16 * ks + 8 * h), k1 = *(const bf16x8*)(KTb + (size_t)(32 + r) * 64 + 16 * ks + 8 * h);
                    const bf16x8 q0 = *(const bf16x8*)(QTb + (size_t)r * 64 + 16 * ks + 8 * h), q1 = *(const bf16x8*)(QTb + (size_t)(32 + r) * 64 + 16 * ks + 8 * h);
                    x00 = MFMA32(k0, q0, x00); x01 = MFMA32(k0, q1, x01); x11 = MFMA32(k1, q1, x11);
                }
#pragma unroll
                for (int i = 0; i < 16; ++i) if (crow(i, h) > r) { x00[i] = 0.f; x11[i] = 0.f; }
                const bf16x8 p00a = pack8(x00, 0), p00b = pack8(x00, 1), p01a = pack8(x01, 0), p01b = pack8(x01, 1), p11a = pack8(x11, 0), p11b = pack8(x11, 1);
                bf16x8 ka0[4], ka1[4];
#pragma unroll
                for (int ts = 0; ts < 4; ++ts) { ka0[ts] = *(const bf16x8*)(KTTb + (size_t)r * 64 + 16 * ts + 8 * h); ka1[ts] = *(const bf16x8*)(KTTb + (size_t)(32 + r) * 64 + 16 * ts + 8 * h); }
                float* OI = (float*)(c.ws + WS_OI) + (rb) * 128; float* DST = (float*)(c.ws + WS_DST) + (size_t)(bh * 32 + ch) * 8192;
                const bf16_t* VTb = (const bf16_t*)(c.ws + WS_VT) + vf_block(b, 6 + hh, ch * 2) + c.lane * 8;
                for (int sl = 0; sl < 4; ++sl) {
                    bf16x8 vb[4];
#pragma unroll
                    for (int ts = 0; ts < 4; ++ts) vb[ts] = *(const bf16x8*)(VTb + (size_t)(ts >> 1) * 4096 + (sl * 2 + (ts & 1)) * 512);
                    f32x16 o0, o1, d0, d1;
#pragma unroll
                    for (int i = 0; i < 16; ++i) { o0[i] = 0.f; o1[i] = 0.f; d0[i] = 0.f; d1[i] = 0.f; }
                    o0 = MFMA32(vb[0], p00a, o0); o0 = MFMA32(vb[1], p00b, o0);
                    o1 = MFMA32(vb[0], p01a, o1); o1 = MFMA32(vb[1], p01b, o1); o1 = MFMA32(vb[2], p11a, o1); o1 = MFMA32(vb[3], p11b, o1);
#pragma unroll
                    for (int ts = 0; ts < 4; ++ts) { d0 = MFMA32(vb[ts], ka0[ts], d0); d1 = MFMA32(vb[ts], ka1[ts], d1); }
#pragma unroll
                    for (int q = 0; q < 4; ++q) { f32x4 v0, v1; v0.x = o0[4 * q]; v0.y = o0[4 * q + 1]; v0.z = o0[4 * q + 2]; v0.w = o0[4 * q + 3]; v1.x = o1[4 * q]; v1.y = o1[4 * q + 1]; v1.z = o1[4 * q + 2]; v1.w = o1[4 * q + 3];
                        *(f32x4*)(OI + (size_t)r * 128 + 32 * sl + 8 * q + 4 * h) = v0; *(f32x4*)(OI + (size_t)(32 + r) * 128 + 32 * sl + 8 * q + 4 * h) = v1; }
#pragma unroll
                    for (int i = 0; i < 16; ++i) { DST[(size_t)(32 * sl + crow(i, h)) * 64 + r] = d0[i]; DST[(size_t)(32 * sl + crow(i, h)) * 64 + 32 + r] = d1[i]; }
                }
            }
        } else {
            const int t2 = task - 512, b = t2 / 48, hd = (t2 / 8) % 6, blk = t2 & 7;
            const bf16_t* kp = proj + (size_t)(b * SEQ + blk * 256) * PROJP + C_MK + hd * 128 + 2 * c.lane;
            float s0 = 0.f, s1 = 0.f;
#pragma unroll 8
            for (int t = 0; t < 256; ++t) { const unsigned w = *(const unsigned*)(kp + (size_t)t * PROJP); s0 += bflo(w); s1 += bfhi(w); }
            *(unsigned*)(KM + (size_t)((b * 6 + hd) * 8 + blk) * 128 + 2 * c.lane) = pk_bf16(s0 * (1.f / 256.f), s1 * (1.f / 256.f));
        }
    }
}

template <int OFF> __device__ __forceinline__ void gld16(bf16x8& dst, const bf16_t* p) { asm volatile("global_load_dwordx4 %0, %1, off offset:%2" : "+v"(dst) : "v"(p), "n"(OFF) : "memory"); }
template <int NKS> __device__ __forceinline__ void issue_k(bf16x8 (&kf)[NKS], const bf16_t* kp) {
    gld16<0>(kf[0], kp); gld16<1024>(kf[1], kp); gld16<2048>(kf[2], kp); gld16<3072>(kf[3], kp);
    if constexpr (NKS == 8) { const bf16_t* k2 = kp + 2048; gld16<0>(kf[4], k2); gld16<1024>(kf[5], k2); gld16<2048>(kf[6], k2); gld16<3072>(kf[7], k2); }
}
__device__ __forceinline__ void issue_v(bf16x8 (&vf)[8], const bf16_t* vp) {
    const bf16_t* v2 = vp + 2048;
    gld16<0>(vf[0], vp); gld16<1024>(vf[1], vp); gld16<2048>(vf[2], vp); gld16<3072>(vf[3], vp); gld16<0>(vf[4], v2); gld16<1024>(vf[5], v2); gld16<2048>(vf[6], v2); gld16<3072>(vf[7], v2);
}
template <int NKS, int CNT> __device__ __forceinline__ void wait_k(bf16x8 (&kf)[NKS]) {
    if constexpr (NKS == 4) asm volatile("s_waitcnt vmcnt(%4)" : "+v"(kf[0]), "+v"(kf[1]), "+v"(kf[2]), "+v"(kf[3]) : "n"(CNT) : "memory");
    else asm volatile("s_waitcnt vmcnt(%8)" : "+v"(kf[0]), "+v"(kf[1]), "+v"(kf[2]), "+v"(kf[3]), "+v"(kf[4]), "+v"(kf[5]), "+v"(kf[6]), "+v"(kf[7]) : "n"(CNT) : "memory");
}
template <int CNT> __device__ __forceinline__ void wait_v(bf16x8 (&vf)[8]) {
    asm volatile("s_waitcnt vmcnt(%8)" : "+v"(vf[0]), "+v"(vf[1]), "+v"(vf[2]), "+v"(vf[3]), "+v"(vf[4]), "+v"(vf[5]), "+v"(vf[6]), "+v"(vf[7]) : "n"(CNT) : "memory");
}
template <int DQ, bool QLDS, int KD  >
__device__ __forceinline__ void attn_pass(const bf16_t* qrow  , const bf16_t* kbase  , const bf16_t* vbase  ,
                                          int qt, int own, unsigned selmask, int r, int h, f32x16 (&O)[4], LAS unsigned char* wlds  ) {
    constexpr int NKS = DQ / 16;
    bf16x8 qf[QLDS ? 1 : NKS];
    if constexpr (QLDS) {
#pragma unroll
        for (int ks = 0; ks < NKS; ++ks) *(LAS bf16x8*)(wlds + ks * 1024) = *(const bf16x8*)(qrow + 16 * ks);
    } else {
#pragma unroll
        for (int ks = 0; ks < NKS; ++ks) qf[ks] = *(const bf16x8*)(qrow + 16 * ks);
    }
#pragma unroll
    for (int t = 0; t < 4; ++t)
#pragma unroll
        for (int i = 0; i < 16; ++i) O[t][i] = 0.f;
    unsigned bmask = 0u;
    for (int n = 0; n < own; ++n) if (__ballot((selmask >> n) & 1u) != 0ull) bmask |= 1u << n;
    bmask |= 0xffffff00u | (0xffu & ~((1u << own) - 1u));
    bmask = (unsigned)__builtin_amdgcn_readfirstlane((int)bmask);
    float m = NEG_BIG, l = 0.f;
    int kt = 8 * __builtin_ctz(bmask);
    bf16x8 kfa[NKS], kfb[KD == 2 ? NKS : 1], vfa[8], vfb[8];
#pragma unroll
    for (int i = 0; i < NKS; ++i) { kfa[i] = (bf16x8){0, 0, 0, 0, 0, 0, 0, 0}; if constexpr (KD == 2) kfb[i] = (bf16x8){0, 0, 0, 0, 0, 0, 0, 0}; }
#pragma unroll
    for (int i = 0; i < 8; ++i) { vfa[i] = (bf16x8){0, 0, 0, 0, 0, 0, 0, 0}; vfb[i] = (bf16x8){0, 0, 0, 0, 0, 0, 0, 0}; }
    if constexpr (!QLDS) {
#pragma unroll
        for (int ks = 0; ks < NKS; ++ks) asm volatile("" : "+v"(qf[ks]));
    }
#define ATTN_NEXT(k) (((((k) + 1) & 7) == 0) ? ((k) + 1 + 8 * __builtin_ctz(bmask >> (((k) + 1) >> 3))) : ((k) + 1))
#define ATTN_CLAMP(k) ((k) <= qt ? (k) : qt)
    int k1 = ATTN_NEXT(kt);
    asm volatile("s_waitcnt vmcnt(0)" ::: "memory");
    if constexpr (KD == 2) {
        issue_k<NKS>(kfa, kbase + (size_t)kt * (NKS * 512));            issue_v(vfa, vbase + (size_t)kt * 4096);
        issue_k<NKS>(kfb, kbase + (size_t)ATTN_CLAMP(k1) * (NKS * 512)); issue_v(vfb, vbase + (size_t)ATTN_CLAMP(k1) * 4096);
    } else {
        issue_v(vfa, vbase + (size_t)kt * 4096); issue_k<NKS>(kfa, kbase + (size_t)kt * (NKS * 512)); issue_v(vfb, vbase + (size_t)ATTN_CLAMP(k1) * 4096);
    }
#define ATTN_TILE(KC, VC, TIDX, TNEXT1, TNEXT2) { \
        const int tcur = (TIDX); const bool live = tcur <= qt; const int n = tcur >> 3; \
        const bool vis = live && ((n >= own) || ((selmask >> n) & 1u)); \
        f32x16 s; \
        _Pragma("unroll") for (int i = 0; i < 16; ++i) s[i] = 0.f; \
        wait_k<NKS, KD == 2 ? 16 + NKS : 8>(KC); \
        if constexpr (QLDS) { \
            LAS unsigned char* ql = wlds; asm volatile("" : "+v"(ql)); \
            _Pragma("unroll") for (int ks = 0; ks < NKS; ++ks) { const bf16x8 qq = *(const LAS bf16x8*)(ql + ks * 1024); s = MFMA32(KC[ks], qq, s); } \
        } else { \
            _Pragma("unroll") for (int ks = 0; ks < NKS; ++ks) s = MFMA32(KC[ks], qf[ks], s); \
        } \
        if (tcur == qt) { _Pragma("unroll") for (int i = 0; i < 16; ++i) if (crow(i, h) > r) s[i] = NEG_BIG; } \
        if (!vis) { _Pragma("unroll") for (int i = 0; i < 16; ++i) s[i] = NEG_BIG; } \
        float mx = fmaxf(fmaxf(fmaxf(s[0], s[1]), fmaxf(s[2], s[3])), fmaxf(fmaxf(s[4], s[5]), fmaxf(s[6], s[7]))); \
        mx = fmaxf(mx, fmaxf(fmaxf(fmaxf(s[8], s[9]), fmaxf(s[10], s[11])), fmaxf(fmaxf(s[12], s[13]), fmaxf(s[14], s[15])))); \
        if (__ballot(mx > m + 8.f) != 0ull) { \
            mx = fmaxf(mx, __shfl_xor(mx, 32)); \
            const float mn = fmaxf(m, mx), alpha = fexp2(m - mn); m = mn; l *= alpha; \
            _Pragma("unroll") for (int t = 0; t < 4; ++t) O[t] = O[t] * alpha; \
        } \
        issue_k<NKS>(KC, kbase + (size_t)ATTN_CLAMP(KD == 2 ? (TNEXT2) : (TNEXT1)) * (NKS * 512)); \
        _Pragma("unroll") for (int i = 0; i < 16; ++i) s[i] = live ? fexp2(s[i] - m) : 0.f; \
        l += ((s[0] + s[1]) + (s[2] + s[3])) + ((s[4] + s[5]) + (s[6] + s[7])) + ((s[8] + s[9]) + (s[10] + s[11])) + ((s[12] + s[13]) + (s[14] + s[15])); \
        const bf16x8 p0 = pack8(s, 0), p1 = pack8(s, 1); \
        wait_v<KD == 2 ? 8 + 2 * NKS : 8 + NKS>(VC); \
        _Pragma("unroll") for (int t = 0; t < 4; ++t) { O[t] = MFMA32(VC[2 * t], p0, O[t]); O[t] = MFMA32(VC[2 * t + 1], p1, O[t]); } \
        asm volatile("" : "+v"(O[0]), "+v"(O[1]), "+v"(O[2]), "+v"(O[3])); \
        issue_v(VC, vbase + (size_t)ATTN_CLAMP(TNEXT2) * 4096); }
    while (kt <= qt) {
        const int k2 = ATTN_NEXT(k1), k3 = ATTN_NEXT(k2);
        if constexpr (KD == 2) { ATTN_TILE(kfa, vfa, kt, k1, k2) ATTN_TILE(kfb, vfb, k1, k2, k3) }
        else { ATTN_TILE(kfa, vfa, kt, k1, k2) ATTN_TILE(kfa, vfb, k1, k2, k3) }
        kt = k2; k1 = k3;
    }
#undef ATTN_TILE
#undef ATTN_NEXT
#undef ATTN_CLAMP
    asm volatile("s_waitcnt vmcnt(0)" : "+v"(kfa[0]), "+v"(vfa[0]), "+v"(vfb[0]) :: "memory");
    l += __shfl_xor(l, 32);
    const float inv = 1.f / l;
#pragma unroll
    for (int t = 0; t < 4; ++t) O[t] = O[t] * inv;
}

__device__ __forceinline__ void store_o(bf16_t* orow  , const f32x16 (&O)[4]) {
#pragma unroll
    for (int t = 0; t < 4; ++t)
#pragma unroll
        for (int q = 0; q < 4; ++q) { u32x2 w; w.x = pk_bf16(O[t][4 * q], O[t][4 * q + 1]); w.y = pk_bf16(O[t][4 * q + 2], O[t][4 * q + 3]); *(u32x2*)(orow + 32 * t + 8 * q) = w; }
}

__device__ __forceinline__ void diff_task(const Ctx& c, ArgsP a, int l, int bh, int qt) {
    const int b = bh / 6, hd = bh % 6, r = c.lane & 31, h = c.lane >> 5;
    const bf16_t* proj = (const bf16_t*)(c.ws + WS_PROJ); const bf16_t* VT = (const bf16_t*)(c.ws + WS_VT); bf16_t* mix = (bf16_t*)(c.ws + WS_MIX);
    const float* lf = a->in[5] + (size_t)l * 256;
    const float d1 = wave_sum(lf[c.lane] * lf[64 + c.lane]), d2 = wave_sum(lf[128 + c.lane] * lf[192 + c.lane]);
    const float lam_init = 0.8f - 0.6f * expf(-0.3f * (float)l);
    const float lam = expf(d1) - expf(d2) + lam_init;
    const size_t tokq = (size_t)b * SEQ + qt * 32 + r;
    const bf16_t* kb = (const bf16_t*)(c.ws + WS_KFD) + kfd_block(b, hd * 2, 0) + c.lane * 8;
    const bf16_t* vb = VT + vf_block(b, hd, 0) + c.lane * 8;
    f32x16 O1[4];
    LAS unsigned char* wl = c.lds + c.wave * 16384 + c.lane * 16;
    {
        f32x16 O2[4];
        attn_pass<64, true, 2>(proj + tokq * PROJP + C_DQ + hd * 128 + 64 + 8 * h, kb + (size_t)64 * 2048, vb, qt, 0, 0u, r, h, O2, wl);
#pragma unroll
        for (int t = 0; t < 4; ++t)
#pragma unroll
            for (int hf = 0; hf < 2; ++hf) { u32x4 w; w.x = pk_bf16(O2[t][8 * hf], O2[t][8 * hf + 1]); w.y = pk_bf16(O2[t][8 * hf + 2], O2[t][8 * hf + 3]); w.z = pk_bf16(O2[t][8 * hf + 4], O2[t][8 * hf + 5]); w.w = pk_bf16(O2[t][8 * hf + 6], O2[t][8 * hf + 7]);
                *(LAS u32x4*)(wl + 8192 + (t * 2 + hf) * 1024) = w; }
    }
    attn_pass<64, true, 2>(proj + tokq * PROJP + C_DQ + hd * 128 + 8 * h, kb, vb, qt, 0, 0u, r, h, O1, wl);
    float ss = 0.f;
#pragma unroll
    for (int t = 0; t < 4; ++t)
#pragma unroll
        for (int hf = 0; hf < 2; ++hf) { const u32x4 w = *(const LAS u32x4*)(wl + 8192 + (t * 2 + hf) * 1024);
            const float o2[8] = {bflo(w.x), bfhi(w.x), bflo(w.y), bfhi(w.y), bflo(w.z), bfhi(w.z), bflo(w.w), bfhi(w.w)};
#pragma unroll
            for (int e = 0; e < 8; ++e) { const float v = O1[t][8 * hf + e] - lam * o2[e]; O1[t][8 * hf + e] = v; ss += v * v; } }
    ss += __shfl_xor(ss, 32);
    const float rs = (1.f - lam_init) / sqrtf(ss * (1.f / 128.f) + LN_EPS);
    const float* gn = a->in[6] + (size_t)l * 128 + 4 * h;
#pragma unroll
    for (int t = 0; t < 4; ++t)
#pragma unroll
        for (int q = 0; q < 4; ++q) { const f32x4 gv = *(const f32x4*)(gn + 32 * t + 8 * q);
            O1[t][4 * q] *= rs * gv.x; O1[t][4 * q + 1] *= rs * gv.y; O1[t][4 * q + 2] *= rs * gv.z; O1[t][4 * q + 3] *= rs * gv.w; }
    store_o(mix + tokq * DM + hd * 128 + 4 * h, O1);
}

__device__ __forceinline__ void moba_task(const Ctx& c, int bh, int qt) {
    const int b = bh / 6, hd = bh % 6, r = c.lane & 31, h = c.lane >> 5;
    const bf16_t* proj = (const bf16_t*)(c.ws + WS_PROJ); const bf16_t* VT = (const bf16_t*)(c.ws + WS_VT); bf16_t* mix = (bf16_t*)(c.ws + WS_MIX);
    const bf16_t* KM = (const bf16_t*)(c.ws + WS_KM) + (size_t)(b * 6 + hd) * 8 * 128;
    const size_t tokq = (size_t)b * SEQ + qt * 32 + r;
    const bf16_t* qrow = proj + tokq * PROJP + C_MQ + hd * 128 + 8 * h;
    const int own = qt >> 3;
    unsigned selmask = 0u;
    if (own > 3) {
        f32x16 g;
#pragma unroll
        for (int i = 0; i < 16; ++i) g[i] = 0.f;
#pragma unroll
        for (int ks = 0; ks < 8; ++ks) { bf16x8 kf = {0, 0, 0, 0, 0, 0, 0, 0}; if (r < 8) kf = *(const bf16x8*)(KM + r * 128 + 16 * ks + 8 * h);
            const bf16x8 qf = *(const bf16x8*)(qrow + 16 * ks); g = MFMA32(kf, qf, g); }
        float gate[8];
#pragma unroll
        for (int i = 0; i < 4; ++i) { const float mine = g[i], other = __shfl_xor(mine, 32); gate[i] = h ? other : mine; gate[4 + i] = h ? mine : other; }
#pragma unroll
        for (int n = 0; n < 8; ++n) { int rank = 0;
#pragma unroll
            for (int mm = 0; mm < 8; ++mm) { if (mm == n) continue; const bool ahead = (gate[mm] > gate[n]) || (gate[mm] == gate[n] && mm < n); rank += (mm < own && ahead) ? 1 : 0; }
            if (n < own && rank < 3) selmask |= 1u << n; }
    } else selmask = 0xffu;
    f32x16 O[4];
    attn_pass<128, true, 1>(qrow, (const bf16_t*)(c.ws + WS_KFM) + kfm_block(b, hd, 0) + c.lane * 8, VT + vf_block(b, 10 + hd, 0) + c.lane * 8, qt, own, selmask, r, h, O, c.lds + c.wave * 16384 + c.lane * 16);
    store_o(mix + tokq * DM + 1280 + hd * 128 + 4 * h, O);
}

__device__ __forceinline__ void gla_scan_phase(const Ctx& c) {
    const float* DST = (const float*)(c.ws + WS_DST); const float* EL = (const float*)(c.ws + WS_EL); bf16_t* SBT = (bf16_t*)(c.ws + WS_SBT);
    for (int idx = c.gw * 64 + c.lane; idx < 16 * 8192; idx += c.NGW * 64) {
        const int bh = idx >> 13, e = idx & 8191, k = e & 63;
        float S = 0.f;
#pragma unroll 8
        for (int ch = 0; ch < 32; ++ch) {
            const size_t o = (size_t)(bh * 32 + ch) * 8192 + e;
            SBT[o] = (bf16_t)(pk_bf16(S, 0.f) & 0xffffu);
            S = EL[(size_t)(bh * 32 + ch) * 64 + k] * (S + DST[o]);
        }
    }
}
__device__ __forceinline__ void gla_final_task(const Ctx& c, ArgsP a, int l, int bh, int ch) {
    const int r = c.lane & 31, h = c.lane >> 5, b = bh >> 2, hh = bh & 3;
    const bf16_t* QT = (const bf16_t*)(c.ws + WS_QT) + ((size_t)bh * SEQ + ch * 64) * 64;
    const bf16_t* SBT = (const bf16_t*)(c.ws + WS_SBT) + (size_t)(bh * 32 + ch) * 8192;
    const float* OI = (const float*)(c.ws + WS_OI) + ((size_t)bh * SEQ + ch * 64) * 128;
    const bf16_t* proj = (const bf16_t*)(c.ws + WS_PROJ); bf16_t* mix = (bf16_t*)(c.ws + WS_MIX);
    const float* gn = a->in[9] + (size_t)l * 128 + 4 * h;
    for (int it = 0; it < 2; ++it) {
        f32x16 acc[4];
        const float* oi = OI + (size_t)(32 * it + r) * 128 + 4 * h;
#pragma unroll
        for (int dt = 0; dt < 4; ++dt)
#pragma unroll
            for (int q = 0; q < 4; ++q) { const f32x4 v = *(const f32x4*)(oi + 32 * dt + 8 * q); acc[dt][4 * q] = v.x; acc[dt][4 * q + 1] = v.y; acc[dt][4 * q + 2] = v.z; acc[dt][4 * q + 3] = v.w; }
#pragma unroll
        for (int ks = 0; ks < 4; ++ks) {
            const bf16x8 qf = *(const bf16x8*)(QT + (size_t)(32 * it + r) * 64 + 16 * ks + 8 * h);
#pragma unroll
            for (int dt = 0; dt < 4; ++dt) { const bf16x8 sf = *(const bf16x8*)(SBT + (size_t)(32 * dt + r) * 64 + 16 * ks + 8 * h); acc[dt] = MFMA32(sf, qf, acc[dt]); }
        }
        float ss = 0.f;
#pragma unroll
        for (int dt = 0; dt < 4; ++dt)
#pragma unroll
            for (int i = 0; i < 16; ++i) ss += acc[dt][i] * acc[dt][i];
        ss += __shfl_xor(ss, 32);
        const float rs = 1.f / sqrtf(ss * (1.f / 128.f) + LN_EPS);
        const size_t tok = (size_t)b * SEQ + ch * 64 + 32 * it + r;
        const bf16_t* gp = proj + tok * PROJP + C_GR + hh * 128 + 4 * h; bf16_t* mp = mix + tok * DM + 768 + hh * 128 + 4 * h;
#pragma unroll
        for (int dt = 0; dt < 4; ++dt)
#pragma unroll
            for (int q = 0; q < 4; ++q) { const u32x2 gw = *(const u32x2*)(gp + 32 * dt + 8 * q); const f32x4 gv = *(const f32x4*)(gn + 32 * dt + 8 * q);
                const float g0 = bflo(gw.x), g1 = bfhi(gw.x), g2 = bflo(gw.y), g3 = bfhi(gw.y);
                const float o0 = acc[dt][4 * q] * rs * gv.x * (g0 * fsigmoid(g0)), o1 = acc[dt][4 * q + 1] * rs * gv.y * (g1 * fsigmoid(g1));
                const float o2 = acc[dt][4 * q + 2] * rs * gv.z * (g2 * fsigmoid(g2)), o3 = acc[dt][4 * q + 3] * rs * gv.w * (g3 * fsigmoid(g3));
                u32x2 w; w.x = pk_bf16(o0, o1); w.y = pk_bf16(o2, o3); *(u32x2*)(mp + 32 * dt + 8 * q) = w; }
    }
}

__device__ __forceinline__ void attn_phase(const Ctx& c, ArgsP a, int l, int ctr_slot) {
    unsigned* ctr0 = (unsigned*)(c.ws + WS_CTL) + 64 * ctr_slot;
    const int myq = (int)(__builtin_amdgcn_s_getreg((3 << 11) | 20) & 7u);
    for (int qi = 0; qi < 8; ++qi) {
        const int q = (myq + qi) & 7;
        unsigned* ctr = ctr0 + 64 * q;
        for (;;) {
            int t = 0;
            if (c.lane == 0) t = (int)atomicAdd(ctr, 1u);
            t = __builtin_amdgcn_readfirstlane(t);
            if (t >= 448) break;
            Ctx ct = c; { int ln = c.lane; asm volatile("" : "+v"(ln)); ct.lane = ln; }
            int ll = l; asm volatile("" : "+s"(ll));
            if (t >= 384) { const int f = (t - 384) * 8 + q; gla_final_task(ct, a, ll, f >> 5, f & 31); continue; }
            const int grp = t / 192, u = t % 192, qt = 63 - u / 3, j = grp * 3 + u % 3, hh48 = j * 8 + q;
            if (hh48 < 24) diff_task(ct, a, ll, hh48, qt); else moba_task(ct, hh48 - 24, qt);
        }
    }
}

#define XB_TMO      128
#define XB_XCNT(j)  (256  + 64 * (j))
#define XB_XSUB(j)  (1280 + 64 * (j))
#define XB_XGEN(j)  (2304 + 64 * (j))
#define XB_TOP      3328
#define XB_TOPGEN   3392
#define XB_SPIN_CAP (1u << 22)
__device__ __forceinline__ unsigned xb_ld(unsigned* p)              { return __hip_atomic_load(p, __ATOMIC_RELAXED, __HIP_MEMORY_SCOPE_AGENT); }
__device__ __forceinline__ unsigned xb_add(unsigned* p, unsigned v) { return __hip_atomic_fetch_add(p, v, __ATOMIC_RELAXED, __HIP_MEMORY_SCOPE_AGENT); }
__device__ __forceinline__ unsigned xb_xcc_id() { return (unsigned)__builtin_amdgcn_s_getreg((3 << 11) | 20) & 0xFu; }
#define XB_SPIN(cond, bar) do { unsigned _sp = 0; while (cond) { __builtin_amdgcn_s_sleep(1); \
    if ((++_sp & 255u) == 0u) { if (xb_ld(&(bar)[XB_TMO])) break; if (_sp > XB_SPIN_CAP) { atomicAdd(&(bar)[XB_TMO], 1u); break; } } } } while (0)
__device__ __forceinline__ void xcd_barrier_complete(unsigned* bar, unsigned x, unsigned G, unsigned& nloc, unsigned& nx) {
    unsigned sum, cnt, mine, sp = 0u;
    for (;;) {
        sum = 0u; cnt = 0u; mine = 0u;
#pragma unroll
        for (unsigned j = 0; j < 16; ++j) { const unsigned cc = xb_ld(&bar[XB_XCNT(j)]); sum += cc; cnt += (cc > 0u) ? 1u : 0u; mine = (j == x) ? cc : mine; }
        if (sum == G) break;
        __builtin_amdgcn_s_sleep(1);
        if ((++sp & 255u) == 0u) { if (xb_ld(&bar[XB_TMO])) break; if (sp > XB_SPIN_CAP) { atomicAdd(&bar[XB_TMO], 1u); break; } }
    }
    nloc = mine > 0u ? mine : 1u; nx = cnt > 0u ? cnt : 1u;
}
__device__ __forceinline__ void xcd_barrier(unsigned* bar, volatile LAS unsigned* st, unsigned G) {
    asm volatile("s_waitcnt vmcnt(0)" ::: "memory");
    __syncthreads();
    if (threadIdx.x == 0) {
        const unsigned x = xb_xcc_id();
        __builtin_amdgcn_s_waitcnt(0);
        unsigned nloc = st[0], nx = st[1];
        if (nloc == 0u) { xcd_barrier_complete(bar, x, G, nloc, nx); st[0] = nloc; st[1] = nx; }
        const unsigned old = xb_add(&bar[XB_XSUB(x)], 1u);
        const unsigned gen = old / nloc;
        if (old + 1u == (gen + 1u) * nloc) {
            __builtin_amdgcn_fence(__ATOMIC_RELEASE, "agent");
            asm volatile("s_waitcnt vmcnt(0)" ::: "memory");
            const unsigned og = xb_add(&bar[XB_TOP], 1u);
            const unsigned tg = og / nx;
            if (og + 1u == (tg + 1u) * nx) xb_add(&bar[XB_TOPGEN], 1u);
            else XB_SPIN(xb_ld(&bar[XB_TOPGEN]) == tg, bar);
            __builtin_amdgcn_fence(__ATOMIC_ACQUIRE, "agent");
            xb_add(&bar[XB_XGEN(x)], 1u);
            asm volatile("s_waitcnt vmcnt(0)" ::: "memory");
        } else {
            XB_SPIN(xb_ld(&bar[XB_XGEN(x)]) == gen, bar);
            __builtin_amdgcn_fence(__ATOMIC_ACQUIRE, "agent");
            asm volatile("s_waitcnt vmcnt(0)" ::: "memory");
        }
    }
    __syncthreads();
}

__global__ void __launch_bounds__(NTHREADS, 2) fwd_megakernel(Args args) {
    extern __shared__ __attribute__((aligned(16))) unsigned char lds_raw[];
    cg::grid_group grid = cg::this_grid();
    ArgsP ap0 = (ArgsP)__builtin_amdgcn_kernarg_segment_ptr();
    const int ph_lo = ap0->ph_lo, ph_hi = ap0->ph_hi, use_sync = ap0->use_sync, dup_mask = ap0->pad;
    {
        volatile LAS unsigned* st0 = (volatile LAS unsigned*)((LAS unsigned char*)lds_raw + 131072 + 512);
        if (threadIdx.x == 0) { st0[0] = 0u; st0[1] = 0u; (void)xb_add((unsigned*)(ap0->ws + WS_CTL) + 4096 + XB_XCNT(xb_xcc_id()), 1u); }
        __syncthreads();
    }
    for (int ph = ph_lo; ph < ph_hi; ++ph) {
        if (ph > ph_lo && use_sync) {
            if (use_sync == 2) grid.sync();
            else xcd_barrier((unsigned*)(ap0->ws + WS_CTL) + 4096, (volatile LAS unsigned*)((LAS unsigned char*)lds_raw + 131072 + 512), gridDim.x);
        }
        const int ptype = (ph == 0) ? 15 : (ph - 1) % 14, nrep = 1 + ((dup_mask >> ptype) & 1);
        for (int rep = 0; rep < nrep; ++rep) {
        ArgsP ap = ap0; asm volatile("" : "+s"(ap));
        int tid_ = threadIdx.x; asm volatile("" : "+v"(tid_));
        unsigned char* ws = ap->ws;
        int bid_ = blockIdx.x, G_ = gridDim.x; asm volatile("" : "+s"(bid_), "+s"(G_));
        Ctx c; c.tid = tid_; c.lane = c.tid & 63; c.wave = __builtin_amdgcn_readfirstlane(c.tid >> 6); c.G = G_; c.bid = bid_;
        c.gw = c.bid * NWAVES + c.wave; c.NGW = c.G * NWAVES; c.lds = (LAS unsigned char*)lds_raw; c.ws = ws;
        float* X = (float*)(ws + WS_X); bf16_t* XB = (bf16_t*)(ws + WS_XB); bf16_t* HB = (bf16_t*)(ws + WS_H); float* E1 = (float*)(ws + WS_H);
        bf16_t* PROJ = (bf16_t*)(ws + WS_PROJ); bf16_t* VT = (bf16_t*)(ws + WS_VT); bf16_t* MIX = (bf16_t*)(ws + WS_MIX); float* STATS = (float*)(ws + WS_GG + 512 * 1024);
        if (ph == 0) { prologue(ap, c);
            continue; }
        const int l = (ph - 1) / 14; int s = (ph - 1) % 14;
        if (s == 5) { gla_scan_phase(c); continue; }
        if (s > 5) --s;
        unsigned char* wl = ws + WS_W + (size_t)l * WL_SIZE;
        const float* lng = ap->in[18] + (size_t)l * 4 * DM; const float* lnb = ap->in[19] + (size_t)l * 4 * DM;
        const float* xsrc = (l == 0 && s <= 1) ? ap->in[0] : X;
        if (s == 0 || s == 8) {
            pg8::Gemm g{XB, (const bf16_t*)(wl + (s == 0 ? WL_GU1 : WL_GU2)), MTOK, 2 * FF, DM}; pg8::StaticOrder S; S.init(MTOK, 2 * FF, c.G, c.bid);
            pg8::EpiSwiGLU E{HB};
            pg8::gemm_phase<pg8::EpiSwiGLU, pg8::StaticOrder, true, true>(c.lds, g, S, E, c.tid);
            const int half0 = c.G / 2;
            if (c.bid >= half0) {
                if (s == 8) {
                    pg8::Gemm g2{(const bf16_t*)(ws + WS_PB) + (size_t)l * MTOK * PLE, (const bf16_t*)(wl + WL_PE), MTOK, DM, PLE}; pg8::StaticOrder S2; S2.init(MTOK, DM, c.G - half0, c.bid - half0);
                    pg8::EpiF32 E2{(float*)PROJ};
                    pg8::gemm_phase<pg8::EpiF32, pg8::StaticOrder, false, true>(c.lds, g2, S2, E2, c.tid);
                }
                {
                    const int tk = 2 * l + (s == 8 ? 1 : 0), cnt = tail_cnt(tk);
                    LAS float* scr = (LAS float*)(c.lds + c.wave * 16384);
                    for (int it = (c.bid - half0) * NWAVES + c.wave; it < cnt; it += (c.G - half0) * NWAVES) convert_item(ap, c, PER_LAYER + tail_item(tk, it), scr);
                }
            }
        } else if (s == 1 || s == 9) {
            pg8::Gemm g{HB, (const bf16_t*)(wl + (s == 1 ? WL_D1 : WL_D2)), MTOK, DM, FF}; pg8::StaticOrder S; S.init(MTOK, DM, c.G, c.bid);
            const bool raw = (l == 0 && s == 1);
            const float* pg_ = (s == 1) ? (ap->in[18] + (size_t)((l - 1) * 4 + 3) * DM) : (lng + 1 * DM); const float* pb_ = (s == 1) ? (ap->in[19] + (size_t)((l - 1) * 4 + 3) * DM) : (lnb + 1 * DM);
            pg8::EpiResid E{xsrc, X, ALPHA, 0.5f, raw ? nullptr : STATS, pg_, pb_};
            pg8::gemm_phase<pg8::EpiResid, pg8::StaticOrder, false, true>(c.lds, g, S, E, c.tid);
        } else if (s == 2 || s == 7 || s == 10 || s == 12) {
            const int which = (s == 2) ? 0 : (s == 7) ? 1 : (s == 10) ? 2 : 3;
            const bool final_ln = (l == DEPTH - 1 && s == 12);
            ln_phase(c, X, final_ln ? ap->out : nullptr, final_ln ? nullptr : XB, STATS, lng + which * DM, lnb + which * DM);
        } else if (s == 3) {
            { pg8::Gemm g{XB, (const bf16_t*)(wl + WL_IN), MTOK, PROJW, DM}; pg8::StaticOrder S; S.init(MTOK, PROJW, c.G, c.bid);
              pg8::EpiProj E{PROJ, (const float*)(ws + WS_R128), (const float*)(ws + WS_R64), (bf16_t*)(ws + WS_KFD), (bf16_t*)(ws + WS_KFM)};
              pg8::gemm_phase<pg8::EpiProj, pg8::StaticOrder, true, true>(c.lds, g, S, E, c.tid);
            }
            { pg8::Gemm g{(const bf16_t*)(wl + WL_V), XB, DM, MTOK, DM}; pg8::StaticOrder S; S.init(DM, MTOK, c.G, c.bid);
              pg8::EpiVt E{VT};
              pg8::gemm_phase<pg8::EpiVt, pg8::StaticOrder, false, true>(c.lds, g, S, E, c.tid); }
            gg_phase(c, XB, (const bf16_t*)(wl + WL_GG), (float*)(ws + WS_GG));
        } else if (s == 4) {
            post_phase(c, ap, l);
        } else if (s == 5) {
            attn_phase(c, ap, l, 1 + 16 * l + 8 * rep);
        } else if (s == 6) {
            pg8::Gemm g{MIX, (const bf16_t*)(wl + WL_OUT), MTOK, DM, DM}; pg8::StaticOrder S; S.init(MTOK, DM, c.G, c.bid);
            pg8::EpiResid E{X, X, ALPHA, 1.0f, STATS, lng, lnb};
            pg8::gemm_phase<pg8::EpiResid, pg8::StaticOrder, false, true>(c.lds, g, S, E, c.tid);
        } else if (s == 11) {
            { pg8::Gemm g{XB, (const bf16_t*)(wl + WL_PG), MTOK, DM, DM}; pg8::StaticOrder S; S.init(MTOK, DM, c.G, c.bid);
              pg8::EpiGate E{X, X, (const float*)PROJ, ALPHA, STATS, lng + 2 * DM, lnb + 2 * DM};
              pg8::gemm_phase<pg8::EpiGate, pg8::StaticOrder, false, true>(c.lds, g, S, E, c.tid); }
        }
        }
    }
}

extern "C" void kernel_launch(void* const* d_in, const int* in_sizes, int n_in, void* d_out, int out_size, void* d_ws, size_t ws_size, hipStream_t stream) {
    static int grid = 0;
    if (grid == 0) {
        if (n_in != 20 || in_sizes[0] != MTOK * DM || out_size != MTOK * DM || ws_size < WS_END) {
            fprintf(stderr, "kernel_launch: unexpected shapes (n_in %d, in0 %d, out %d, ws %zu need %zu)\n", n_in, n_in > 0 ? in_sizes[0] : -1, out_size, ws_size, (size_t)WS_END); grid = -1; return; }
        int dev = 0, cus = 0, per_cu = 0;
        hipGetDevice(&dev); hipDeviceGetAttribute(&cus, hipDeviceAttributeMultiprocessorCount, dev);
        hipFuncSetAttribute((const void*)fwd_megakernel, hipFuncAttributeMaxDynamicSharedMemorySize, LDS_BYTES);
        hipOccupancyMaxActiveBlocksPerMultiprocessor(&per_cu, (const void*)fwd_megakernel, NTHREADS, LDS_BYTES);
        if (per_cu < 1) { fprintf(stderr, "kernel_launch: occupancy query says %d blocks per CU\n", per_cu); per_cu = 1; }
        (void)hipGetLastError();
        grid = cus * per_cu;
        fprintf(stderr, "kernel_launch: grid %d (cus %d x %d)\n", grid, cus, per_cu);
    }
    if (grid < 0) return;
    hipMemsetAsync((char*)d_ws + WS_CTL, 0, 1 * MiB, stream);
    Args a{};
    for (int i = 0; i < 20; ++i) a.in[i] = (const float*)d_in[i];
    a.out = (float*)d_out; a.ws = (unsigned char*)d_ws; a.ph_lo = 0; a.ph_hi = 29; a.use_sync = 1;
#ifndef DUP_MASK
#define DUP_MASK 0
#endif
    a.pad = DUP_MASK;
    void* kargs[] = {&a};
    hipError_t e = hipLaunchCooperativeKernel((const void*)fwd_megakernel, dim3(grid), dim3(NTHREADS), kargs, LDS_BYTES, stream);
    if (e != hipSuccess) fprintf(stderr, "cooperative launch failed: %s (grid %d)\n", hipGetErrorString(e), grid);
}
```

```cpp
#include <hip/hip_runtime.h>
#include <hip/hip_cooperative_groups.h>
#include <cstdio>
#include <cstdint>
namespace cg = cooperative_groups;

#define LAS __attribute__((address_space(3)))
typedef unsigned short bf16_t;
typedef short bf16x8 __attribute__((ext_vector_type(8)));
typedef float f32x2 __attribute__((ext_vector_type(2)));
typedef float f32x4 __attribute__((ext_vector_type(4)));
typedef float f32x16 __attribute__((ext_vector_type(16)));
typedef unsigned u32x2 __attribute__((ext_vector_type(2)));
typedef unsigned u32x4 __attribute__((ext_vector_type(4)));

constexpr int NB = 4, SEQ = 2048, DM = 2048, MTOK = NB * SEQ, FF = 5632, DIN = 6160, PLE = 256, DEPTH = 2;
constexpr int PROJW = 4096, PROJP = 4160, VTP = 8256;
constexpr int C_DQ = 0, C_DK = 768, C_MQ = 1536, C_MK = 2304, C_GQ = 3072, C_GK = 3328, C_GR = 3584;
constexpr int W_DQ = 0, W_DK = 768, W_DV = 1536, W_GQ = 2304, W_GK = 2560, W_GV = 2816, W_GR = 3328, W_GG = 3840, W_MQ = 3856, W_MK = 4624, W_MV = 5392;
constexpr float LN_EPS = 1e-5f;
constexpr float ALPHA = 1.4142135623730951f;
constexpr float LOG2E = 1.4426950408889634f;
constexpr float NEG_BIG = -1.0e30f;

constexpr size_t MiB = 1u << 20;
constexpr size_t WL_GU1 = 0, WL_D1 = 44 * MiB, WL_IN = 66 * MiB, WL_V = 82 * MiB, WL_OUT = 90 * MiB, WL_GU2 = 98 * MiB, WL_D2 = 142 * MiB, WL_PE = 164 * MiB, WL_PG = 165 * MiB, WL_GG = 173 * MiB, WL_SIZE = 174 * MiB;
constexpr size_t WS_CTL = 0;
constexpr size_t WS_W = 1 * MiB;
constexpr size_t WS_X = WS_W + 2 * WL_SIZE;
constexpr size_t WS_XB = WS_X + 64 * MiB;
constexpr size_t WS_H = WS_XB + 32 * MiB;
constexpr size_t WS_PROJ = WS_H + 88 * MiB;
constexpr size_t WS_VT = WS_PROJ + 66 * MiB;
constexpr size_t WS_MIX = WS_VT + 33 * MiB;
constexpr size_t WS_PB = WS_MIX + 32 * MiB;
constexpr size_t WS_R128 = WS_PB + 8 * MiB;
constexpr size_t WS_R64 = WS_R128 + 4 * MiB;
constexpr size_t WS_GG = WS_R64 + 2 * MiB;
constexpr size_t WS_QT = WS_GG + 1 * MiB;
constexpr size_t WS_KT = WS_QT + 4 * MiB;
constexpr size_t WS_KTT = WS_KT + 4 * MiB;
constexpr size_t WS_EL = WS_KTT + 4 * MiB;
constexpr size_t WS_KM = WS_EL + 1 * MiB;
constexpr size_t WS_OI = WS_KM + 1 * MiB;
constexpr size_t WS_DST = WS_OI + 16 * MiB;
constexpr size_t WS_SBT = WS_DST + 16 * MiB;
constexpr size_t WS_KFD = WS_SBT + 8 * MiB;
constexpr size_t WS_KFM = WS_KFD + 12 * MiB;
constexpr size_t WS_END = WS_KFM + 12 * MiB;

constexpr int LDS_BYTES = 147456;
constexpr int NWAVES = 8, NTHREADS = 512;

__device__ __forceinline__ size_t vf_block(int b, int u, int tile) { return (size_t)((b * 16 + u) * 64 + tile) * 4096; }
__device__ __forceinline__ size_t kfd_block(int b, int sk, int tile) { return (size_t)((b * 12 + sk) * 64 + tile) * 2048; }
__device__ __forceinline__ size_t kfm_block(int b, int hd, int tile) { return (size_t)((b * 6 + hd) * 64 + tile) * 4096; }
__device__ __forceinline__ float bf2f(bf16_t b) { return __uint_as_float(((unsigned)b) << 16); }
__device__ __forceinline__ float bflo(unsigned w) { return __uint_as_float(w << 16); }
__device__ __forceinline__ float bfhi(unsigned w) { return __uint_as_float(w & 0xffff0000u); }
typedef __bf16 bf16x2_t __attribute__((ext_vector_type(2)));
__device__ __forceinline__ unsigned pk_bf16(float lo, float hi) { f32x2 v = {lo, hi}; bf16x2_t b = __builtin_convertvector(v, bf16x2_t); return __builtin_bit_cast(unsigned, b); }
__device__ __forceinline__ float wave_sum(float v) {
#pragma unroll
    for (int o = 1; o < 64; o <<= 1) v += __shfl_xor(v, o);
    return v;
}
__device__ __forceinline__ float fexp2(float x) { return __builtin_amdgcn_exp2f(x); }
__device__ __forceinline__ float fsigmoid(float x) { return __builtin_amdgcn_rcpf(1.f + fexp2(-x * LOG2E)); }
__device__ __forceinline__ int crow(int reg, int h) { return (reg & 3) + 8 * (reg >> 2) + 4 * h; }
#define MFMA32(a, b, c) __builtin_amdgcn_mfma_f32_32x32x16_bf16((a), (b), (c), 0, 0, 0)
#define LDS_WAIT() asm volatile("s_waitcnt lgkmcnt(0)" ::: "memory")
__device__ __forceinline__ bf16x8 pack8(const f32x16& x, int s) {
    u32x4 p;
    p.x = pk_bf16(x[8 * s + 0], x[8 * s + 1]); p.y = pk_bf16(x[8 * s + 2], x[8 * s + 3]);
    p.z = pk_bf16(x[8 * s + 4], x[8 * s + 5]); p.w = pk_bf16(x[8 * s + 6], x[8 * s + 7]);
    return __builtin_bit_cast(bf16x8, p);
}

namespace pg8 {
constexpr int BM = 256, BK = 64, HALF = 128, HTB = HALF * BK * 2, STAGE_BYTES = 8 * HTB, NXCD = 8, WGM = 8;
__host__ __device__ __forceinline__ int lds_byte(int r, int c) { const int st = (r >> 4) * 2 + (c >> 5), rr = r & 15, cc = c & 31, ob = rr * 64 + cc * 2; return st * 1024 + (ob ^ (((ob >> 9) & 1) << 5)); }
__host__ __device__ __forceinline__ void stage_rc(int b, int& R, int& C) { const int st = b / 1024, sb = b % 1024, swz = sb ^ (((sb >> 9) & 1) << 5); R = (st >> 1) * 16 + swz / 64; C = (st & 1) * 32 + (swz % 64) / 2; }
__host__ __device__ __forceinline__ int perm32(int rho) { const int n = rho >> 4, i = rho & 15; return 8 * (i >> 2) + 4 * n + (i & 3); }
struct Unit { int pm, pn; };
struct Gemm { const bf16_t* A; const bf16_t* Bt; int M, N, K; };
struct StaticOrder {
    int nM, nN, nwg, G, c;
    __host__ __device__ void init(int M, int N, int G_, int c_) { nM = M / BM; nN = N / BM; nwg = nM * nN; G = G_; c = c_; }
    __host__ __device__ bool next(int i, Unit& u) const {
        const long L = (long)i * G + c; if (L >= nwg) return false;
        int wgid = (int)L; { const int q = nwg / NXCD, r = nwg % NXCD, xcd = wgid % NXCD, off = wgid / NXCD; wgid = (xcd < r ? xcd * (q + 1) : r * (q + 1) + (xcd - r) * q) + off; }
        const int nig = WGM * nN, gid = wgid / nig, fm = gid * WGM, gsz = (nM - fm) < WGM ? (nM - fm) : WGM;
        u.pm = fm + ((wgid % nig) % gsz); u.pn = (wgid % nig) / gsz; return true;
    }
    __device__ __forceinline__ void a_ready(const Unit&) const {}
    __device__ __forceinline__ void done(const Unit&) const {}
};

template <class Epi, class Sched, bool ALIGN_EPI = false, bool SP2 = false>
__device__ __forceinline__ void gemm_phase(LAS unsigned char* lds, const Gemm g, const Sched& S, const Epi& E, const int tid) {
    const int wid = __builtin_amdgcn_readfirstlane(tid >> 6), lane = tid & 63, wr = wid >> 2, wc = wid & 3, fr = lane & 15, fq = lane >> 4;
    const int K = g.K, nt = K / BK;
    unsigned voffA[2], voffB[2];
#pragma unroll
    for (int i = 0; i < 2; ++i) { int R, C; stage_rc(tid * 16 + i * 8192, R, C); const int Rb = Epi::PERM ? ((R & ~31) + perm32(R & 31)) : R;
        voffA[i] = (unsigned)(R * K + C) * 2u; voffB[i] = (unsigned)(Rb * K + C) * 2u; }
    const size_t kstep = (size_t)(BK * 2);
    const size_t hstep = (size_t)HALF * K * 2;
    const size_t tstep = 2 * hstep;
    const unsigned ldsw = (unsigned)wid * 1024u;
    const int aoff = lds_byte(wr * 64 + fr, fq * 8), boff = lds_byte(wc * 32 + fr, fq * 8);
#define PG8_SA(b, h) (((b) * 2 + (h)) * HTB)
#define PG8_SB(b, h) ((4 + (b) * 2 + (h)) * HTB)
#define PG8_STAGE(bufoff, gbase, voff) do { _Pragma("unroll") for (int _i = 0; _i < 2; ++_i) \
        __builtin_amdgcn_global_load_lds((const unsigned*)((const char*)(gbase) + (voff)[_i]), (LAS unsigned*)(lds + (bufoff) + ldsw + _i * 8192), 16, 0, 0); } while (0)
#define PG8_LDA(dst, b, h) do { _Pragma("unroll") for (int m = 0; m < 4; ++m) _Pragma("unroll") for (int k = 0; k < 2; ++k) dst[m][k] = *(const LAS bf16x8*)(lds + PG8_SA(b, h) + aoff + m * 2048 + k * 1024); } while (0)
#define PG8_LDB(dst, b, h) do { _Pragma("unroll") for (int n = 0; n < 2; ++n) _Pragma("unroll") for (int k = 0; k < 2; ++k) dst[n][k] = *(const LAS bf16x8*)(lds + PG8_SB(b, h) + boff + n * 2048 + k * 1024); } while (0)
#define PG8_MMA(ai, bj, At, Bt) do { __builtin_amdgcn_s_setprio(1); _Pragma("unroll") for (int m = 0; m < 4; ++m) _Pragma("unroll") for (int n = 0; n < 2; ++n) _Pragma("unroll") for (int k = 0; k < 2; ++k) \
        acc[ai][bj][m][n] = __builtin_amdgcn_mfma_f32_16x16x32_bf16(Bt[n][k], At[m][k], acc[ai][bj][m][n], 0, 0, 0); __builtin_amdgcn_s_setprio(0); } while (0)
#define PG8_WAIT_V(n) asm volatile("s_waitcnt vmcnt(" #n ")" ::: "memory")
#define PG8_WAIT_L(n) asm volatile("s_waitcnt lgkmcnt(" #n ")" ::: "memory")
#define PG8_BAR __builtin_amdgcn_s_barrier()
#define PG8_SCHED __builtin_amdgcn_sched_barrier(0)
    Unit cur, nxt; int ui = 0;
    if (!S.next(0, cur)) return;
    f32x4 acc[2][2][4][2];
#pragma unroll
    for (int a = 0; a < 2; ++a)
#pragma unroll
        for (int b = 0; b < 2; ++b)
#pragma unroll
            for (int m = 0; m < 4; ++m)
#pragma unroll
                for (int n = 0; n < 2; ++n) acc[a][b][m][n] = (f32x4){0.f, 0.f, 0.f, 0.f};
    bf16x8 At[4][2], B0[2][2], B1[2][2];
    const char* cA = (const char*)g.A + (size_t)cur.pm * tstep; const char* cB = (const char*)g.Bt + (size_t)cur.pn * tstep;
    S.a_ready(cur);
    if constexpr (SP2) {
        PG8_STAGE(PG8_SB(0, 0), cB, voffB); PG8_STAGE(PG8_SB(0, 1), cB + hstep, voffB); PG8_STAGE(PG8_SA(0, 0), cA, voffA); PG8_STAGE(PG8_SA(0, 1), cA + hstep, voffA);
        if (wr == 1) PG8_BAR;
        PG8_WAIT_V(2); PG8_BAR;
        PG8_STAGE(PG8_SB(1, 0), cB + kstep, voffB); PG8_STAGE(PG8_SA(1, 0), cA + kstep, voffA); PG8_STAGE(PG8_SB(1, 1), cB + hstep + kstep, voffB);
        PG8_WAIT_V(6); PG8_BAR;
    } else {
        PG8_STAGE(PG8_SB(0, 0), cB, voffB); PG8_STAGE(PG8_SA(0, 0), cA, voffA); PG8_STAGE(PG8_SB(0, 1), cB + hstep, voffB); PG8_STAGE(PG8_SA(0, 1), cA + hstep, voffA);
        if (wr == 1) PG8_BAR;
        PG8_WAIT_V(4); PG8_BAR;
        PG8_STAGE(PG8_SB(1, 0), cB + kstep, voffB); PG8_STAGE(PG8_SA(1, 0), cA + kstep, voffA); PG8_STAGE(PG8_SB(1, 1), cB + hstep + kstep, voffB);
        PG8_WAIT_V(6); PG8_BAR;
    }
    for (;;) {
        const bool has_next = S.next(ui + 1, nxt);
        const char* nA = has_next ? (const char*)g.A + (size_t)nxt.pm * tstep : cA; const char* nB = has_next ? (const char*)g.Bt + (size_t)nxt.pn * tstep : cB;
        for (int t = 0; t < nt; t += 2) {
            const bool last = (t == nt - 2);
            const char* a1 = cA + (size_t)(t + 1) * kstep;
            const char* a2 = last ? nA : cA + (size_t)(t + 2) * kstep; const char* b2 = last ? nB : cB + (size_t)(t + 2) * kstep;
            const char* a3 = a2 + kstep; const char* b3 = b2 + kstep;
            if (last && has_next) S.a_ready(nxt);
            if constexpr (SP2) {
            PG8_LDB(B0, 0, 0); PG8_LDB(B1, 0, 1); PG8_SCHED; PG8_LDA(At, 0, 0); PG8_STAGE(PG8_SA(1, 1), a1 + hstep, voffA);
            PG8_WAIT_V(8); PG8_WAIT_L(0); PG8_BAR; PG8_MMA(0, 0, At, B0); PG8_MMA(0, 1, At, B1); PG8_BAR; PG8_SCHED;
            PG8_LDA(At, 0, 1); PG8_STAGE(PG8_SB(0, 0), b2, voffB); PG8_STAGE(PG8_SB(0, 1), b2 + hstep, voffB); PG8_STAGE(PG8_SA(0, 0), a2, voffA);
            PG8_WAIT_V(8); PG8_WAIT_L(0); PG8_BAR; PG8_MMA(1, 0, At, B0); PG8_MMA(1, 1, At, B1); PG8_BAR; PG8_SCHED;
            PG8_LDB(B0, 1, 0); PG8_LDB(B1, 1, 1); PG8_SCHED; PG8_LDA(At, 1, 0); PG8_STAGE(PG8_SA(0, 1), a2 + hstep, voffA);
            PG8_WAIT_V(8); PG8_WAIT_L(0); PG8_BAR; PG8_MMA(0, 0, At, B0); PG8_MMA(0, 1, At, B1); PG8_BAR; PG8_SCHED;
            PG8_LDA(At, 1, 1); PG8_STAGE(PG8_SB(1, 0), b3, voffB); PG8_STAGE(PG8_SB(1, 1), b3 + hstep, voffB); PG8_STAGE(PG8_SA(1, 0), a3, voffA);
            PG8_WAIT_V(8); PG8_WAIT_L(0); PG8_BAR; PG8_MMA(1, 0, At, B0); PG8_MMA(1, 1, At, B1); PG8_BAR; PG8_SCHED;
            } else {
            PG8_LDB(B0, 0, 0); PG8_SCHED; PG8_LDA(At, 0, 0); PG8_STAGE(PG8_SA(1, 1), a1 + hstep, voffA);
            PG8_WAIT_L(8); PG8_BAR; PG8_WAIT_L(0); PG8_MMA(0, 0, At, B0); PG8_BAR; PG8_SCHED;
            PG8_LDB(B1, 0, 1); PG8_STAGE(PG8_SB(0, 0), b2, voffB);
            PG8_BAR; PG8_WAIT_L(0); PG8_MMA(0, 1, At, B1); PG8_BAR;
            PG8_LDA(At, 0, 1); PG8_STAGE(PG8_SA(0, 0), a2, voffA);
            PG8_BAR; PG8_WAIT_L(0); PG8_MMA(1, 0, At, B0); PG8_BAR; PG8_SCHED;
            PG8_STAGE(PG8_SB(0, 1), b2 + hstep, voffB);
            PG8_WAIT_V(6); PG8_BAR; PG8_MMA(1, 1, At, B1); PG8_BAR;
            PG8_LDB(B0, 1, 0); PG8_SCHED; PG8_LDA(At, 1, 0); PG8_STAGE(PG8_SA(0, 1), a2 + hstep, voffA);
            PG8_WAIT_L(8); PG8_BAR; PG8_WAIT_L(0); PG8_MMA(0, 0, At, B0); PG8_BAR; PG8_SCHED;
            PG8_LDB(B1, 1, 1); PG8_STAGE(PG8_SB(1, 0), b3, voffB);
            PG8_BAR; PG8_WAIT_L(0); PG8_MMA(0, 1, At, B1); PG8_BAR;
            PG8_LDA(At, 1, 1); PG8_STAGE(PG8_SA(1, 0), a3, voffA);
            PG8_BAR; PG8_WAIT_L(0); PG8_MMA(1, 0, At, B0); PG8_BAR; PG8_SCHED;
            PG8_STAGE(PG8_SB(1, 1), b3 + hstep, voffB);
            PG8_WAIT_V(6); PG8_BAR; PG8_MMA(1, 1, At, B1); PG8_BAR;
            }
        }
        if constexpr (ALIGN_EPI) { if (wr == 0) PG8_BAR; }
        E(acc, cur, wr, wc, fr, fq); S.done(cur);
        if (!has_next) break;
#pragma unroll
        for (int a = 0; a < 2; ++a)
#pragma unroll
            for (int b = 0; b < 2; ++b)
#pragma unroll
                for (int m = 0; m < 4; ++m)
#pragma unroll
                    for (int n = 0; n < 2; ++n) acc[a][b][m][n] = (f32x4){0.f, 0.f, 0.f, 0.f};
        cur = nxt; cA = nA; cB = nB; ++ui;
        if constexpr (ALIGN_EPI) { if (wr == 1) PG8_BAR; }
    }
    PG8_WAIT_V(0);
    if constexpr (!ALIGN_EPI) { if (wr == 0) PG8_BAR; }
    PG8_BAR;
#undef PG8_SA
#undef PG8_SB
#undef PG8_STAGE
#undef PG8_LDA
#undef PG8_LDB
#undef PG8_MMA
#undef PG8_WAIT_V
#undef PG8_WAIT_L
#undef PG8_BAR
#undef PG8_SCHED
}

typedef const f32x4 (&AccRef)[2][2][4][2];

struct EpiSwiGLU {
    static constexpr bool PERM = true;
    bf16_t* H;
    __device__ __forceinline__ void operator()(AccRef acc, const Unit& u, int wr, int wc, int fr, int fq) const {
        const int row0 = u.pm * BM + wr * 64 + fr, col0 = u.pn * 128 + wc * 32 + 8 * fq;
#pragma unroll
        for (int ai = 0; ai < 2; ++ai)
#pragma unroll
            for (int m = 0; m < 4; ++m) {
                float o[8];
#pragma unroll
                for (int n = 0; n < 2; ++n)
#pragma unroll
                    for (int j = 0; j < 4; ++j) { const float g = acc[ai][0][m][n][j], up = acc[ai][1][m][n][j]; o[4 * n + j] = g * fsigmoid(g) * up; }
                u32x4 w; w.x = pk_bf16(o[0], o[1]); w.y = pk_bf16(o[2], o[3]); w.z = pk_bf16(o[4], o[5]); w.w = pk_bf16(o[6], o[7]);
                *(u32x4*)(H + (size_t)(row0 + ai * HALF + m * 16) * FF + col0) = w;
            }
    }
};
struct EpiResid {
    static constexpr bool PERM = false;
    const float* src; float* dst; float alpha, beta; const float* stats; const float* g; const float* b;
    __device__ __forceinline__ void operator()(AccRef acc, const Unit& u, int wr, int wc, int fr, int fq) const {
        const int row0 = u.pm * BM + wr * 64 + fr, col0 = u.pn * BM + wc * 32 + 4 * fq;
        f32x4 gv[2][2], bv[2][2];
#pragma unroll
        for (int bj = 0; bj < 2; ++bj)
#pragma unroll
            for (int n = 0; n < 2; ++n) { gv[bj][n] = *(const f32x4*)(g + col0 + bj * HALF + n * 16); bv[bj][n] = *(const f32x4*)(b + col0 + bj * HALF + n * 16); }
#pragma unroll
        for (int ai = 0; ai < 2; ++ai)
#pragma unroll
            for (int mp = 0; mp < 2; ++mp) {
                f32x4 zv[2][2][2]; f32x2 st[2];
#pragma unroll
                for (int mm = 0; mm < 2; ++mm) { const int row = row0 + ai * HALF + (2 * mp + mm) * 16; st[mm] = *(const f32x2*)(stats + 2 * row);
#pragma unroll
                    for (int bj = 0; bj < 2; ++bj)
#pragma unroll
                        for (int n = 0; n < 2; ++n) zv[mm][bj][n] = *(const f32x4*)(src + (size_t)row * DM + col0 + bj * HALF + n * 16); }
#pragma unroll
                for (int mm = 0; mm < 2; ++mm) { const int m = 2 * mp + mm; const size_t ro = (size_t)(row0 + ai * HALF + m * 16) * DM + col0;
#pragma unroll
                    for (int bj = 0; bj < 2; ++bj)
#pragma unroll
                        for (int n = 0; n < 2; ++n) { const f32x4 xv = (zv[mm][bj][n] - st[mm].x) * st[mm].y * gv[bj][n] + bv[bj][n];
                            *(f32x4*)(dst + ro + bj * HALF + n * 16) = xv * alpha + acc[ai][bj][m][n] * beta; } }
            }
    }
};
struct EpiF32 {
    static constexpr bool PERM = false;
    float* C;
    __device__ __forceinline__ void operator()(AccRef acc, const Unit& u, int wr, int wc, int fr, int fq) const {
        const int row0 = u.pm * BM + wr * 64 + fr, col0 = u.pn * BM + wc * 32 + 4 * fq;
#pragma unroll
        for (int ai = 0; ai < 2; ++ai)
#pragma unroll
            for (int m = 0; m < 4; ++m) { const size_t ro = (size_t)(row0 + ai * HALF + m * 16) * DM + col0;
#pragma unroll
                for (int bj = 0; bj < 2; ++bj)
#pragma unroll
                    for (int n = 0; n < 2; ++n) *(f32x4*)(C + ro + bj * HALF + n * 16) = acc[ai][bj][m][n]; }
    }
};
struct EpiGate {
    static constexpr bool PERM = false;
    const float* src; float* dst; const float* E1; float alpha; const float* stats; const float* g; const float* b;
    __device__ __forceinline__ void operator()(AccRef acc, const Unit& u, int wr, int wc, int fr, int fq) const {
        const int row0 = u.pm * BM + wr * 64 + fr, col0 = u.pn * BM + wc * 32 + 4 * fq;
        f32x4 gv[2][2], bv[2][2];
#pragma unroll
        for (int bj = 0; bj < 2; ++bj)
#pragma unroll
            for (int n = 0; n < 2; ++n) { gv[bj][n] = *(const f32x4*)(g + col0 + bj * HALF + n * 16); bv[bj][n] = *(const f32x4*)(b + col0 + bj * HALF + n * 16); }
#pragma unroll
        for (int ai = 0; ai < 2; ++ai)
#pragma unroll
            for (int m = 0; m < 4; ++m) { const int row = row0 + ai * HALF + m * 16; const size_t ro = (size_t)row * DM + col0;
                const f32x2 st = *(const f32x2*)(stats + 2 * row);
                f32x4 zv[2][2], ev[2][2];
#pragma unroll
                for (int bj = 0; bj < 2; ++bj)
#pragma unroll
                    for (int n = 0; n < 2; ++n) { zv[bj][n] = *(const f32x4*)(src + ro + bj * HALF + n * 16); ev[bj][n] = *(const f32x4*)(E1 + ro + bj * HALF + n * 16); }
#pragma unroll
                for (int bj = 0; bj < 2; ++bj)
#pragma unroll
                    for (int n = 0; n < 2; ++n) { const size_t o = ro + bj * HALF + n * 16; const f32x4 a = acc[ai][bj][m][n];
                        const f32x4 xv = (zv[bj][n] - st.x) * st.y * gv[bj][n] + bv[bj][n]; const f32x4 e = ev[bj][n];
                        f32x4 r; r.x = xv.x * alpha + e.x * fsigmoid(a.x); r.y = xv.y * alpha + e.y * fsigmoid(a.y); r.z = xv.z * alpha + e.z * fsigmoid(a.z); r.w = xv.w * alpha + e.w * fsigmoid(a.w);
                        *(f32x4*)(dst + o) = r; } }
    }
};
struct EpiVt {
    static constexpr bool PERM = false;
    bf16_t* VF;
    __device__ __forceinline__ void operator()(AccRef acc, const Unit& u, int wr, int wc, int fr, int fq) const {
        const int row0 = u.pm * BM + wr * 64 + fr;
#pragma unroll
        for (int ai = 0; ai < 2; ++ai)
#pragma unroll
            for (int m = 0; m < 4; ++m) { const int row = row0 + ai * HALF + m * 16, uu = row >> 7, t = (row >> 5) & 3, r = row & 31;
#pragma unroll
                for (int bj = 0; bj < 2; ++bj) { const int T = u.pn * 8 + bj * 4 + wc, bb = T >> 6, tile = T & 63;
                    bf16_t* bp = VF + vf_block(bb, uu, tile) + (size_t)(t * 2) * 512 + ((fq & 1) * 32 + r) * 8 + 4 * (fq >> 1);
#pragma unroll
                    for (int n = 0; n < 2; ++n) { const f32x4 a = acc[ai][bj][m][n]; u32x2 w; w.x = pk_bf16(a.x, a.y); w.y = pk_bf16(a.z, a.w); *(u32x2*)(bp + n * 512) = w; } } }
    }
};
struct EpiProj {
    static constexpr bool PERM = true;
    bf16_t* P; const float* rope128; const float* rope64; bf16_t* KFD; bf16_t* KFM;
    __device__ __forceinline__ void operator()(AccRef acc, const Unit& u, int wr, int wc, int fr, int fq) const {
        const int pn = u.pn, row0 = u.pm * BM + wr * 64 + fr;
        if (pn < 12) {
            const bool isdiff = pn < 6; const int pp = isdiff ? pn : pn - 6; const int g = pp / 3, tg = pp % 3;
            const float sc = (g == 0) ? (isdiff ? 0.125f * LOG2E : 0.08838834764831845f * LOG2E) : 1.f;
            int fbase, col1, half, rpitch; const float* rt0;
            if (isdiff) { fbase = 8 * fq; col1 = g * 768 + (tg * 4 + wc) * 64 + fbase; half = 32; rpitch = 64; rt0 = rope64; }
            else { fbase = 32 * (wc & 1) + 8 * fq; col1 = C_MQ + g * 768 + (tg * 2 + (wc >> 1)) * 128 + fbase; half = 64; rpitch = 128; rt0 = rope128; }
#pragma unroll
            for (int ai = 0; ai < 2; ++ai)
#pragma unroll
                for (int m = 0; m < 4; ++m) { const int row = row0 + ai * HALF + m * 16;
                    const f32x4* rt = (const f32x4*)(rt0 + (size_t)row * rpitch + 2 * fbase);
                    float o1[8], o2[8];
#pragma unroll
                    for (int q = 0; q < 4; ++q) { const f32x4 cs = rt[q];
#pragma unroll
                        for (int e = 0; e < 2; ++e) { const int idx = 2 * q + e; const float a = acc[ai][0][m][idx >> 2][idx & 3], b = acc[ai][1][m][idx >> 2][idx & 3];
                            const float c = e ? cs.z : cs.x, s = e ? cs.w : cs.y; o1[idx] = (a * c - b * s) * sc; o2[idx] = (b * c + a * s) * sc; } }
                    bf16_t* rp = P + (size_t)row * PROJP + col1;
                    u32x4 w1, w2; w1.x = pk_bf16(o1[0], o1[1]); w1.y = pk_bf16(o1[2], o1[3]); w1.z = pk_bf16(o1[4], o1[5]); w1.w = pk_bf16(o1[6], o1[7]);
                    w2.x = pk_bf16(o2[0], o2[1]); w2.y = pk_bf16(o2[2], o2[3]); w2.z = pk_bf16(o2[4], o2[5]); w2.w = pk_bf16(o2[6], o2[7]);
                    if (g == 0 || !isdiff) { *(u32x4*)rp = w1; *(u32x4*)(rp + half) = w2; }
                    if (g == 1) {
                        const int bb = row >> 11, tile = (row >> 5) & 63, lslot = ((fq & 1) * 32 + (row & 31)) * 8;
                        if (isdiff) { bf16_t* kp = KFD + kfd_block(bb, tg * 4 + wc, tile) + lslot; const int ks = fq >> 1; *(u32x4*)(kp + ks * 512) = w1; *(u32x4*)(kp + (ks + 2) * 512) = w2; }
                        else { bf16_t* kp = KFM + kfm_block(bb, tg * 2 + (wc >> 1), tile) + lslot; const int ks = 2 * (wc & 1) + (fq >> 1); *(u32x4*)(kp + ks * 512) = w1; *(u32x4*)(kp + (ks + 4) * 512) = w2; } } }
        } else {
            const int col0 = C_GQ + (pn - 12) * 256 + wc * 32 + 8 * fq;
#pragma unroll
            for (int ai = 0; ai < 2; ++ai)
#pragma unroll
                for (int m = 0; m < 4; ++m) { bf16_t* rp = P + (size_t)(row0 + ai * HALF + m * 16) * PROJP + col0;
#pragma unroll
                    for (int bj = 0; bj < 2; ++bj) { const f32x4 v0 = acc[ai][bj][m][0], v1 = acc[ai][bj][m][1]; u32x4 w; w.x = pk_bf16(v0.x, v0.y); w.y = pk_bf16(v0.z, v0.w); w.z = pk_bf16(v1.x, v1.y); w.w = pk_bf16(v1.z, v1.w); *(u32x4*)(rp + bj * HALF) = w; } }
        }
    }
};
}

struct Args { const float* in[20]; float* out; unsigned char* ws; int ph_lo, ph_hi; int use_sync, pad; };

typedef const __attribute__((address_space(4))) Args* ArgsP;
struct Ctx { int tid, lane, wave, gw, NGW, G, bid; LAS unsigned char* lds; unsigned char* ws; };

__device__ __forceinline__ void transpose_item(const float* __restrict__ W, int ldw, int src_col0, bf16_t* WT, int K, int dst_row0, int k0, LAS float* scr, int lane) {
    float tmp[32];
#pragma unroll
    for (int i = 0; i < 32; ++i) tmp[i] = __builtin_nontemporal_load(W + (size_t)(k0 + 2 * i + (lane >> 5)) * ldw + src_col0 + (lane & 31));
#pragma unroll
    for (int i = 0; i < 32; ++i) scr[(2 * i + (lane >> 5)) * 33 + (lane & 31)] = tmp[i];
    LDS_WAIT();
    const int c = lane & 7;
#pragma unroll
    for (int j = 0; j < 4; ++j) { const int n = (lane >> 3) + 8 * j; const LAS float* s = scr + (8 * c) * 33 + n;
        u32x4 o; o.x = pk_bf16(s[0 * 33], s[1 * 33]); o.y = pk_bf16(s[2 * 33], s[3 * 33]); o.z = pk_bf16(s[4 * 33], s[5 * 33]); o.w = pk_bf16(s[6 * 33], s[7 * 33]);
        *(u32x4*)(WT + (size_t)(dst_row0 + n) * K + k0 + 8 * c) = o; }
    LDS_WAIT();
}
__device__ __forceinline__ int win_src_col(int gidx) {
    const int pn = gidx >> 3, w = gidx & 7;
    if (pn < 6) { const int g = pn / 3, tg = pn % 3, half = w >> 2, u = w & 3; return (g ? W_DK : W_DQ) + (tg * 4 + u) * 64 + half * 32; }
    if (pn < 12) { const int pp = pn - 6, g = pp / 3, tg = pp % 3, half = w >> 2, ww = w & 3; return (g ? W_MK : W_MQ) + (tg * 2 + (ww >> 1)) * 128 + half * 64 + (ww & 1) * 32; }
    if (pn == 12) return W_GQ + 32 * w;
    if (pn == 13) return W_GK + 32 * w;
    return W_GR + (pn - 14) * 256 + 32 * w;
}
constexpr int I_GU = 32 * 352, I_D = 88 * 64, I_IN = 32 * 128, I_SQ = 32 * 64, I_PE = 4 * 64;
constexpr int PER_LAYER = 2 * I_GU + 2 * I_D + I_IN + 3 * I_SQ + I_PE;
__device__ __forceinline__ int tail_cnt(int k) { return k == 0 ? 14336 : k == 1 ? 8192 : k == 2 ? 15360 : 2048; }
__device__ __forceinline__ int tail_item(int k, int i) {
    return k == 0 ? i : k == 1 ? 22528 + i : k == 2 ? (i < 8192 ? 14336 + i : 30720 + (i - 8192)) : 41984 + i; }
constexpr int DEFER_LO = 37888, DEFER_PG0 = 41984, DEFER_PG1 = 44032;
__device__ __forceinline__ void convert_item(ArgsP a, const Ctx& c, int it, LAS float* scr) {
    {
        const int l = it / PER_LAYER; int r = it - l * PER_LAYER;
        unsigned char* wl = c.ws + WS_W + (size_t)l * WL_SIZE;
        if (r < 2 * I_GU) {
            const int second = r >= I_GU; if (second) r -= I_GU;
            const int kb = r / 352, gidx = r % 352, pn = gidx >> 3, w = gidx & 7;
            const float* src = a->in[(second ? 13 : 10) + (w >> 2)] + (size_t)l * DM * FF;
            transpose_item(src, FF, 128 * pn + 32 * (w & 3), (bf16_t*)(wl + (second ? WL_GU2 : WL_GU1)), DM, 32 * gidx, 64 * kb, scr, c.lane); return; }
        r -= 2 * I_GU;
        if (r < 2 * I_D) { const int second = r >= I_D; if (second) r -= I_D; const int kb = r / 64, nb = r % 64;
            transpose_item(a->in[second ? 15 : 12] + (size_t)l * FF * DM, DM, 32 * nb, (bf16_t*)(wl + (second ? WL_D2 : WL_D1)), FF, 32 * nb, 64 * kb, scr, c.lane); return; }
        r -= 2 * I_D;
        if (r < I_IN) { const int kb = r / 128, gidx = r % 128;
            transpose_item(a->in[3] + (size_t)l * DM * DIN, DIN, win_src_col(gidx), (bf16_t*)(wl + WL_IN), DM, 32 * gidx, 64 * kb, scr, c.lane); return; }
        r -= I_IN;
        if (r < I_SQ) { const int kb = r / 64, nb = r % 64, row0 = 32 * nb; const int sc = row0 < 768 ? W_DV + row0 : (row0 < 1280 ? W_GV + (row0 - 768) : W_MV + (row0 - 1280));
            transpose_item(a->in[3] + (size_t)l * DM * DIN, DIN, sc, (bf16_t*)(wl + WL_V), DM, row0, 64 * kb, scr, c.lane); return; }
        r -= I_SQ;
        if (r < I_SQ) { const int kb = r / 64, nb = r % 64; transpose_item(a->in[4] + (size_t)l * DM * DM, DM, 32 * nb, (bf16_t*)(wl + WL_OUT), DM, 32 * nb, 64 * kb, scr, c.lane); return; }
        r -= I_SQ;
        if (r < I_SQ) { const int kb = r / 64, nb = r % 64; transpose_item(a->in[17] + (size_t)l * DM * DM, DM, 32 * nb, (bf16_t*)(wl + WL_PG), DM, 32 * nb, 64 * kb, scr, c.lane); return; }
        r -= I_SQ;
        { const int kb = r / 64, nb = r % 64; transpose_item(a->in[16] + (size_t)l * PLE * DM, DM, 32 * nb, (bf16_t*)(wl + WL_PE), PLE, 32 * nb, 64 * kb, scr, c.lane); }
    }
}
__device__ __forceinline__ void prologue(ArgsP a, const Ctx& c) {
    LAS float* scr = (LAS float*)(c.lds + c.wave * 16384);
    constexpr int N_MID = DEFER_PG0 - DEFER_LO, N_PRO = PER_LAYER + N_MID + (PER_LAYER - DEFER_PG1);
    for (int j = c.gw; j < N_PRO; j += c.NGW) {
        const int it = j < PER_LAYER ? j : (j < PER_LAYER + N_MID ? PER_LAYER + DEFER_LO + (j - PER_LAYER) : PER_LAYER + DEFER_PG1 + (j - PER_LAYER - N_MID));
        convert_item(a, c, it, scr);
    }
    { float* idb = (float*)(c.ws + WS_GG + 640 * 1024); const int gt = c.gw * 64 + c.lane, NT = c.NGW * 64;
      for (int i = gt; i < 2 * MTOK + 2 * DM; i += NT) idb[i] = (i < 2 * MTOK) ? (float)(i & 1) : (i < 2 * MTOK + DM ? 1.f : 0.f); }
    { const float* x = a->in[0]; bf16_t* xb = (bf16_t*)(c.ws + WS_XB);
      for (int m = c.gw; m < MTOK; m += c.NGW) { const f32x4* xr = (const f32x4*)(x + (size_t)m * DM) + c.lane; u32x2* o = (u32x2*)(xb + (size_t)m * DM) + c.lane;
#pragma unroll
          for (int j = 0; j < 8; ++j) { const f32x4 v = xr[64 * j]; u32x2 w; w.x = pk_bf16(v.x, v.y); w.y = pk_bf16(v.z, v.w); o[64 * j] = w; } } }
    { const float* p = a->in[1]; bf16_t* pb = (bf16_t*)(c.ws + WS_PB);
      for (int m = c.gw; m < 2 * MTOK; m += c.NGW) { const f32x4 v = *((const f32x4*)(p + (size_t)m * PLE) + c.lane); u32x2 w; w.x = pk_bf16(v.x, v.y); w.y = pk_bf16(v.z, v.w); *((u32x2*)(pb + (size_t)m * PLE) + c.lane) = w; } }
    { const int* pos = (const int*)a->in[2]; float* r128 = (float*)(c.ws + WS_R128); float* r64 = (float*)(c.ws + WS_R64);
      const int gt = c.gw * 64 + c.lane, NT = c.NGW * 64;
      for (int idx = gt; idx < MTOK * 64; idx += NT) { const int m = idx >> 6, f = idx & 63;
          const float inv = exp2f(-(float)f * (13.287712379549449f / 64.f));
          const float ang = (float)pos[m] * inv;
          const double rev = (double)ang * 0.15915494309189535; const float fr = (float)(rev - rint(rev));
          const float cv = __builtin_amdgcn_cosf(fr), sv = __builtin_amdgcn_sinf(fr);
          r128[2 * idx] = cv; r128[2 * idx + 1] = sv;
          if ((f & 1) == 0) { const int i2 = m * 32 + (f >> 1); r64[2 * i2] = cv; r64[2 * i2 + 1] = sv; } } }
    { const int gt = c.gw * 64 + c.lane, NT = c.NGW * 64;
      for (int idx = gt; idx < 2 * 16 * DM; idx += NT) { const int l = idx / (16 * DM), rr = (idx / DM) & 15, k = idx % DM;
          ((bf16_t*)(c.ws + WS_W + (size_t)l * WL_SIZE + WL_GG))[rr * DM + k] = (bf16_t)(pk_bf16(a->in[3][(size_t)l * DM * DIN + (size_t)k * DIN + W_GG + rr], 0.f) & 0xffffu); } }
}

__device__ __forceinline__ void ln_phase(const Ctx& c, const float* z, float* xo, bf16_t* xbo, float* stats, const float* g, const float* b) {
    for (int m = c.gw; m < MTOK; m += 2 * c.NGW) {
        const int m1 = m + c.NGW; const bool two = m1 < MTOK;
        const f32x4* zr0 = (const f32x4*)(z + (size_t)m * DM) + c.lane; const f32x4* zr1 = (const f32x4*)(z + (size_t)(two ? m1 : m) * DM) + c.lane;
        f32x4 v0[8], v1[8]; float s0 = 0.f, s1 = 0.f;
#pragma unroll
        for (int j = 0; j < 8; ++j) { v0[j] = __builtin_nontemporal_load(zr0 + 64 * j); v1[j] = __builtin_nontemporal_load(zr1 + 64 * j); }
#pragma unroll
        for (int j = 0; j < 8; ++j) { s0 += (v0[j].x + v0[j].y) + (v0[j].z + v0[j].w); s1 += (v1[j].x + v1[j].y) + (v1[j].z + v1[j].w); }
        const float mean0 = wave_sum(s0) * (1.f / DM), mean1 = wave_sum(s1) * (1.f / DM); float q0 = 0.f, q1 = 0.f;
#pragma unroll
        for (int j = 0; j < 8; ++j) { v0[j] = v0[j] - mean0; v1[j] = v1[j] - mean1;
            q0 += (v0[j].x * v0[j].x + v0[j].y * v0[j].y) + (v0[j].z * v0[j].z + v0[j].w * v0[j].w); q1 += (v1[j].x * v1[j].x + v1[j].y * v1[j].y) + (v1[j].z * v1[j].z + v1[j].w * v1[j].w); }
        const float rstd0 = 1.f / sqrtf(wave_sum(q0) * (1.f / DM) + LN_EPS), rstd1 = 1.f / sqrtf(wave_sum(q1) * (1.f / DM) + LN_EPS);
        if (c.lane == 0) { f32x2 st = {mean0, rstd0}; *(f32x2*)(stats + 2 * m) = st; if (two) { f32x2 st1 = {mean1, rstd1}; *(f32x2*)(stats + 2 * m1) = st1; } }
#pragma unroll
        for (int j = 0; j < 8; ++j) { const f32x4 gv = ((const f32x4*)g)[c.lane + 64 * j], bv = ((const f32x4*)b)[c.lane + 64 * j];
            const f32x4 o0 = v0[j] * rstd0 * gv + bv, o1 = v1[j] * rstd1 * gv + bv;
            if (xo) { ((f32x4*)(xo + (size_t)m * DM) + c.lane)[64 * j] = o0; if (two) ((f32x4*)(xo + (size_t)m1 * DM) + c.lane)[64 * j] = o1; }
            if (xbo) { u32x2 w; w.x = pk_bf16(o0.x, o0.y); w.y = pk_bf16(o0.z, o0.w); ((u32x2*)(xbo + (size_t)m * DM) + c.lane)[64 * j] = w;
                if (two) { u32x2 w1; w1.x = pk_bf16(o1.x, o1.y); w1.y = pk_bf16(o1.z, o1.w); ((u32x2*)(xbo + (size_t)m1 * DM) + c.lane)[64 * j] = w1; } } }
    }
}

__device__ __forceinline__ void gg_phase(const Ctx& c, const bf16_t* xb, const bf16_t* wgg, float* gg) {
    const int row = c.lane & 15, quad = c.lane >> 4;
    for (int t = c.wave * c.G + c.bid; t < MTOK / 16; t += c.NGW) {
        f32x4 acc = {0.f, 0.f, 0.f, 0.f};
        const bf16_t* ap = xb + (size_t)(t * 16 + row) * DM + quad * 8; const bf16_t* bp = wgg + (size_t)row * DM + quad * 8;
#pragma unroll 16
        for (int k0 = 0; k0 < DM; k0 += 32) { const bf16x8 av = *(const bf16x8*)(ap + k0), bv = *(const bf16x8*)(bp + k0); acc = __builtin_amdgcn_mfma_f32_16x16x32_bf16(av, bv, acc, 0, 0, 0); }
#pragma unroll
        for (int j = 0; j < 4; ++j) gg[(size_t)(t * 16 + quad * 4 + j) * 16 + row] = acc[j];
    }
}

__device__ __forceinline__ int perm23(int t) { return (t & ~12) | ((t & 4) << 1) | ((t & 8) >> 1); }
__device__ __forceinline__ void post_phase(const Ctx& c, ArgsP a, int l) {
    const bf16_t* proj = (const bf16_t*)(c.ws + WS_PROJ); const float* gg = (const float*)(c.ws + WS_GG);
    bf16_t* QT = (bf16_t*)(c.ws + WS_QT); bf16_t* KT = (bf16_t*)(c.ws + WS_KT); bf16_t* KTT = (bf16_t*)(c.ws + WS_KTT);
    float* EL = (float*)(c.ws + WS_EL); bf16_t* KM = (bf16_t*)(c.ws + WS_KM);
    const float* gate_up = a->in[7] + (size_t)l * 16 * 256; const float* gate_b = a->in[8] + (size_t)l * 256;
    for (int task = c.gw; task < 512 + 192; task += c.NGW) {
        if (task < 512) {
            const int bh = task >> 5, ch = task & 31, b = bh >> 2, hh = bh & 3, k = c.lane;
            float up[16];
#pragma unroll
            for (int r = 0; r < 16; ++r) up[r] = gate_up[r * 256 + hh * 64 + k];
            const float bias = gate_b[hh * 64 + k];
            float cum = 0.f;
            const int tok0 = b * SEQ + ch * 64; const size_t rb = (size_t)bh * SEQ + ch * 64;
            for (int t8 = 0; t8 < 8; ++t8) {
                unsigned kk[8];
#pragma unroll
                for (int tt = 0; tt < 8; ++tt) { const int t = t8 * 8 + tt; const int tok = tok0 + t;
                    const f32x4* gp = (const f32x4*)(gg + (size_t)tok * 16);
                    float pre = bias;
#pragma unroll
                    for (int q = 0; q < 4; ++q) { const f32x4 gv = gp[q]; pre += gv.x * up[4 * q] + gv.y * up[4 * q + 1] + gv.z * up[4 * q + 2] + gv.w * up[4 * q + 3]; }
                    const float ls = -0.6931471805599453f * __builtin_amdgcn_logf(1.f + fexp2(-pre * LOG2E));
                    cum += ls * (1.f / 16.f);
                    const float qv = bf2f(proj[(size_t)tok * PROJP + C_GQ + hh * 64 + k]), kv = bf2f(proj[(size_t)tok * PROJP + C_GK + hh * 64 + k]);
                    const float ec = fexp2(cum * LOG2E); const float qt = qv * ec * 0.125f, kt = kv * __builtin_amdgcn_rcpf(ec);
                    const bf16_t qb = (bf16_t)(pk_bf16(qt, 0.f) & 0xffffu), kb = (bf16_t)(pk_bf16(kt, 0.f) & 0xffffu);
                    QT[(rb + t) * 64 + k] = qb; KT[(rb + t) * 64 + k] = kb; kk[tt] = kb; }
                bf16_t* dst = KTT + ((size_t)(bh * 32 + ch) * 64 + k) * 64 + (t8 >> 2) * 32;
                const int t8l = t8 & 3;
                u32x2 w0, w1; w0.x = kk[0] | (kk[1] << 16); w0.y = kk[2] | (kk[3] << 16); w1.x = kk[4] | (kk[5] << 16); w1.y = kk[6] | (kk[7] << 16);
                *(u32x2*)(dst + (t8l >> 1) * 16 + 0 * 8 + (t8l & 1) * 4) = w0;
                *(u32x2*)(dst + (t8l >> 1) * 16 + 1 * 8 + (t8l & 1) * 4) = w1;
            }
            EL[(size_t)(bh * 32 + ch) * 64 + k] = fexp2(cum * LOG2E);
            asm volatile("s_waitcnt vmcnt(0)" ::: "memory");
            {
                const int r = c.lane & 31, h = c.lane >> 5;
                const bf16_t* QTb = QT + rb * 64; const bf16_t* KTb = KT + rb * 64; const bf16_t* KTTb = KTT + (size_t)(bh * 32 + ch) * 4096;
                f32x16 x00, x01, x11;
#pragma unroll
                for (int i = 0; i < 16; ++i) { x00[i] = 0.f; x01[i] = 0.f; x11[i] = 0.f; }
#pragma unroll
                for (int ks = 0; ks < 4; ++ks) {
                    const bf16x8 k0 = *(const bf16x8*)(KTb + (size_t)r * 64 + 16 * ks + 8 * h), k1 = *(const bf16x8*)(KTb + (size_t)(32 + r) * 64 + 16 * ks + 8 * h);
                    const bf16x8 q0 = *(const bf16x8*)(QTb + (size_t)r * 64 + 16 * ks + 8 * h), q1 = *(const bf16x8*)(QTb + (size_t)(32 + r) * 64 + 16 * ks + 8 * h);
                    x00 = MFMA32(k0, q0, x00); x01 = MFMA32(k0, q1, x01); x11 = MFMA32(k1, q1, x11);
                }
#pragma unroll
                for (int i = 0; i < 16; ++i) if (crow(i, h) > r) { x00[i] = 0.f; x11[i] = 0.f; }
                const bf16x8 p00a = pack8(x00, 0), p00b = pack8(x00, 1), p01a = pack8(x01, 0), p01b = pack8(x01, 1), p11a = pack8(x11, 0), p11b = pack8(x11, 1);
                bf16x8 ka0[4], ka1[4];
#pragma unroll
                for (int ts = 0; ts < 4; ++ts) { ka0[ts] = *(const bf16x8*)(KTTb + (size_t)r * 64 + 16 * ts + 8 * h); ka1[ts] = *(const bf16x8*)(KTTb + (size_t)(32 + r) * 64 + 16 * ts + 8 * h); }
                float* OI = (float*)(c.ws + WS_OI) + (rb) * 128; float* DST = (float*)(c.ws + WS_DST) + (size_t)(bh * 32 + ch) * 8192;
                const bf16_t* VTb = (const bf16_t*)(c.ws + WS_VT) + vf_block(b, 6 + hh, ch * 2) + c.lane * 8;
                for (int sl = 0; sl < 4; ++sl) {
                    bf16x8 vb[4];
#pragma unroll
                    for (int ts = 0; ts < 4; ++ts) vb[ts] = *(const bf16x8*)(VTb + (size_t)(ts >> 1) * 4096 + (sl * 2 + (ts & 1)) * 512);
                    f32x16 o0, o1, d0, d1;
#pragma unroll
                    for (int i = 0; i < 16; ++i) { o0[i] = 0.f; o1[i] = 0.f; d0[i] = 0.f; d1[i] = 0.f; }
                    o0 = MFMA32(vb[0], p00a, o0); o0 = MFMA32(vb[1], p00b, o0);
                    o1 = MFMA32(vb[0], p01a, o1); o1 = MFMA32(vb[1], p01b, o1); o1 = MFMA32(vb[2], p11a, o1); o1 = MFMA32(vb[3], p11b, o1);
#pragma unroll
                    for (int ts = 0; ts < 4; ++ts) { d0 = MFMA32(vb[ts], ka0[ts], d0); d1 = MFMA32(vb[ts], ka1[ts], d1); }
#pragma unroll
                    for (int q = 0; q < 4; ++q) { f32x4 v0, v1; v0.x = o0[4 * q]; v0.y = o0[4 * q + 1]; v0.z = o0[4 * q + 2]; v0.w = o0[4 * q + 3]; v1.x = o1[4 * q]; v1.y = o1[4 * q + 1]; v1.z = o1[4 * q + 2]; v1.w = o1[4 * q + 3];
                        *(f32x4*)(OI + (size_t)r * 128 + 32 * sl + 8 * q + 4 * h) = v0; *(f32x4*)(OI + (size_t)(32 + r) * 128 + 32 * sl + 8 * q + 4 * h) = v1; }
#pragma unroll
                    for (int i = 0; i < 16; ++i) { DST[(size_t)(32 * sl + crow(i, h)) * 64 + r] = d0[i]; DST[(size_t)(32 * sl + crow(i, h)) * 64 + 32 + r] = d1[i]; }
                }
            }
        } else {
            const int t2 = task - 512, b = t2 / 48, hd = (t2 / 8) % 6, blk = t2 & 7;
            const bf16_t* kp = proj + (size_t)(b * SEQ + blk * 256) * PROJP + C_MK + hd * 128 + 2 * c.lane;
            float s0 = 0.f, s1 = 0.f;
#pragma unroll 8
            for (int t = 0; t < 256; ++t) { const unsigned w = *(const unsigned*)(kp + (size_t)t * PROJP); s0 += bflo(w); s1 += bfhi(w); }
            *(unsigned*)(KM + (size_t)((b * 6 + hd) * 8 + blk) * 128 + 2 * c.lane) = pk_bf16(s0 * (1.f / 256.f), s1 * (1.f / 256.f));
        }
    }
}

template <int OFF> __device__ __forceinline__ void gld16(bf16x8& dst, const bf16_t* p) { asm volatile("global_load_dwordx4 %0, %1, off offset:%2" : "+v"(dst) : "v"(p), "n"(OFF) : "memory"); }
template <int NKS> __device__ __forceinline__ void issue_k(bf16x8 (&kf)[NKS], const bf16_t* kp) {
    gld16<0>(kf[0], kp); gld16<1024>(kf[1], kp); gld16<2048>(kf[2], kp); gld16<3072>(kf[3], kp);
    if constexpr (NKS == 8) { const bf16_t* k2 = kp + 2048; gld16<0>(kf[4], k2); gld16<1024>(kf[5], k2); gld16<2048>(kf[6], k2); gld16<3072>(kf[7], k2); }
}
__device__ __forceinline__ void issue_v(bf16x8 (&vf)[8], const bf16_t* vp) {
    const bf16_t* v2 = vp + 2048;
    gld16<0>(vf[0], vp); gld16<1024>(vf[1], vp); gld16<2048>(vf[2], vp); gld16<3072>(vf[3], vp); gld16<0>(vf[4], v2); gld16<1024>(vf[5], v2); gld16<2048>(vf[6], v2); gld16<3072>(vf[7], v2);
}
template <int NKS, int CNT> __device__ __forceinline__ void wait_k(bf16x8 (&kf)[NKS]) {
    if constexpr (NKS == 4) asm volatile("s_waitcnt vmcnt(%4)" : "+v"(kf[0]), "+v"(kf[1]), "+v"(kf[2]), "+v"(kf[3]) : "n"(CNT) : "memory");
    else asm volatile("s_waitcnt vmcnt(%8)" : "+v"(kf[0]), "+v"(kf[1]), "+v"(kf[2]), "+v"(kf[3]), "+v"(kf[4]), "+v"(kf[5]), "+v"(kf[6]), "+v"(kf[7]) : "n"(CNT) : "memory");
}
template <int CNT> __device__ __forceinline__ void wait_v(bf16x8 (&vf)[8]) {
    asm volatile("s_waitcnt vmcnt(%8)" : "+v"(vf[0]), "+v"(vf[1]), "+v"(vf[2]), "+v"(vf[3]), "+v"(vf[4]), "+v"(vf[5]), "+v"(vf[6]), "+v"(vf[7]) : "n"(CNT) : "memory");
}
template <int DQ, bool QLDS, int KD  >
__device__ __forceinline__ void attn_pass(const bf16_t* qrow  , const bf16_t* kbase  , const bf16_t* vbase  ,
                                          int qt, int own, unsigned selmask, int r, int h, f32x16 (&O)[4], LAS unsigned char* wlds  ) {
    constexpr int NKS = DQ / 16;
    bf16x8 qf[QLDS ? 1 : NKS];
    if constexpr (QLDS) {
#pragma unroll
        for (int ks = 0; ks < NKS; ++ks) *(LAS bf16x8*)(wlds + ks * 1024) = *(const bf16x8*)(qrow + 16 * ks);
    } else {
#pragma unroll
        for (int ks = 0; ks < NKS; ++ks) qf[ks] = *(const bf16x8*)(qrow + 16 * ks);
    }
#pragma unroll
    for (int t = 0; t < 4; ++t)
#pragma unroll
        for (int i = 0; i < 16; ++i) O[t][i] = 0.f;
    unsigned bmask = 0u;
    for (int n = 0; n < own; ++n) if (__ballot((selmask >> n) & 1u) != 0ull) bmask |= 1u << n;
    bmask |= 0xffffff00u | (0xffu & ~((1u << own) - 1u));
    bmask = (unsigned)__builtin_amdgcn_readfirstlane((int)bmask);
    float m = NEG_BIG, l = 0.f;
    int kt = 8 * __builtin_ctz(bmask);
    bf16x8 kfa[NKS], kfb[KD == 2 ? NKS : 1], vfa[8], vfb[8];
#pragma unroll
    for (int i = 0; i < NKS; ++i) { kfa[i] = (bf16x8){0, 0, 0, 0, 0, 0, 0, 0}; if constexpr (KD == 2) kfb[i] = (bf16x8){0, 0, 0, 0, 0, 0, 0, 0}; }
#pragma unroll
    for (int i = 0; i < 8; ++i) { vfa[i] = (bf16x8){0, 0, 0, 0, 0, 0, 0, 0}; vfb[i] = (bf16x8){0, 0, 0, 0, 0, 0, 0, 0}; }
    if constexpr (!QLDS) {
#pragma unroll
        for (int ks = 0; ks < NKS; ++ks) asm volatile("" : "+v"(qf[ks]));
    }
#define ATTN_NEXT(k) (((((k) + 1) & 7) == 0) ? ((k) + 1 + 8 * __builtin_ctz(bmask >> (((k) + 1) >> 3))) : ((k) + 1))
#define ATTN_CLAMP(k) ((k) <= qt ? (k) : qt)
    int k1 = ATTN_NEXT(kt);
    asm volatile("s_waitcnt vmcnt(0)" ::: "memory");
    if constexpr (KD == 2) {
        issue_k<NKS>(kfa, kbase + (size_t)kt * (NKS * 512));            issue_v(vfa, vbase + (size_t)kt * 4096);
        issue_k<NKS>(kfb, kbase + (size_t)ATTN_CLAMP(k1) * (NKS * 512)); issue_v(vfb, vbase + (size_t)ATTN_CLAMP(k1) * 4096);
    } else {
        issue_v(vfa, vbase + (size_t)kt * 4096); issue_k<NKS>(kfa, kbase + (size_t)kt * (NKS * 512)); issue_v(vfb, vbase + (size_t)ATTN_CLAMP(k1) * 4096);
    }
#define ATTN_TILE(KC, VC, TIDX, TNEXT1, TNEXT2) { \
        const int tcur = (TIDX); const bool live = tcur <= qt; const int n = tcur >> 3; \
        const bool vis = live && ((n >= own) || ((selmask >> n) & 1u)); \
        f32x16 s; \
        _Pragma("unroll") for (int i = 0; i < 16; ++i) s[i] = 0.f; \
        wait_k<NKS, KD == 2 ? 16 + NKS : 8>(KC); \
        if constexpr (QLDS) { \
            LAS unsigned char* ql = wlds; asm volatile("" : "+v"(ql)); \
            _Pragma("unroll") for (int ks = 0; ks < NKS; ++ks) { const bf16x8 qq = *(const LAS bf16x8*)(ql + ks * 1024); s = MFMA32(KC[ks], qq, s); } \
        } else { \
            _Pragma("unroll") for (int ks = 0; ks < NKS; ++ks) s = MFMA32(KC[ks], qf[ks], s); \
        } \
        if (tcur == qt) { _Pragma("unroll") for (int i = 0; i < 16; ++i) if (crow(i, h) > r) s[i] = NEG_BIG; } \
        if (!vis) { _Pragma("unroll") for (int i = 0; i < 16; ++i) s[i] = NEG_BIG; } \
        float mx = fmaxf(fmaxf(fmaxf(s[0], s[1]), fmaxf(s[2], s[3])), fmaxf(fmaxf(s[4], s[5]), fmaxf(s[6], s[7]))); \
        mx = fmaxf(mx, fmaxf(fmaxf(fmaxf(s[8], s[9]), fmaxf(s[10], s[11])), fmaxf(fmaxf(s[12], s[13]), fmaxf(s[14], s[15])))); \
        if (__ballot(mx > m + 8.f) != 0ull) { \
            mx = fmaxf(mx, __shfl_xor(mx, 32)); \
            const float mn = fmaxf(m, mx), alpha = fexp2(m - mn); m = mn; l *= alpha; \
            _Pragma("unroll") for (int t = 0; t < 4; ++t) O[t] = O[t] * alpha; \
        } \
        issue_k<NKS>(KC, kbase + (size_t)ATTN_CLAMP(KD == 2 ? (TNEXT2) : (TNEXT1)) * (NKS * 512)); \
        _Pragma("unroll") for (int i = 0; i < 16; ++i) s[i] = live ? fexp2(s[i] - m) : 0.f; \
        l += ((s[0] + s[1]) + (s[2] + s[3])) + ((s[4] + s[5]) + (s[6] + s[7])) + ((s[8] + s[9]) + (s[10] + s[11])) + ((s[12] + s[13]) + (s[14] + s[15])); \
        const bf16x8 p0 = pack8(s, 0), p1 = pack8(s, 1); \
        wait_v<KD == 2 ? 8 + 2 * NKS : 8 + NKS>(VC); \
        _Pragma("unroll") for (int t = 0; t < 4; ++t) { O[t] = MFMA32(VC[2 * t], p0, O[t]); O[t] = MFMA32(VC[2 * t + 1], p1, O[t]); } \
        asm volatile("" : "+v"(O[0]), "+v"(O[1]), "+v"(O[2]), "+v"(O[3])); \
        issue_v(VC, vbase + (size_t)ATTN_CLAMP(TNEXT2) * 4096); }
    while (kt <= qt) {
        const int k2 = ATTN_NEXT(k1), k3 = ATTN_NEXT(k2);
        if constexpr (KD == 2) { ATTN_TILE(kfa, vfa, kt, k1, k2) ATTN_TILE(kfb, vfb, k1, k2, k3) }
        else { ATTN_TILE(kfa, vfa, kt, k1, k2) ATTN_TILE(kfa, vfb, k1, k2, k3) }
        kt = k2; k1 = k3;
    }
#undef ATTN_TILE
#undef ATTN_NEXT
#undef ATTN_CLAMP
    asm volatile("s_waitcnt vmcnt(0)" : "+v"(kfa[0]), "+v"(vfa[0]), "+v"(vfb[0]) :: "memory");
    l += __shfl_xor(l, 32);
    const float inv = 1.f / l;
#pragma unroll
    for (int t = 0; t < 4; ++t) O[t] = O[t] * inv;
}

__device__ __forceinline__ void store_o(bf16_t* orow  , const f32x16 (&O)[4]) {
#pragma unroll
    for (int t = 0; t < 4; ++t)
#pragma unroll
        for (int q = 0; q < 4; ++q) { u32x2 w; w.x = pk_bf16(O[t][4 * q], O[t][4 * q + 1]); w.y = pk_bf16(O[t][4 * q + 2], O[t][4 * q + 3]); *(u32x2*)(orow + 32 * t + 8 * q) = w; }
}

__device__ __forceinline__ void diff_task(const Ctx& c, ArgsP a, int l, int bh, int qt) {
    const int b = bh / 6, hd = bh % 6, r = c.lane & 31, h = c.lane >> 5;
    const bf16_t* proj = (const bf16_t*)(c.ws + WS_PROJ); const bf16_t* VT = (const bf16_t*)(c.ws + WS_VT); bf16_t* mix = (bf16_t*)(c.ws + WS_MIX);
    const float* lf = a->in[5] + (size_t)l * 256;
    const float d1 = wave_sum(lf[c.lane] * lf[64 + c.lane]), d2 = wave_sum(lf[128 + c.lane] * lf[192 + c.lane]);
    const float lam_init = 0.8f - 0.6f * expf(-0.3f * (float)l);
    const float lam = expf(d1) - expf(d2) + lam_init;
    const size_t tokq = (size_t)b * SEQ + qt * 32 + r;
    const bf16_t* kb = (const bf16_t*)(c.ws + WS_KFD) + kfd_block(b, hd * 2, 0) + c.lane * 8;
    const bf16_t* vb = VT + vf_block(b, hd, 0) + c.lane * 8;
    f32x16 O1[4];
    LAS unsigned char* wl = c.lds + c.wave * 16384 + c.lane * 16;
    {
        f32x16 O2[4];
        attn_pass<64, true, 2>(proj + tokq * PROJP + C_DQ + hd * 128 + 64 + 8 * h, kb + (size_t)64 * 2048, vb, qt, 0, 0u, r, h, O2, wl);
#pragma unroll
        for (int t = 0; t < 4; ++t)
#pragma unroll
            for (int hf = 0; hf < 2; ++hf) { u32x4 w; w.x = pk_bf16(O2[t][8 * hf], O2[t][8 * hf + 1]); w.y = pk_bf16(O2[t][8 * hf + 2], O2[t][8 * hf + 3]); w.z = pk_bf16(O2[t][8 * hf + 4], O2[t][8 * hf + 5]); w.w = pk_bf16(O2[t][8 * hf + 6], O2[t][8 * hf + 7]);
                *(LAS u32x4*)(wl + 8192 + (t * 2 + hf) * 1024) = w; }
    }
    attn_pass<64, true, 2>(proj + tokq * PROJP + C_DQ + hd * 128 + 8 * h, kb, vb, qt, 0, 0u, r, h, O1, wl);
    float ss = 0.f;
#pragma unroll
    for (int t = 0; t < 4; ++t)
#pragma unroll
        for (int hf = 0; hf < 2; ++hf) { const u32x4 w = *(const LAS u32x4*)(wl + 8192 + (t * 2 + hf) * 1024);
            const float o2[8] = {bflo(w.x), bfhi(w.x), bflo(w.y), bfhi(w.y), bflo(w.z), bfhi(w.z), bflo(w.w), bfhi(w.w)};
#pragma unroll
            for (int e = 0; e < 8; ++e) { const float v = O1[t][8 * hf + e] - lam * o2[e]; O1[t][8 * hf + e] = v; ss += v * v; } }
    ss += __shfl_xor(ss, 32);
    const float rs = (1.f - lam_init) / sqrtf(ss * (1.f / 128.f) + LN_EPS);
    const float* gn = a->in[6] + (size_t)l * 128 + 4 * h;
#pragma unroll
    for (int t = 0; t < 4; ++t)
#pragma unroll
        for (int q = 0; q < 4; ++q) { const f32x4 gv = *(const f32x4*)(gn + 32 * t + 8 * q);
            O1[t][4 * q] *= rs * gv.x; O1[t][4 * q + 1] *= rs * gv.y; O1[t][4 * q + 2] *= rs * gv.z; O1[t][4 * q + 3] *= rs * gv.w; }
    store_o(mix + tokq * DM + hd * 128 + 4 * h, O1);
}

__device__ __forceinline__ void moba_task(const Ctx& c, int bh, int qt) {
    const int b = bh / 6, hd = bh % 6, r = c.lane & 31, h = c.lane >> 5;
    const bf16_t* proj = (const bf16_t*)(c.ws + WS_PROJ); const bf16_t* VT = (const bf16_t*)(c.ws + WS_VT); bf16_t* mix = (bf16_t*)(c.ws + WS_MIX);
    const bf16_t* KM = (const bf16_t*)(c.ws + WS_KM) + (size_t)(b * 6 + hd) * 8 * 128;
    const size_t tokq = (size_t)b * SEQ + qt * 32 + r;
    const bf16_t* qrow = proj + tokq * PROJP + C_MQ + hd * 128 + 8 * h;
    const int own = qt >> 3;
    unsigned selmask = 0u;
    if (own > 3) {
        f32x16 g;
#pragma unroll
        for (int i = 0; i < 16; ++i) g[i] = 0.f;
#pragma unroll
        for (int ks = 0; ks < 8; ++ks) { bf16x8 kf = {0, 0, 0, 0, 0, 0, 0, 0}; if (r < 8) kf = *(const bf16x8*)(KM + r * 128 + 16 * ks + 8 * h);
            const bf16x8 qf = *(const bf16x8*)(qrow + 16 * ks); g = MFMA32(kf, qf, g); }
        float gate[8];
#pragma unroll
        for (int i = 0; i < 4; ++i) { const float mine = g[i], other = __shfl_xor(mine, 32); gate[i] = h ? other : mine; gate[4 + i] = h ? mine : other; }
#pragma unroll
        for (int n = 0; n < 8; ++n) { int rank = 0;
#pragma unroll
            for (int mm = 0; mm < 8; ++mm) { if (mm == n) continue; const bool ahead = (gate[mm] > gate[n]) || (gate[mm] == gate[n] && mm < n); rank += (mm < own && ahead) ? 1 : 0; }
            if (n < own && rank < 3) selmask |= 1u << n; }
    } else selmask = 0xffu;
    f32x16 O[4];
    attn_pass<128, true, 1>(qrow, (const bf16_t*)(c.ws + WS_KFM) + kfm_block(b, hd, 0) + c.lane * 8, VT + vf_block(b, 10 + hd, 0) + c.lane * 8, qt, own, selmask, r, h, O, c.lds + c.wave * 16384 + c.lane * 16);
    store_o(mix + tokq * DM + 1280 + hd * 128 + 4 * h, O);
}

__device__ __forceinline__ void gla_scan_phase(const Ctx& c) {
    const float* DST = (const float*)(c.ws + WS_DST); const float* EL = (const float*)(c.ws + WS_EL); bf16_t* SBT = (bf16_t*)(c.ws + WS_SBT);
    for (int idx = c.gw * 64 + c.lane; idx < 16 * 8192; idx += c.NGW * 64) {
        const int bh = idx >> 13, e = idx & 8191, k = e & 63;
        float S = 0.f;
#pragma unroll 8
        for (int ch = 0; ch < 32; ++ch) {
            const size_t o = (size_t)(bh * 32 + ch) * 8192 + e;
            SBT[o] = (bf16_t)(pk_bf16(S, 0.f) & 0xffffu);
            S = EL[(size_t)(bh * 32 + ch) * 64 + k] * (S + DST[o]);
        }
    }
}
__device__ __forceinline__ void gla_final_task(const Ctx& c, ArgsP a, int l, int bh, int ch) {
    const int r = c.lane & 31, h = c.lane >> 5, b = bh >> 2, hh = bh & 3;
    const bf16_t* QT = (const bf16_t*)(c.ws + WS_QT) + ((size_t)bh * SEQ + ch * 64) * 64;
    const bf16_t* SBT = (const bf16_t*)(c.ws + WS_SBT) + (size_t)(bh * 32 + ch) * 8192;
    const float* OI = (const float*)(c.ws + WS_OI) + ((size_t)bh * SEQ + ch * 64) * 128;
    const bf16_t* proj = (const bf16_t*)(c.ws + WS_PROJ); bf16_t* mix = (bf16_t*)(c.ws + WS_MIX);
    const float* gn = a->in[9] + (size_t)l * 128 + 4 * h;
    for (int it = 0; it < 2; ++it) {
        f32x16 acc[4];
        const float* oi = OI + (size_t)(32 * it + r) * 128 + 4 * h;
#pragma unroll
        for (int dt = 0; dt < 4; ++dt)
#pragma unroll
            for (int q = 0; q < 4; ++q) { const f32x4 v = *(const f32x4*)(oi + 32 * dt + 8 * q); acc[dt][4 * q] = v.x; acc[dt][4 * q + 1] = v.y; acc[dt][4 * q + 2] = v.z; acc[dt][4 * q + 3] = v.w; }
#pragma unroll
        for (int ks = 0; ks < 4; ++ks) {
            const bf16x8 qf = *(const bf16x8*)(QT + (size_t)(32 * it + r) * 64 + 16 * ks + 8 * h);
#pragma unroll
            for (int dt = 0; dt < 4; ++dt) { const bf16x8 sf = *(const bf16x8*)(SBT + (size_t)(32 * dt + r) * 64 + 16 * ks + 8 * h); acc[dt] = MFMA32(sf, qf, acc[dt]); }
        }
        float ss = 0.f;
#pragma unroll
        for (int dt = 0; dt < 4; ++dt)
#pragma unroll
            for (int i = 0; i < 16; ++i) ss += acc[dt][i] * acc[dt][i];
        ss += __shfl_xor(ss, 32);
        const float rs = 1.f / sqrtf(ss * (1.f / 128.f) + LN_EPS);
        const size_t tok = (size_t)b * SEQ + ch * 64 + 32 * it + r;
        const bf16_t* gp = proj + tok * PROJP + C_GR + hh * 128 + 4 * h; bf16_t* mp = mix + tok * DM + 768 + hh * 128 + 4 * h;
#pragma unroll
        for (int dt = 0; dt < 4; ++dt)
#pragma unroll
            for (int q = 0; q < 4; ++q) { const u32x2 gw = *(const u32x2*)(gp + 32 * dt + 8 * q); const f32x4 gv = *(const f32x4*)(gn + 32 * dt + 8 * q);
                const float g0 = bflo(gw.x), g1 = bfhi(gw.x), g2 = bflo(gw.y), g3 = bfhi(gw.y);
                const float o0 = acc[dt][4 * q] * rs * gv.x * (g0 * fsigmoid(g0)), o1 = acc[dt][4 * q + 1] * rs * gv.y * (g1 * fsigmoid(g1));
                const float o2 = acc[dt][4 * q + 2] * rs * gv.z * (g2 * fsigmoid(g2)), o3 = acc[dt][4 * q + 3] * rs * gv.w * (g3 * fsigmoid(g3));
                u32x2 w; w.x = pk_bf16(o0, o1); w.y = pk_bf16(o2, o3); *(u32x2*)(mp + 32 * dt + 8 * q) = w; }
    }
}

__device__ __forceinline__ void attn_phase(const Ctx& c, ArgsP a, int l, int ctr_slot) {
    unsigned* ctr0 = (unsigned*)(c.ws + WS_CTL) + 64 * ctr_slot;
    const int myq = (int)(__builtin_amdgcn_s_getreg((3 << 11) | 20) & 7u);
    for (int qi = 0; qi < 8; ++qi) {
        const int q = (myq + qi) & 7;
        unsigned* ctr = ctr0 + 64 * q;
        for (;;) {
            int t = 0;
            if (c.lane == 0) t = (int)atomicAdd(ctr, 1u);
            t = __builtin_amdgcn_readfirstlane(t);
            if (t >= 448) break;
            Ctx ct = c; { int ln = c.lane; asm volatile("" : "+v"(ln)); ct.lane = ln; }
            int ll = l; asm volatile("" : "+s"(ll));
            if (t >= 384) { const int f = (t - 384) * 8 + q; gla_final_task(ct, a, ll, f >> 5, f & 31); continue; }
            const int grp = t / 192, u = t % 192, qt = 63 - u / 3, j = grp * 3 + u % 3, hh48 = j * 8 + q;
            if (hh48 < 24) diff_task(ct, a, ll, hh48, qt); else moba_task(ct, hh48 - 24, qt);
        }
    }
}

#define XB_TMO      128
#define XB_XCNT(j)  (256  + 64 * (j))
#define XB_XSUB(j)  (1280 + 64 * (j))
#define XB_XGEN(j)  (2304 + 64 * (j))
#define XB_TOP      3328
#define XB_TOPGEN   3392
#define XB_SPIN_CAP (1u << 22)
__device__ __forceinline__ unsigned xb_ld(unsigned* p)              { return __hip_atomic_load(p, __ATOMIC_RELAXED, __HIP_MEMORY_SCOPE_AGENT); }
__device__ __forceinline__ unsigned xb_add(unsigned* p, unsigned v) { return __hip_atomic_fetch_add(p, v, __ATOMIC_RELAXED, __HIP_MEMORY_SCOPE_AGENT); }
__device__ __forceinline__ unsigned xb_xcc_id() { return (unsigned)__builtin_amdgcn_s_getreg((3 << 11) | 20) & 0xFu; }
#define XB_SPIN(cond, bar) do { unsigned _sp = 0; while (cond) { __builtin_amdgcn_s_sleep(1); \
    if ((++_sp & 255u) == 0u) { if (xb_ld(&(bar)[XB_TMO])) break; if (_sp > XB_SPIN_CAP) { atomicAdd(&(bar)[XB_TMO], 1u); break; } } } } while (0)
__device__ __forceinline__ void xcd_barrier_complete(unsigned* bar, unsigned x, unsigned G, unsigned& nloc, unsigned& nx) {
    unsigned sum, cnt, mine, sp = 0u;
    for (;;) {
        sum = 0u; cnt = 0u; mine = 0u;
#pragma unroll
        for (unsigned j = 0; j < 16; ++j) { const unsigned cc = xb_ld(&bar[XB_XCNT(j)]); sum += cc; cnt += (cc > 0u) ? 1u : 0u; mine = (j == x) ? cc : mine; }
        if (sum == G) break;
        __builtin_amdgcn_s_sleep(1);
        if ((++sp & 255u) == 0u) { if (xb_ld(&bar[XB_TMO])) break; if (sp > XB_SPIN_CAP) { atomicAdd(&bar[XB_TMO], 1u); break; } }
    }
    nloc = mine > 0u ? mine : 1u; nx = cnt > 0u ? cnt : 1u;
}
__device__ __forceinline__ void xcd_barrier(unsigned* bar, volatile LAS unsigned* st, unsigned G) {
    asm volatile("s_waitcnt vmcnt(0)" ::: "memory");
    __syncthreads();
    if (threadIdx.x == 0) {
        const unsigned x = xb_xcc_id();
        __builtin_amdgcn_s_waitcnt(0);
        unsigned nloc = st[0], nx = st[1];
        if (nloc == 0u) { xcd_barrier_complete(bar, x, G, nloc, nx); st[0] = nloc; st[1] = nx; }
        const unsigned old = xb_add(&bar[XB_XSUB(x)], 1u);
        const unsigned gen = old / nloc;
        if (old + 1u == (gen + 1u) * nloc) {
            __builtin_amdgcn_fence(__ATOMIC_RELEASE, "agent");
            asm volatile("s_waitcnt vmcnt(0)" ::: "memory");
            const unsigned og = xb_add(&bar[XB_TOP], 1u);
            const unsigned tg = og / nx;
            if (og + 1u == (tg + 1u) * nx) xb_add(&bar[XB_TOPGEN], 1u);
            else XB_SPIN(xb_ld(&bar[XB_TOPGEN]) == tg, bar);
            __builtin_amdgcn_fence(__ATOMIC_ACQUIRE, "agent");
            xb_add(&bar[XB_XGEN(x)], 1u);
            asm volatile("s_waitcnt vmcnt(0)" ::: "memory");
        } else {
            XB_SPIN(xb_ld(&bar[XB_XGEN(x)]) == gen, bar);
            __builtin_amdgcn_fence(__ATOMIC_ACQUIRE, "agent");
            asm volatile("s_waitcnt vmcnt(0)" ::: "memory");
        }
    }
    __syncthreads();
}

__global__ void __launch_bounds__(NTHREADS, 2) fwd_megakernel(Args args) {
    extern __shared__ __attribute__((aligned(16))) unsigned char lds_raw[];
    cg::grid_group grid = cg::this_grid();
    ArgsP ap0 = (ArgsP)__builtin_amdgcn_kernarg_segment_ptr();
    const int ph_lo = ap0->ph_lo, ph_hi = ap0->ph_hi, use_sync = ap0->use_sync, dup_mask = ap0->pad;
    {
        volatile LAS unsigned* st0 = (volatile LAS unsigned*)((LAS unsigned char*)lds_raw + 131072 + 512);
        if (threadIdx.x == 0) { st0[0] = 0u; st0[1] = 0u; (void)xb_add((unsigned*)(ap0->ws + WS_CTL) + 4096 + XB_XCNT(xb_xcc_id()), 1u); }
        __syncthreads();
    }
    for (int ph = ph_lo; ph < ph_hi; ++ph) {
        if (ph > ph_lo && use_sync) {
            if (use_sync == 2) grid.sync();
            else xcd_barrier((unsigned*)(ap0->ws + WS_CTL) + 4096, (volatile LAS unsigned*)((LAS unsigned char*)lds_raw + 131072 + 512), gridDim.x);
        }
        const int ptype = (ph == 0) ? 15 : (ph - 1) % 14, nrep = 1 + ((dup_mask >> ptype) & 1);
        for (int rep = 0; rep < nrep; ++rep) {
        ArgsP ap = ap0; asm volatile("" : "+s"(ap));
        int tid_ = threadIdx.x; asm volatile("" : "+v"(tid_));
        unsigned char* ws = ap->ws;
        int bid_ = blockIdx.x, G_ = gridDim.x; asm volatile("" : "+s"(bid_), "+s"(G_));
        Ctx c; c.tid = tid_; c.lane = c.tid & 63; c.wave = __builtin_amdgcn_readfirstlane(c.tid >> 6); c.G = G_; c.bid = bid_;
        c.gw = c.bid * NWAVES + c.wave; c.NGW = c.G * NWAVES; c.lds = (LAS unsigned char*)lds_raw; c.ws = ws;
        float* X = (float*)(ws + WS_X); bf16_t* XB = (bf16_t*)(ws + WS_XB); bf16_t* HB = (bf16_t*)(ws + WS_H); float* E1 = (float*)(ws + WS_H);
        bf16_t* PROJ = (bf16_t*)(ws + WS_PROJ); bf16_t* VT = (bf16_t*)(ws + WS_VT); bf16_t* MIX = (bf16_t*)(ws + WS_MIX); float* STATS = (float*)(ws + WS_GG + 512 * 1024);
        if (ph == 0) { prologue(ap, c);
            continue; }
        const int l = (ph - 1) / 14; int s = (ph - 1) % 14;
        if (s == 5) { gla_scan_phase(c); continue; }
        if (s > 5) --s;
        unsigned char* wl = ws + WS_W + (size_t)l * WL_SIZE;
        const float* lng = ap->in[18] + (size_t)l * 4 * DM; const float* lnb = ap->in[19] + (size_t)l * 4 * DM;
        const float* xsrc = (l == 0 && s <= 1) ? ap->in[0] : X;
        if (s == 0 || s == 8) {
            pg8::Gemm g{XB, (const bf16_t*)(wl + (s == 0 ? WL_GU1 : WL_GU2)), MTOK, 2 * FF, DM}; pg8::StaticOrder S; S.init(MTOK, 2 * FF, c.G, c.bid);
            pg8::EpiSwiGLU E{HB};
            pg8::gemm_phase<pg8::EpiSwiGLU, pg8::StaticOrder, true, true>(c.lds, g, S, E, c.tid);
            const int half0 = c.G / 2;
            if (c.bid >= half0) {
                if (s == 8) {
                    pg8::Gemm g2{(const bf16_t*)(ws + WS_PB) + (size_t)l * MTOK * PLE, (const bf16_t*)(wl + WL_PE), MTOK, DM, PLE}; pg8::StaticOrder S2; S2.init(MTOK, DM, c.G - half0, c.bid - half0);
                    pg8::EpiF32 E2{(float*)PROJ};
                    pg8::gemm_phase<pg8::EpiF32, pg8::StaticOrder, false, true>(c.lds, g2, S2, E2, c.tid);
                }
                {
                    const int tk = 2 * l + (s == 8 ? 1 : 0), cnt = tail_cnt(tk);
                    LAS float* scr = (LAS float*)(c.lds + c.wave * 16384);
                    for (int it = (c.bid - half0) * NWAVES + c.wave; it < cnt; it += (c.G - half0) * NWAVES) convert_item(ap, c, PER_LAYER + tail_item(tk, it), scr);
                }
            }
        } else if (s == 1 || s == 9) {
            pg8::Gemm g{HB, (const bf16_t*)(wl + (s == 1 ? WL_D1 : WL_D2)), MTOK, DM, FF}; pg8::StaticOrder S; S.init(MTOK, DM, c.G, c.bid);
            const bool raw = (l == 0 && s == 1);
            const float* pg_ = (s == 1) ? (ap->in[18] + (size_t)((l - 1) * 4 + 3) * DM) : (lng + 1 * DM); const float* pb_ = (s == 1) ? (ap->in[19] + (size_t)((l - 1) * 4 + 3) * DM) : (lnb + 1 * DM);
            const float* idb = (const float*)(ws + WS_GG + 640 * 1024);
            pg8::EpiResid E{xsrc, X, ALPHA, 0.5f, raw ? idb : STATS, raw ? idb + 2 * MTOK : pg_, raw ? idb + 2 * MTOK + DM : pb_};
            pg8::gemm_phase<pg8::EpiResid, pg8::StaticOrder, false, true>(c.lds, g, S, E, c.tid);
        } else if (s == 2 || s == 7 || s == 10 || s == 12) {
            const int which = (s == 2) ? 0 : (s == 7) ? 1 : (s == 10) ? 2 : 3;
            const bool final_ln = (l == DEPTH - 1 && s == 12);
            ln_phase(c, X, final_ln ? ap->out : nullptr, final_ln ? nullptr : XB, STATS, lng + which * DM, lnb + which * DM);
        } else if (s == 3) {
            { pg8::Gemm g{XB, (const bf16_t*)(wl + WL_IN), MTOK, PROJW, DM}; pg8::StaticOrder S; S.init(MTOK, PROJW, c.G, c.bid);
              pg8::EpiProj E{PROJ, (const float*)(ws + WS_R128), (const float*)(ws + WS_R64), (bf16_t*)(ws + WS_KFD), (bf16_t*)(ws + WS_KFM)};
              pg8::gemm_phase<pg8::EpiProj, pg8::StaticOrder, true, true>(c.lds, g, S, E, c.tid);
            }
            { pg8::Gemm g{(const bf16_t*)(wl + WL_V), XB, DM, MTOK, DM}; pg8::StaticOrder S; S.init(DM, MTOK, c.G, c.bid);
              pg8::EpiVt E{VT};
              pg8::gemm_phase<pg8::EpiVt, pg8::StaticOrder, false, true>(c.lds, g, S, E, c.tid); }
            gg_phase(c, XB, (const bf16_t*)(wl + WL_GG), (float*)(ws + WS_GG));
        } else if (s == 4) {
            post_phase(c, ap, l);
        } else if (s == 5) {
            attn_phase(c, ap, l, 1 + 16 * l + 8 * rep);
        } else if (s == 6) {
            pg8::Gemm g{MIX, (const bf16_t*)(wl + WL_OUT), MTOK, DM, DM}; pg8::StaticOrder S; S.init(MTOK, DM, c.G, c.bid);
            pg8::EpiResid E{X, X, ALPHA, 1.0f, STATS, lng, lnb};
            pg8::gemm_phase<pg8::EpiResid, pg8::StaticOrder, false, true>(c.lds, g, S, E, c.tid);
        } else if (s == 11) {
            { pg8::Gemm g{XB, (const bf16_t*)(wl + WL_PG), MTOK, DM, DM}; pg8::StaticOrder S; S.init(MTOK, DM, c.G, c.bid);
              pg8::EpiGate E{X, X, (const float*)PROJ, ALPHA, STATS, lng + 2 * DM, lnb + 2 * DM};
              pg8::gemm_phase<pg8::EpiGate, pg8::StaticOrder, false, true>(c.lds, g, S, E, c.tid); }
        }
        }
    }
}

extern "C" void kernel_launch(void* const* d_in, const int* in_sizes, int n_in, void* d_out, int out_size, void* d_ws, size_t ws_size, hipStream_t stream) {
    static int grid = 0;
    if (grid == 0) {
        if (n_in != 20 || in_sizes[0] != MTOK * DM || out_size != MTOK * DM || ws_size < WS_END) {
            fprintf(stderr, "kernel_launch: unexpected shapes (n_in %d, in0 %d, out %d, ws %zu need %zu)\n", n_in, n_in > 0 ? in_sizes[0] : -1, out_size, ws_size, (size_t)WS_END); grid = -1; return; }
        int dev = 0, cus = 0, per_cu = 0;
        hipGetDevice(&dev); hipDeviceGetAttribute(&cus, hipDeviceAttributeMultiprocessorCount, dev);
        hipFuncSetAttribute((const void*)fwd_megakernel, hipFuncAttributeMaxDynamicSharedMemorySize, LDS_BYTES);
        hipOccupancyMaxActiveBlocksPerMultiprocessor(&per_cu, (const void*)fwd_megakernel, NTHREADS, LDS_BYTES);
        if (per_cu < 1) { fprintf(stderr, "kernel_launch: occupancy query says %d blocks per CU\n", per_cu); per_cu = 1; }
        (void)hipGetLastError();
        grid = cus * per_cu;
        fprintf(stderr, "kernel_launch: grid %d (cus %d x %d)\n", grid, cus, per_cu);
    }
    if (grid < 0) return;
    hipMemsetAsync((char*)d_ws + WS_CTL, 0, 1 * MiB, stream);
    Args a{};
    for (int i = 0; i < 20; ++i) a.in[i] = (const float*)d_in[i];
    a.out = (float*)d_out; a.ws = (unsigned char*)d_ws; a.ph_lo = 0; a.ph_hi = 29; a.use_sync = 1;
#ifndef DUP_MASK
#define DUP_MASK 0
#endif
    a.pad = DUP_MASK;
    void* kargs[] = {&a};
    hipError_t e = hipLaunchCooperativeKernel((const void*)fwd_megakernel, dim3(grid), dim3(NTHREADS), kargs, LDS_BYTES, stream);
    if (e != hipSuccess) fprintf(stderr, "cooperative launch failed: %s (grid %d)\n", hipGetErrorString(e), grid);
}
```
